# Optimizing an MI355X kernel written in HIP

```python
import math
import jax
import jax.numpy as jnp
from jax import lax
import numpy as np


D_MODEL = 1024
BATCH = 16
SEQ = 4096
DEPTH = 4

N_DIFF_HEADS = 8
DIFF_HEAD_DIM = D_MODEL // N_DIFF_HEADS // 2
ROPE_THETA = 10000.0
Q_BLOCK = 128
D_RNN = D_MODEL
N_LRU_BLOCKS = 8
LRU_BLOCK = D_RNN // N_LRU_BLOCKS
CONV_WIDTH = 4
LRU_C = 8.0
D_FF = 2816
N_EXPERTS = 8
TOP_K = 2
D_FF_EXPERT = 3584
EXPERT_BLOCK = 256
D_PLE = 256
NORM_EPS = 1e-6
SUBLN_EPS = 1e-5

kernel_name = 'hybrid_diffattn_rglru_moe'


def rmsnorm(x, g, eps=NORM_EPS):
    xf = x.astype(jnp.float32)
    y = xf * lax.rsqrt(jnp.mean(xf * xf, axis=-1, keepdims=True) + eps)
    return (y * g.astype(jnp.float32)).astype(x.dtype)


def rope_tables(seq, dim):
    inv = 1.0 / (ROPE_THETA ** (jnp.arange(0, dim, 2, dtype=jnp.float32) / dim))
    ang = jnp.arange(seq, dtype=jnp.float32)[:, None] * inv[None, :]
    return jnp.cos(ang), jnp.sin(ang)


def apply_rope(x, cos, sin):
    x1, x2 = jnp.split(x.astype(jnp.float32), 2, axis=-1)
    c = cos[None, :, None, :]
    s = sin[None, :, None, :]
    return jnp.concatenate([x1 * c - x2 * s, x2 * c + x1 * s], axis=-1).astype(x.dtype)


def diff_attention(xn, wq, wk, wv, wo, lq1, lk1, lq2, lk2, subln_g, lambda_init):
    B, S, _ = xn.shape
    H, d = N_DIFF_HEADS, DIFF_HEAD_DIM
    q = (xn @ wq).reshape(B, S, 2 * H, d)
    k = (xn @ wk).reshape(B, S, 2 * H, d)
    v = (xn @ wv).reshape(B, S, H, 2 * d)
    cos, sin = rope_tables(S, d)
    q = apply_rope(q, cos, sin) * (d ** -0.5)
    k = apply_rope(k, cos, sin)
    lam = (jnp.exp(jnp.sum(lq1.astype(jnp.float32) * lk1.astype(jnp.float32)))
           - jnp.exp(jnp.sum(lq2.astype(jnp.float32) * lk2.astype(jnp.float32)))
           + lambda_init)
    outs = []
    for start in range(0, S, Q_BLOCK):
        end = start + Q_BLOCK
        qb = q[:, start:end]
        kb = k[:, :end]
        vb = v[:, :end]
        s = jnp.einsum('bqmd,bkmd->bmqk', qb, kb, preferred_element_type=jnp.float32)
        qpos = jnp.arange(start, end)[:, None]
        kpos = jnp.arange(end)[None, :]
        s = jnp.where(kpos <= qpos, s, -jnp.inf)
        w = jax.nn.softmax(s, axis=-1).reshape(B, H, 2, Q_BLOCK, end)
        wdiff = w[:, :, 0] - lam * w[:, :, 1]
        outs.append(jnp.einsum('bhqk,bkhe->bqhe', wdiff.astype(vb.dtype), vb))
    o = jnp.concatenate(outs, axis=1)
    o = rmsnorm(o, subln_g, SUBLN_EPS) * (1.0 - lambda_init)
    return o.reshape(B, S, H * 2 * d) @ wo


def block_diag_linear(x, w, b):
    B, S, C = x.shape
    xb = x.reshape(B, S, N_LRU_BLOCKS, LRU_BLOCK)
    return jnp.einsum('bsnc,ncd->bsnd', xb, w).reshape(B, S, C) + b


def causal_depthwise_conv(x, w, b):
    C = x.shape[-1]
    y = lax.conv_general_dilated(
        x, w[:, None, :], window_strides=(1,), padding=[(CONV_WIDTH - 1, 0)],
        dimension_numbers=('NWC', 'WIO', 'NWC'), feature_group_count=C)
    return y + b


def rg_lru(x, wa, ba, wx, bx, lam):
    r = jax.nn.sigmoid(block_diag_linear(x, wa, ba)).astype(jnp.float32)
    i = jax.nn.sigmoid(block_diag_linear(x, wx, bx)).astype(jnp.float32)
    log_a = -LRU_C * r * jax.nn.softplus(-lam.astype(jnp.float32))
    a = jnp.exp(log_a)
    mult = jnp.sqrt(-jnp.expm1(2.0 * log_a))
    bt = mult * i * x.astype(jnp.float32)

    def combine(left, right):
        a1, b1 = left
        a2, b2 = right
        return a1 * a2, a2 * b1 + b2

    _, h = lax.associative_scan(combine, (a, bt), axis=1)
    return h.astype(x.dtype)


def recurrent_block(xn, w_in_x, w_in_y, conv_w, conv_b, wa, ba, wx, bx, lam, w_out):
    y = jax.nn.gelu(xn @ w_in_y, approximate=True)
    u = causal_depthwise_conv(xn @ w_in_x, conv_w, conv_b)
    h = rg_lru(u, wa, ba, wx, bx, lam)
    return (h * y) @ w_out


def swiglu(xn, wg, wu, wd):
    return (jax.nn.silu(xn @ wg) * (xn @ wu)) @ wd


def moe_swiglu(xn, w_router, w_gate, w_up, w_down):
    B, S, D = xn.shape
    N = B * S
    xt = xn.reshape(N, D)
    logits = jnp.einsum('nd,de->ne', xt, w_router, preferred_element_type=jnp.float32)
    top_vals, top_idx = lax.top_k(logits, TOP_K)
    gates = jax.nn.softmax(top_vals, axis=-1)
    flat_e = top_idx.reshape(-1).astype(jnp.int32)
    flat_tok = jnp.repeat(jnp.arange(N, dtype=jnp.int32), TOP_K)
    flat_g = gates.reshape(-1)
    order = jnp.argsort(flat_e, stable=True)
    sorted_e = flat_e[order]
    counts = jnp.bincount(flat_e, length=N_EXPERTS).astype(jnp.int32)
    padded = (counts + EXPERT_BLOCK - 1) // EXPERT_BLOCK * EXPERT_BLOCK
    start = jnp.cumsum(counts) - counts
    pstart = jnp.cumsum(padded) - padded
    rank = jnp.arange(N * TOP_K, dtype=jnp.int32) - start[sorted_e]
    dest = pstart[sorted_e] + rank
    n_blocks = -(-(N * TOP_K) // EXPERT_BLOCK) + N_EXPERTS
    P = n_blocks * EXPERT_BLOCK
    slot_tok = jnp.zeros((P,), jnp.int32).at[dest].set(flat_tok[order])
    slot_gate = jnp.zeros((P,), jnp.float32).at[dest].set(flat_g[order])
    block_start = jnp.arange(n_blocks, dtype=jnp.int32) * EXPERT_BLOCK
    block_expert = jnp.minimum(
        jnp.searchsorted(jnp.cumsum(padded), block_start, side='right'), N_EXPERTS - 1)
    xs = xt[slot_tok].reshape(n_blocks, EXPERT_BLOCK, D)

    def expert_block(args):
        xb, e = args
        hb = jax.nn.silu(xb @ w_gate[e]) * (xb @ w_up[e])
        return hb @ w_down[e]

    ys = lax.map(expert_block, (xs, block_expert)).reshape(P, D)
    out = jnp.zeros((N, D), jnp.float32).at[slot_tok].add(
        ys.astype(jnp.float32) * slot_gate[:, None])
    return out.astype(xn.dtype).reshape(B, S, D)


def per_layer_embedding(h, p_i, ln_g, w_proj, w_gate):
    g = jax.nn.sigmoid(rmsnorm(h, ln_g) @ w_gate)
    return g * (p_i @ w_proj)


def setup_inputs(seed: int = 0) -> dict:
    key = jax.random.key(seed)
    ks = jax.random.split(key, 40)
    n_even = (DEPTH + 1) // 2
    n_odd = DEPTH // 2
    D = D_MODEL
    d = DIFF_HEAD_DIM
    f32 = jnp.float32

    def nrm(k, shape, fan_in):
        return jax.random.normal(k, shape, f32) * (fan_in ** -0.5)

    def gain(k, shape):
        return 1.0 + 0.02 * jax.random.normal(k, shape, f32)

    def bias(k, shape):
        return 0.01 * jax.random.normal(k, shape, f32)

    a0 = jax.random.uniform(ks[27], (n_odd, D_RNN), f32, 0.9, 0.999)
    s0 = a0 ** (1.0 / LRU_C)
    lru_lambda = jnp.log(s0) - jnp.log1p(-s0)

    return {
        'x': jax.random.normal(ks[0], (BATCH, SEQ, D), f32),
        'p': jax.random.normal(ks[1], (DEPTH, BATCH, SEQ, D_PLE), f32),
        'ln_mix': gain(ks[2], (DEPTH, D)),
        'ln_ffn': gain(ks[3], (DEPTH, D)),
        'ln_ple': gain(ks[4], (DEPTH, D)),
        'ln_final': gain(ks[5], (D,)),
        'ple_w_proj': nrm(ks[6], (DEPTH, D_PLE, D), D_PLE),
        'ple_w_gate': nrm(ks[7], (DEPTH, D, D), D),
        'attn_wq': nrm(ks[8], (n_even, D, 2 * N_DIFF_HEADS * d), D),
        'attn_wk': nrm(ks[9], (n_even, D, 2 * N_DIFF_HEADS * d), D),
        'attn_wv': nrm(ks[10], (n_even, D, 2 * N_DIFF_HEADS * d), D),
        'attn_wo': nrm(ks[11], (n_even, 2 * N_DIFF_HEADS * d, D), 2 * N_DIFF_HEADS * d),
        'attn_lambda_q1': 0.1 * jax.random.normal(ks[12], (n_even, d), f32),
        'attn_lambda_k1': 0.1 * jax.random.normal(ks[13], (n_even, d), f32),
        'attn_lambda_q2': 0.1 * jax.random.normal(ks[14], (n_even, d), f32),
        'attn_lambda_k2': 0.1 * jax.random.normal(ks[15], (n_even, d), f32),
        'attn_subln': gain(ks[16], (n_even, 2 * d)),
        'ffn_w_gate': nrm(ks[17], (n_even, D, D_FF), D),
        'ffn_w_up': nrm(ks[18], (n_even, D, D_FF), D),
        'ffn_w_down': nrm(ks[19], (n_even, D_FF, D), D_FF),
        'lru_w_in_x': nrm(ks[20], (n_odd, D, D_RNN), D),
        'lru_w_in_y': nrm(ks[21], (n_odd, D, D_RNN), D),
        'lru_conv_w': nrm(ks[22], (n_odd, CONV_WIDTH, D_RNN), CONV_WIDTH),
        'lru_conv_b': bias(ks[23], (n_odd, D_RNN)),
        'lru_gate_a_w': nrm(ks[24], (n_odd, N_LRU_BLOCKS, LRU_BLOCK, LRU_BLOCK), LRU_BLOCK),
        'lru_gate_a_b': bias(ks[25], (n_odd, D_RNN)),
        'lru_gate_x_w': nrm(ks[26], (n_odd, N_LRU_BLOCKS, LRU_BLOCK, LRU_BLOCK), LRU_BLOCK),
        'lru_gate_x_b': bias(ks[28], (n_odd, D_RNN)),
        'lru_lambda': lru_lambda,
        'lru_w_out': nrm(ks[29], (n_odd, D_RNN, D), D_RNN),
        'moe_w_router': nrm(ks[30], (n_odd, D, N_EXPERTS), D),
        'moe_w_gate': nrm(ks[31], (n_odd, N_EXPERTS, D, D_FF_EXPERT), D),
        'moe_w_up': nrm(ks[32], (n_odd, N_EXPERTS, D, D_FF_EXPERT), D),
        'moe_w_down': nrm(ks[33], (n_odd, N_EXPERTS, D_FF_EXPERT, D), D_FF_EXPERT),
    }


def reference(x, p, ln_mix, ln_ffn, ln_ple, ln_final, ple_w_proj, ple_w_gate,
              attn_wq, attn_wk, attn_wv, attn_wo, attn_lambda_q1, attn_lambda_k1,
              attn_lambda_q2, attn_lambda_k2, attn_subln,
              ffn_w_gate, ffn_w_up, ffn_w_down,
              lru_w_in_x, lru_w_in_y, lru_conv_w, lru_conv_b, lru_gate_a_w, lru_gate_a_b,
              lru_gate_x_w, lru_gate_x_b, lru_lambda, lru_w_out,
              moe_w_router, moe_w_gate, moe_w_up, moe_w_down):
    h = x
    for i in range(DEPTH):
        j = i // 2
        hn = rmsnorm(h, ln_mix[i])
        if i % 2 == 0:
            lambda_init = 0.8 - 0.6 * math.exp(-0.3 * i)
            h = h + diff_attention(hn, attn_wq[j], attn_wk[j], attn_wv[j], attn_wo[j],
                                   attn_lambda_q1[j], attn_lambda_k1[j],
                                   attn_lambda_q2[j], attn_lambda_k2[j],
                                   attn_subln[j], lambda_init)
            h = h + swiglu(rmsnorm(h, ln_ffn[i]), ffn_w_gate[j], ffn_w_up[j], ffn_w_down[j])
        else:
            h = h + recurrent_block(hn, lru_w_in_x[j], lru_w_in_y[j], lru_conv_w[j], lru_conv_b[j],
                                    lru_gate_a_w[j], lru_gate_a_b[j], lru_gate_x_w[j],
                                    lru_gate_x_b[j], lru_lambda[j], lru_w_out[j])
            h = h + moe_swiglu(rmsnorm(h, ln_ffn[i]), moe_w_router[j], moe_w_gate[j],
                               moe_w_up[j], moe_w_down[j])
        h = h + per_layer_embedding(h, p[i], ln_ple[i], ple_w_proj[i], ple_w_gate[i])
    return rmsnorm(h, ln_final)
```

```cpp
#include <hip/hip_runtime.h>
#include <hip/hip_bf16.h>
#include <cstdio>
#include <cstdint>
#include <cmath>

#define GAS __attribute__((address_space(1)))
#define LAS __attribute__((address_space(3)))
typedef unsigned short bf16_t;
typedef short bf16x8 __attribute__((ext_vector_type(8)));
typedef float f32x4 __attribute__((ext_vector_type(4)));
typedef float f32x2 __attribute__((ext_vector_type(2)));
typedef unsigned u32x4 __attribute__((ext_vector_type(4)));
typedef unsigned u32x2 __attribute__((ext_vector_type(2)));
typedef int v4i_t __attribute__((ext_vector_type(4)));
typedef int v8i_t __attribute__((ext_vector_type(8)));

constexpr int NB = 16, SEQ = 4096, D = 1024, NTOK = NB * SEQ, DEPTH = 4;
constexpr int FF = 2816, FFE = 3584, NE = 8, DPLE = 256;
constexpr float NORM_EPS = 1e-6f, SUBLN_EPS = 1e-5f;
constexpr float C2 = 0.125f * 1.4426950408889634f;

__device__ __forceinline__ unsigned cvt_pk_bf16(float lo, float hi) { unsigned r; asm volatile("v_cvt_pk_bf16_f32 %0, %1, %2" : "=v"(r) : "v"(lo), "v"(hi)); return r; }
__device__ __forceinline__ float bf_lo(unsigned w) { return __uint_as_float(w << 16); }
__device__ __forceinline__ float bf_hi(unsigned w) { return __uint_as_float(w & 0xffff0000u); }
__device__ __forceinline__ float fast_sigmoid(float x) { return __builtin_amdgcn_rcpf(1.0f + __builtin_amdgcn_exp2f(-1.4426950408889634f * x)); }

template <int M> __device__ __forceinline__ float swz_xor(float v) { return __int_as_float(__builtin_amdgcn_ds_swizzle(__float_as_int(v), (M << 10) | 0x1f)); }
__device__ __forceinline__ float add_x32(float v) { auto rr = __builtin_amdgcn_permlane32_swap(__float_as_uint(v), __float_as_uint(v), false, false); return __uint_as_float(rr[0]) + __uint_as_float(rr[1]); }
__device__ __forceinline__ unsigned pk_fp8x4(float a, float b, float c, float d) {
    a = __builtin_fminf(__builtin_fmaxf(a, -448.f), 448.f); b = __builtin_fminf(__builtin_fmaxf(b, -448.f), 448.f); c = __builtin_fminf(__builtin_fmaxf(c, -448.f), 448.f); d = __builtin_fminf(__builtin_fmaxf(d, -448.f), 448.f);
    int w = 0; w = __builtin_amdgcn_cvt_pk_fp8_f32(a, b, w, false); w = __builtin_amdgcn_cvt_pk_fp8_f32(c, d, w, true); return (unsigned)w; }
__device__ __forceinline__ unsigned pk_fp8x4_m3(float a, float b, float c, float d) {
    a = __builtin_amdgcn_fmed3f(a, -448.f, 448.f); b = __builtin_amdgcn_fmed3f(b, -448.f, 448.f); c = __builtin_amdgcn_fmed3f(c, -448.f, 448.f); d = __builtin_amdgcn_fmed3f(d, -448.f, 448.f);
    int w = 0; w = __builtin_amdgcn_cvt_pk_fp8_f32(a, b, w, false); w = __builtin_amdgcn_cvt_pk_fp8_f32(c, d, w, true); return (unsigned)w; }
constexpr float W8_SCALE = 64.0f, H8_SCALE = 8.0f;
__device__ __forceinline__ int tid_of(int wave_s) { unsigned m_ = ~0u; asm volatile("" : "+s"(m_), "+s"(wave_s)); return wave_s * 64 + (int)__builtin_amdgcn_mbcnt_hi(m_, __builtin_amdgcn_mbcnt_lo(m_, 0u)); }
__device__ __forceinline__ float rstd_of(const float* ssp, int row) {
    const f32x4* p = (const f32x4*)(ssp + (size_t)row * 16); const f32x4 a = p[0], b = p[1], c = p[2], d = p[3];
    const float s = (((a[0] + a[1]) + (a[2] + a[3])) + ((b[0] + b[1]) + (b[2] + b[3]))) + (((c[0] + c[1]) + (c[2] + c[3])) + ((d[0] + d[1]) + (d[2] + d[3])));
    return __builtin_amdgcn_rsqf(s * (1.f / D) + NORM_EPS);
}
namespace pg8 {
constexpr int BM = 256, BK = 64, HALF = 128, HTB = HALF * BK * 2, STAGE_BYTES = 8 * HTB, NXCD = 8, WGM = 8;
__host__ __device__ __forceinline__ int lds_byte(int r, int c) { const int st = (r >> 4) * 2 + (c >> 5), rr = r & 15, cc = c & 31, ob = rr * 64 + cc * 2; return st * 1024 + (ob ^ (((ob >> 9) & 1) << 5)); }
__host__ __device__ __forceinline__ void stage_rc(int b, int& R, int& C) { const int st = b / 1024, sb = b % 1024, swz = sb ^ (((sb >> 9) & 1) << 5); R = (st >> 1) * 16 + swz / 64; C = (st & 1) * 32 + (swz % 64) / 2; }
__host__ __device__ __forceinline__ int perm32(int rho) { const int n = rho >> 4, i = rho & 15; return 8 * (i >> 2) + 4 * n + (i & 3); }

struct Unit { int pm, pn; };
struct StaticOrder {
    int nM, nN, nwg, G, c, heavy, xs;
    __device__ __forceinline__ void init(int nM_, int nN_, int G_, int c_) { nM = nM_; nN = nN_; nwg = nM * nN; G = G_; c = c_; heavy = 0; xs = 0; }
    __device__ __forceinline__ void comp(int heavy_, int xs_) { heavy = heavy_; xs = heavy_ > 0 ? xs_ : 0; }
    __device__ __forceinline__ bool next(int i, Unit& u) const {
        long L = (long)i * G + c;
        if (xs > 0) { const long base = (long)xs * (G - heavy); L = (c < heavy) ? base + (long)i * G + c : (i < xs ? (long)i * (G - heavy) + (c - heavy) : base + (long)(i - xs) * G + c); }
        if (L >= nwg) return false;
        int wgid = (int)L; { const int q = nwg / NXCD, r = nwg % NXCD, xcd = wgid % NXCD, off = wgid / NXCD; wgid = (xcd < r ? xcd * (q + 1) : r * (q + 1) + (xcd - r) * q) + off; }
        const int nig = WGM * nN, gid = wgid / nig, fm = gid * WGM, gsz = (nM - fm) < WGM ? (nM - fm) : WGM;
        u.pm = fm + ((wgid % nig) % gsz); u.pn = (wgid % nig) / gsz; return true;
    }
};

template <class Epi, class Sched, bool GATHER, bool FP8>
__device__ __forceinline__ void gemm_phase(LAS unsigned char* lds, LAS float* rs_lds, const int K, const int lda, const int ldb, const Sched& S, const Epi& E, const int wave_s) {
    int tid = tid_of(wave_s); asm volatile("" : "+v"(tid));
    const int wid = __builtin_amdgcn_readfirstlane(tid >> 6), lane = tid & 63, wr = wid >> 2, wc = wid & 3, fr = lane & 15, fq = lane >> 4;
    int K_ = K; asm volatile("" : "+s"(K_)); const int nt = K_ / BK;
    int sR[2], sC[2];
    unsigned voffB[2], vA[2][2], vN[2][2];
#pragma unroll
    for (int i = 0; i < 2; ++i) { stage_rc(tid * 16 + i * 8192, sR[i], sC[i]); const int Rb = Epi::PERM ? ((sR[i] & ~31) + perm32(sR[i] & 31)) : sR[i];
        voffB[i] = (unsigned)(Rb * ldb + sC[i]) * 2u; }
    const size_t kstep = (size_t)(BK * 2);
    const size_t hstepB = (size_t)HALF * ldb * 2;
    const unsigned ldsw = (unsigned)wid * 1024u;
    const int aoff = lds_byte(wr * 64 + fr, fq * 8), boff = lds_byte(wc * 32 + fr, fq * 8);
#define PG8_SA(b, h) (((b) * 2 + (h)) * HTB)
#define PG8_SB(b, h) ((4 + (b) * 2 + (h)) * HTB)
#define PG8_STAGE(bufoff, gbase, voff) do { _Pragma("unroll") for (int _i = 0; _i < 2; ++_i) \
        __builtin_amdgcn_global_load_lds((const unsigned*)((const char*)(gbase) + (voff)[_i]), (LAS unsigned*)(lds + (bufoff) + ldsw + _i * 8192), 16, 0, 0); } while (0)
#define PG8_LD2(p) __builtin_shufflevector(*(const LAS v4i_t*)(p), *(const LAS v4i_t*)((p) + 1024), 0, 1, 2, 3, 4, 5, 6, 7)
#define PG8_LDA(dst, b, h) do { _Pragma("unroll") for (int m = 0; m < 4; ++m) dst[m] = PG8_LD2(lds + PG8_SA(b, h) + aoff + m * 2048); } while (0)
#define PG8_LDB(dst, b, h) do { _Pragma("unroll") for (int n = 0; n < 2; ++n) dst[n] = PG8_LD2(lds + PG8_SB(b, h) + boff + n * 2048); } while (0)
#define PG8_HALF(x, k) __builtin_bit_cast(bf16x8, __builtin_shufflevector(x, x, 4 * (k), 4 * (k) + 1, 4 * (k) + 2, 4 * (k) + 3))
#define PG8_MMA(ai, bj, At, Bt) do { __builtin_amdgcn_s_setprio(1); _Pragma("unroll") for (int m = 0; m < 4; ++m) _Pragma("unroll") for (int n = 0; n < 2; ++n) { \
        if constexpr (FP8) asm volatile("v_mfma_scale_f32_16x16x128_f8f6f4 %0, %1, %2, %0, %3, %3 op_sel_hi:[0,0,0]" : "+v"(acc[ai][bj][m][n]) : "v"(Bt[n]), "v"(At[m]), "v"(sc127));        \
        else { acc[ai][bj][m][n] = __builtin_amdgcn_mfma_f32_16x16x32_bf16(PG8_HALF(Bt[n], 0), PG8_HALF(At[m], 0), acc[ai][bj][m][n], 0, 0, 0); \
               acc[ai][bj][m][n] = __builtin_amdgcn_mfma_f32_16x16x32_bf16(PG8_HALF(Bt[n], 1), PG8_HALF(At[m], 1), acc[ai][bj][m][n], 0, 0, 0); } } __builtin_amdgcn_s_setprio(0); } while (0)
#define PG8_WAIT_V(n) asm volatile("s_waitcnt vmcnt(" #n ")" ::: "memory")
#define PG8_WAIT_L(n) asm volatile("s_waitcnt lgkmcnt(" #n ")" ::: "memory")
#define PG8_BAR __builtin_amdgcn_s_barrier()
#define PG8_SCHED __builtin_amdgcn_sched_barrier(0)
#define PG8_AOFFS(dst, u) do { _Pragma("unroll") for (int _h = 0; _h < 2; ++_h) _Pragma("unroll") for (int _i = 0; _i < 2; ++_i) { \
        if constexpr (GATHER) dst[_h][_i] = (unsigned)(S.arow(u, _h * HALF + sR[_i]) * lda + sC[_i]) * 2u; else dst[_h][_i] = (unsigned)((_h * HALF + sR[_i]) * lda + sC[_i]) * 2u; } } while (0)
    Unit cur, nxt; int ui = 0;
    if (!S.next(0, cur)) return;
    f32x4 acc[2][2][4][2];
#pragma unroll
    for (int a = 0; a < 2; ++a)
#pragma unroll
        for (int b = 0; b < 2; ++b)
#pragma unroll
            for (int m = 0; m < 4; ++m)
#pragma unroll
                for (int n = 0; n < 2; ++n) acc[a][b][m][n] = (f32x4){0.f, 0.f, 0.f, 0.f};
    v8i_t At[4], B0[2], B1[2]; const int sc127 = 0x7f7f7f7f; (void)sc127;
    const char* cA = S.abase(cur); const char* cB = S.bbase(cur);
    PG8_AOFFS(vA, cur);
    PG8_STAGE(PG8_SB(0, 0), cB, voffB); PG8_STAGE(PG8_SB(0, 1), cB + hstepB, voffB); PG8_STAGE(PG8_SA(0, 0), cA, vA[0]); PG8_STAGE(PG8_SA(0, 1), cA, vA[1]);
    if (wr == 1) PG8_BAR;
    PG8_WAIT_V(2); PG8_BAR;
    PG8_STAGE(PG8_SB(1, 0), cB + kstep, voffB); PG8_STAGE(PG8_SA(1, 0), cA + kstep, vA[0]); PG8_STAGE(PG8_SB(1, 1), cB + hstepB + kstep, voffB);
    PG8_WAIT_V(6); PG8_BAR;
    for (;;) {
        const bool has_next = S.next(ui + 1, nxt);
        const char* nA = cA; const char* nB = cB;
#pragma unroll
        for (int _h = 0; _h < 2; ++_h)
#pragma unroll
            for (int _i = 0; _i < 2; ++_i) vN[_h][_i] = vA[_h][_i];
        if (has_next) { nA = S.abase(nxt); nB = S.bbase(nxt); if constexpr (GATHER) { PG8_AOFFS(vN, nxt); } }
        for (int t = 0; t < nt; t += 2) {
            const bool last = (t == nt - 2);
            const char* a1 = cA + (size_t)(t + 1) * kstep;
            const char* a2 = last ? nA : cA + (size_t)(t + 2) * kstep; const char* b2 = last ? nB : cB + (size_t)(t + 2) * kstep;
            const char* a3 = a2 + kstep; const char* b3 = b2 + kstep;
            unsigned o2[2][2];
#pragma unroll
            for (int _h = 0; _h < 2; ++_h)
#pragma unroll
                for (int _i = 0; _i < 2; ++_i) o2[_h][_i] = (GATHER && last) ? vN[_h][_i] : vA[_h][_i];
            PG8_LDB(B0, 0, 0); PG8_LDB(B1, 0, 1); PG8_SCHED; PG8_LDA(At, 0, 0); PG8_STAGE(PG8_SA(1, 1), a1, vA[1]);
            PG8_WAIT_V(8); PG8_WAIT_L(0); PG8_BAR; PG8_MMA(0, 0, At, B0); PG8_MMA(0, 1, At, B1); PG8_BAR; PG8_SCHED;
            PG8_LDA(At, 0, 1); PG8_STAGE(PG8_SB(0, 0), b2, voffB); PG8_STAGE(PG8_SB(0, 1), b2 + hstepB, voffB); PG8_STAGE(PG8_SA(0, 0), a2, o2[0]);
            PG8_WAIT_V(8); PG8_WAIT_L(0); PG8_BAR; PG8_MMA(1, 0, At, B0); PG8_MMA(1, 1, At, B1); PG8_BAR; PG8_SCHED;
            PG8_LDB(B0, 1, 0); PG8_LDB(B1, 1, 1); PG8_SCHED; PG8_LDA(At, 1, 0); PG8_STAGE(PG8_SA(0, 1), a2, o2[1]);
            PG8_WAIT_V(8); PG8_WAIT_L(0); PG8_BAR; PG8_MMA(0, 0, At, B0); PG8_MMA(0, 1, At, B1); PG8_BAR; PG8_SCHED;
            PG8_LDA(At, 1, 1); PG8_STAGE(PG8_SB(1, 0), b3, voffB); PG8_STAGE(PG8_SB(1, 1), b3 + hstepB, voffB); PG8_STAGE(PG8_SA(1, 0), a3, o2[0]);
            PG8_WAIT_V(8); PG8_WAIT_L(0); PG8_BAR; PG8_MMA(1, 0, At, B0); PG8_MMA(1, 1, At, B1); PG8_BAR; PG8_SCHED;
        }
        if (wr == 0) PG8_BAR;
        E(acc, cur, wr, wc, fr, fq);
#if defined(EPI_DUP) && EPI_DUP
        if constexpr (Epi::IDEMP) { asm volatile("" : "+v"(acc[0][0][0][0]), "+v"(acc[0][1][0][0]), "+v"(acc[1][0][0][0]), "+v"(acc[1][1][0][0]) :: "memory"); E(acc, cur, wr, wc, fr, fq); }
#endif
        if (!has_next) break;
#pragma unroll
        for (int a = 0; a < 2; ++a)
#pragma unroll
            for (int b = 0; b < 2; ++b)
#pragma unroll
                for (int m = 0; m < 4; ++m)
#pragma unroll
                    for (int n = 0; n < 2; ++n) { f32x2 z0, z1; asm volatile("v_mov_b64 %0, 0\n\tv_mov_b64 %1, 0" : "=v"(z0), "=v"(z1)); acc[a][b][m][n] = __builtin_shufflevector(z0, z1, 0, 1, 2, 3); }
        cur = nxt; cA = nA; cB = nB; ++ui;
#pragma unroll
        for (int _h = 0; _h < 2; ++_h)
#pragma unroll
            for (int _i = 0; _i < 2; ++_i) vA[_h][_i] = vN[_h][_i];
        if (wr == 1) PG8_BAR;
    }
    PG8_WAIT_V(0);
    PG8_BAR;
#undef PG8_SA
#undef PG8_SB
#undef PG8_STAGE
#undef PG8_LDA
#undef PG8_LDB
#undef PG8_MMA
#undef PG8_LD2
#undef PG8_HALF
#undef PG8_WAIT_V
#undef PG8_WAIT_L
#undef PG8_BAR
#undef PG8_SCHED
#undef PG8_AOFFS
}
}

namespace attn_body {
using bf16 = __hip_bfloat16;
using s16x4 = __attribute__((ext_vector_type(4))) short;
using f32x16 = __attribute__((ext_vector_type(16))) float;
constexpr int D64 = 64, DM = 1024, OPITCH = 2048;
constexpr int NW = 8, QBLK = 32, QB = QBLK * NW, KVBLK = 64, NQB = SEQ / QB;
__device__ __forceinline__ int crow(int r, int hi) { return (r & 3) + 8 * (r >> 2) + 4 * hi; }
#define SBAR() __builtin_amdgcn_sched_barrier(0)
__device__ __forceinline__ void cmask(f32x16& p0, f32x16& p1, int jb, int qrel, int hi) {
  const float NEG = -INFINITY; int kb = 64 * jb + 4 * hi;
  #pragma unroll
  for (int r = 0; r < 16; ++r) { int kv = kb + (r & 3) + 8 * (r >> 2); if (kv > qrel) p0[r] = NEG; if (kv + 32 > qrel) p1[r] = NEG; }
}
constexpr int NSLOT = 3, SLOTB = 8192;
constexpr int LDS_K = 0, LDS_V = NSLOT * SLOTB, LDS_WS = 2 * NSLOT * SLOTB, LDS_OST = LDS_WS + NW * 64 * 4, LDS_BYTES = LDS_OST + NW * 4096;
__device__ __forceinline__ void glds16(const void* gsrc, unsigned lds_dst) { unsigned keep;
  asm volatile("s_mov_b32 %0, m0\n\ts_mov_b32 m0, %2\n\ts_nop 0\n\tglobal_load_lds_dwordx4 %1, off\n\ts_mov_b32 m0, %0" : "=&s"(keep) : "v"(gsrc), "s"(lds_dst) : "memory"); }
__device__ __forceinline__ float max3f(float a, float b, float c) { float r; asm("v_max3_f32 %0, %1, %2, %3" : "=v"(r) : "v"(a), "v"(b), "v"(c)); return r; }
__device__ __forceinline__ float max2f(float a, float b) { float r; asm("v_max_f32_e32 %0, %1, %2" : "=v"(r) : "v"(a), "v"(b)); return r; }
__device__ __forceinline__ float fadd_s(float a, float b) { float r; asm("v_add_f32_e32 %0, %1, %2" : "=v"(r) : "v"(a), "v"(b)); return r; }
__device__ __forceinline__ float fsub_s(float a, float b) { float r; asm("v_sub_f32_e32 %0, %1, %2" : "=v"(r) : "v"(a), "v"(b)); return r; }
typedef float f32x2_t __attribute__((ext_vector_type(2))); typedef __bf16 bf16x2_t __attribute__((ext_vector_type(2)));
__device__ __forceinline__ unsigned cvtpk_s(float lo, float hi) { f32x2_t v = {lo, hi}; bf16x2_t b = __builtin_convertvector(v, bf16x2_t); return __builtin_bit_cast(unsigned, b); }
#define WAIT_BAR(N) asm volatile("s_waitcnt vmcnt(" #N ") lgkmcnt(0)\n\ts_barrier" ::: "memory")

__device__ __forceinline__ void qkt(f32x16& p0, f32x16& p1, const char* Kslot, const bf16x8* qr, const f32x16& negm, int r32, int hi) {
  const char* kb = Kslot + hi * 1024 + r32 * 16;
  #pragma unroll
  for (int d0 = 0; d0 < 4; ++d0) {
    const bf16x8 b0 = *reinterpret_cast<const bf16x8*>(kb + d0 * 2048);
    const bf16x8 b1 = *reinterpret_cast<const bf16x8*>(kb + d0 * 2048 + 512);
    if (d0 == 0) { p0 = __builtin_amdgcn_mfma_f32_32x32x16_bf16(b0, qr[0], negm, 0, 0, 0); p1 = __builtin_amdgcn_mfma_f32_32x32x16_bf16(b1, qr[0], negm, 0, 0, 0); }
    else { p0 = __builtin_amdgcn_mfma_f32_32x32x16_bf16(b0, qr[d0], p0, 0, 0, 0); p1 = __builtin_amdgcn_mfma_f32_32x32x16_bf16(b1, qr[d0], p1, 0, 0, 0); } }
}
typedef __attribute__((address_space(3))) const char* lds_cptr;
typedef short v4i16_t __attribute__((ext_vector_type(4)));
__device__ __forceinline__ void kload8(bf16x8* kf, lds_cptr kp) {
  kf[0] = *(const __attribute__((address_space(3))) bf16x8*)(kp);        kf[1] = *(const __attribute__((address_space(3))) bf16x8*)(kp + 512);
  kf[2] = *(const __attribute__((address_space(3))) bf16x8*)(kp + 2048); kf[3] = *(const __attribute__((address_space(3))) bf16x8*)(kp + 2560);
  kf[4] = *(const __attribute__((address_space(3))) bf16x8*)(kp + 4096); kf[5] = *(const __attribute__((address_space(3))) bf16x8*)(kp + 4608);
  kf[6] = *(const __attribute__((address_space(3))) bf16x8*)(kp + 6144); kf[7] = *(const __attribute__((address_space(3))) bf16x8*)(kp + 6656);
}
__device__ __forceinline__ void kload2(bf16x8* kf, lds_cptr kp, int j) { kf[2 * j] = *(const __attribute__((address_space(3))) bf16x8*)(kp + j * 2048); kf[2 * j + 1] = *(const __attribute__((address_space(3))) bf16x8*)(kp + j * 2048 + 512); }
__device__ __forceinline__ s16x4 vtr(lds_cptr p) { return __builtin_bit_cast(s16x4, __builtin_amdgcn_ds_read_tr16_b64_v4i16((__attribute__((address_space(3))) v4i16_t*)p)); }
__device__ __forceinline__ float rowmax(const f32x16& p0, const f32x16& p1) {
  float a = max3f(p0[0], p0[1], p1[0]), b = max3f(p0[2], p0[3], p1[1]); a = max3f(a, p1[2], p1[3]);
  #pragma unroll
  for (int r = 4; r < 16; r += 4) { a = max3f(a, p0[r], p0[r + 1]); b = max3f(b, p0[r + 2], p0[r + 3]); a = max3f(a, p1[r], p1[r + 1]); b = max3f(b, p1[r + 2], p1[r + 3]); }
  const float m = max2f(a, b);
  auto rr = __builtin_amdgcn_permlane32_swap(__float_as_uint(m), __float_as_uint(m), false, false);
  return max2f(__uint_as_float(rr[0]), __uint_as_float(rr[1]));
}
__device__ __forceinline__ void pv(f32x16* o, int vb, bf16x8 pa0, bf16x8 pa1, bf16x8 pa2, bf16x8 pa3) {
  #pragma unroll
  for (int d0 = 0; d0 < 2; ++d0) { s16x4 lo[4], hi[4];
    #pragma unroll
    for (int ks = 0; ks < 4; ++ks) {
      asm volatile("ds_read_b64_tr_b16 %0,%1 offset:%c2" : "=&v"(lo[ks]) : "v"(vb), "i"(d0 * 4096 + ks * 1024) : "memory");
      asm volatile("ds_read_b64_tr_b16 %0,%1 offset:%c2" : "=&v"(hi[ks]) : "v"(vb), "i"(d0 * 4096 + ks * 1024 + 512) : "memory"); }
    asm volatile("s_waitcnt lgkmcnt(0)" ::: "memory"); SBAR();
    #define PK(k) (bf16x8){lo[k][0], lo[k][1], lo[k][2], lo[k][3], hi[k][0], hi[k][1], hi[k][2], hi[k][3]}
    o[d0] = __builtin_amdgcn_mfma_f32_32x32x16_bf16(pa0, PK(0), o[d0], 0, 0, 0);
    o[d0] = __builtin_amdgcn_mfma_f32_32x32x16_bf16(pa1, PK(1), o[d0], 0, 0, 0);
    o[d0] = __builtin_amdgcn_mfma_f32_32x32x16_bf16(pa2, PK(2), o[d0], 0, 0, 0);
    o[d0] = __builtin_amdgcn_mfma_f32_32x32x16_bf16(pa3, PK(3), o[d0], 0, 0, 0);
    #undef PK
  }
}
#define ATTN_STORE16(p, v) (*(u32x4*)(p) = (v))
template<int THRL> __device__ __forceinline__ void attn_unit(int b, int qcol, int vcol, int ocol, int qb, const bf16* Q, const bf16* __restrict__ K, const bf16* __restrict__ V, bf16* O, char* shm, const int wave_s) {
  int tid = tid_of(wave_s); asm volatile("" : "+v"(tid)); const int lane = tid & 63, r32 = lane & 31, hi = lane >> 5; const int wid = __builtin_amdgcn_readfirstlane(tid >> 6);
  const long rowbase = (long)b * SEQ; const int q0 = qb * QB;
  const bf16* Qw = Q + (rowbase + q0 + wid * QBLK) * DM + qcol;
  const bf16* Kh = K + rowbase * DM + qcol, *Vh = V + rowbase * DM + vcol;
  const unsigned lds0 = (unsigned)(uintptr_t)shm;
  float* wsf = (float*)(shm + LDS_WS) + wid * 64;
  const bf16* ksrc = Kh + (long)lane * DM + wid * 8;
  const bf16* vsrc = Vh + (long)(16 * (wid & 3) + (lane >> 2)) * DM + (wid >> 2) * 32 + (lane & 3) * 8;
  const unsigned kdst = lds0 + LDS_K + wid * 1024, vdst = lds0 + LDS_V + wid * 1024;
  #define DMA_K(t, slot) glds16(ksrc + (long)(t) * KVBLK * DM, (unsigned)__builtin_amdgcn_readfirstlane(kdst + (slot)))
  #define DMA_V(t, slot) glds16(vsrc + (long)(t) * KVBLK * DM, (unsigned)__builtin_amdgcn_readfirstlane(vdst + (slot)))
  const int vb0 = (int)(lds0 + LDS_V) + ((lane >> 4) & 1) * 32 + (lane & 3) * 8 + (4 * hi + ((lane & 15) >> 2)) * 64;
  const char* Kbase = shm + LDS_K; bf16x8 kf[8];
  const lds_cptr shm3 = (lds_cptr)shm; const lds_cptr kp0 = shm3 + LDS_K + hi * 1024 + r32 * 16; const lds_cptr vp0 = shm3 + LDS_V + ((lane >> 4) & 1) * 32 + (lane & 3) * 8 + (4 * hi + ((lane & 15) >> 2)) * 64;
  const int NT = (q0 + QB) / KVBLK;
  DMA_K(0, 0); DMA_V(0, 0); DMA_K(1, SLOTB);
  bf16x8 qr[4];
  #pragma unroll
  for (int d0 = 0; d0 < 4; ++d0) qr[d0] = *reinterpret_cast<const bf16x8*>(&Qw[(long)r32 * DM + d0 * 16 + hi * 8]);
  float mhat = 0.f, l_reg = 0.f; f32x16 o[2]; o[0] = f32x16{}; o[1] = f32x16{}; f32x16 negm = f32x16{}; asm volatile("" : "+v"(negm));
  const int qrel = wid * QBLK + r32;
  #define CMASK(P0, P1, t) do { int jb_ = (t) - (NT - 4); if (jb_ >= 0) cmask(P0, P1, jb_, qrel, hi); } while (0)
  bool resc = false;
  #define START(P0, P1) do { const float rm = rowmax(P0, P1); resc = false; \
    { const float dl = rm; mhat = fadd_s(mhat, dl); \
      _Pragma("unroll") for (int r = 0; r < 16; ++r) { P0[r] = fsub_s(P0[r], dl); P1[r] = fsub_s(P1[r], dl); } \
      _Pragma("unroll") for (int r = 0; r < 16; ++r) negm[r] = -mhat; asm volatile("" : "+v"(negm)); } \
    _Pragma("unroll") for (int r = 0; r < 16; ++r) P0[r] = __builtin_amdgcn_exp2f(P0[r]); } while (0)
  #define RESC() do { if (resc) { asm volatile("s_waitcnt lgkmcnt(0)" ::: "memory"); \
      _Pragma("unroll") for (int d_ = 0; d_ < 2; ++d_) _Pragma("unroll") for (int r = 0; r < 16; ++r) o[d_][r] *= wsf[crow(r, hi)]; } } while (0)
  f32x16 pA0, pA1, pB0, pB1;
  int sl_prev = 0, sl_cur = 0, sl_next = SLOTB;
  #define ROT() do { sl_prev = sl_cur; sl_cur = sl_next; sl_next = (sl_next == (NSLOT - 1) * SLOTB) ? 0 : sl_next + SLOTB; } while (0)
  DMA_K(2, 2 * SLOTB);
  WAIT_BAR(3);
  qkt(pA0, pA1, Kbase, qr, negm, r32, hi); asm volatile("s_nop 15\n\ts_nop 7" : "+v"(pA0), "+v"(pA1)); CMASK(pA0, pA1, 0);
  START(pA0, pA1);
  _Pragma("unroll") for (int r = 0; r < 16; ++r) pA1[r] = __builtin_amdgcn_exp2f(pA1[r]);
  WAIT_BAR(0);
  DMA_K(3, 0); DMA_V(1, SLOTB);
  ROT();
  kload8(kf, kp0 + sl_cur);
  WAIT_BAR(2);
  s16x4 vlo[8], vhi[8]; u32x4 pw0, pw1, pw2, pw3;
  #define PKW(P, B) cvtpk_s(P[B], P[B + 1])
  #define PAF(k) __builtin_bit_cast(bf16x8, pw##k)
  #define VFR(i) (bf16x8){vlo[i][0], vlo[i][1], vlo[i][2], vlo[i][3], vhi[i][0], vhi[i][1], vhi[i][2], vhi[i][3]}
  #define PIN(x) asm volatile("" : "+v"(x))
  #define MX3(a, b, c) __builtin_fmaxf(__builtin_fmaxf((a), (b)), (c))
  #define GAPA(MF, A0, A1, A2, A3, W0, W1, PW) do { MF; sacc += A0; sacc += A1; sacc += A2; sacc += A3; PIN(sacc); W0; W1; PIN(PW); SBAR(); } while (0)
  #define EX(v) __builtin_amdgcn_exp2f(v)
  #define GAPB(MF, X, B) do { MF; X[B] = EX(X[B]); X[B + 1] = EX(X[B + 1]); X[B + 2] = EX(X[B + 2]); X[B + 3] = EX(X[B + 3]); PIN(X); SBAR(); } while (0)
  #define VRD(i) do { vlo[i] = vtr(vp_ + (((i) >> 2) * 4096 + ((i) & 3) * 1024)); vhi[i] = vtr(vp_ + (((i) >> 2) * 4096 + ((i) & 3) * 1024 + 512)); } while (0)
  #define KRD(G, j) do { if (G) { kload2(kf, kp0 + sl_next, j); SBAR(); } } while (0)
  #define STEP(C0, C1, P0, P1, t, GK, GV, GL) do { SBAR(); \
    const lds_cptr vp_ = vp0 + sl_prev; \
    VRD(0); SBAR(); float sacc = (P0[0] + P0[1]); \
    GAPA(C0 = __builtin_amdgcn_mfma_f32_32x32x16_bf16(kf[0], qr[0], negm, 0, 0, 0), P0[2], P0[3], P0[4], P0[5],     pw0[0] = PKW(P0, 0), pw0[1] = PKW(P0, 2), pw0); \
    VRD(4); SBAR(); GAPA(C1 = __builtin_amdgcn_mfma_f32_32x32x16_bf16(kf[1], qr[0], negm, 0, 0, 0), P0[6], P0[7], P0[8], P0[9],     pw0[2] = PKW(P0, 4), pw0[3] = PKW(P0, 6), pw0); \
    VRD(1); SBAR(); GAPA(C0 = __builtin_amdgcn_mfma_f32_32x32x16_bf16(kf[2], qr[1], C0, 0, 0, 0),   P0[10], P0[11], P0[12], P0[13], pw1[0] = PKW(P0, 8), pw1[1] = PKW(P0, 10), pw1); \
    VRD(5); SBAR(); GAPA(C1 = __builtin_amdgcn_mfma_f32_32x32x16_bf16(kf[3], qr[1], C1, 0, 0, 0),   P0[14], P0[15], P1[0], P1[1],   pw1[2] = PKW(P0, 12), pw1[3] = PKW(P0, 14), pw1); \
    VRD(2); SBAR(); GAPA(C0 = __builtin_amdgcn_mfma_f32_32x32x16_bf16(kf[4], qr[2], C0, 0, 0, 0),   P1[2], P1[3], P1[4], P1[5],     pw2[0] = PKW(P1, 0), pw2[1] = PKW(P1, 2), pw2); \
    VRD(6); SBAR(); GAPA(C1 = __builtin_amdgcn_mfma_f32_32x32x16_bf16(kf[5], qr[2], C1, 0, 0, 0),   P1[6], P1[7], P1[8], P1[9],     pw2[2] = PKW(P1, 4), pw2[3] = PKW(P1, 6), pw2); \
    VRD(3); SBAR(); GAPA(C0 = __builtin_amdgcn_mfma_f32_32x32x16_bf16(kf[6], qr[3], C0, 0, 0, 0),   P1[10], P1[11], P1[12], P1[13], pw3[0] = PKW(P1, 8), pw3[1] = PKW(P1, 10), pw3); \
    VRD(7); SBAR(); GAPA(C1 = __builtin_amdgcn_mfma_f32_32x32x16_bf16(kf[7], qr[3], C1, 0, 0, 0),   P1[14], P1[15], 0.f, 0.f,       pw3[2] = PKW(P1, 12), pw3[3] = PKW(P1, 14), pw3); \
    l_reg += sacc; \
    if (GK) { DMA_K((t) + 3, sl_cur); } if (GV) { DMA_V((t) + 1, sl_next); } \
    CMASK(C0, C1, t); \
    { float a = MX3(C0[0], C0[1], C1[0]), b = MX3(C0[2], C0[3], C1[1]); a = MX3(a, C1[2], C1[3]); \
      _Pragma("unroll") for (int r = 4; r < 16; r += 4) { a = MX3(a, C0[r], C0[r + 1]); b = MX3(b, C0[r + 2], C0[r + 3]); a = MX3(a, C1[r], C1[r + 1]); b = MX3(b, C1[r + 2], C1[r + 3]); } \
      float rm = __builtin_fmaxf(a, b); { auto rr = __builtin_amdgcn_permlane32_swap(__float_as_uint(rm), __float_as_uint(rm), false, false); rm = __builtin_fmaxf(__uint_as_float(rr[0]), __uint_as_float(rr[1])); } \
      resc = false; \
      if (__builtin_expect(__any(rm > (float)THRL), 0)) { const float dl = __builtin_fmaxf(rm, 0.f); mhat += dl; \
        _Pragma("unroll") for (int r = 0; r < 16; ++r) { C0[r] -= dl; C1[r] -= dl; } \
        _Pragma("unroll") for (int r = 0; r < 16; ++r) negm[r] = -mhat; asm volatile("" : "+v"(negm)); \
        const float f = __builtin_amdgcn_exp2f(-dl); l_reg *= f; if (hi == 0) wsf[r32] = f; resc = true; } } \
    SBAR(); \
    GAPB(o[0] = __builtin_amdgcn_mfma_f32_32x32x16_bf16(PAF(0), VFR(0), o[0], 0, 0, 0), C0, 0); \
    GAPB(o[1] = __builtin_amdgcn_mfma_f32_32x32x16_bf16(PAF(0), VFR(4), o[1], 0, 0, 0), C0, 4); \
    KRD(GL, 0); GAPB(o[0] = __builtin_amdgcn_mfma_f32_32x32x16_bf16(PAF(1), VFR(1), o[0], 0, 0, 0), C0, 8); \
    KRD(GL, 1); GAPB(o[1] = __builtin_amdgcn_mfma_f32_32x32x16_bf16(PAF(1), VFR(5), o[1], 0, 0, 0), C0, 12); \
    KRD(GL, 2); GAPB(o[0] = __builtin_amdgcn_mfma_f32_32x32x16_bf16(PAF(2), VFR(2), o[0], 0, 0, 0), C1, 0); \
    KRD(GL, 3); GAPB(o[1] = __builtin_amdgcn_mfma_f32_32x32x16_bf16(PAF(2), VFR(6), o[1], 0, 0, 0), C1, 4); \
    GAPB(o[0] = __builtin_amdgcn_mfma_f32_32x32x16_bf16(PAF(3), VFR(3), o[0], 0, 0, 0), C1, 8); \
    GAPB(o[1] = __builtin_amdgcn_mfma_f32_32x32x16_bf16(PAF(3), VFR(7), o[1], 0, 0, 0), C1, 12); \
    } while (0)
  int t = 1;
  #undef CMASK
  #define CMASK(P0, P1, t) do {} while (0)
  for (; t + 5 < NT; t += 2) {
    STEP(pB0, pB1, pA0, pA1, t, true, true, true);     WAIT_BAR(2); RESC(); ROT();
    STEP(pA0, pA1, pB0, pB1, t + 1, true, true, true);   WAIT_BAR(2); RESC(); ROT();
  }
  #undef CMASK
  #define CMASK(P0, P1, t) do { int jb_ = (t) - (NT - 4); if (jb_ >= 0) cmask(P0, P1, jb_, qrel, hi); } while (0)
  #define ENDW(tt) do { if ((tt) + 3 < NT) { WAIT_BAR(2); } else if ((tt) + 2 < NT) { WAIT_BAR(1); } else { WAIT_BAR(0); } } while (0)
  for (; t + 1 < NT; t += 2) {
    STEP(pB0, pB1, pA0, pA1, t, (t + 3 < NT), (t + 1 < NT), (t + 1 < NT));       ENDW(t);   RESC(); ROT();
    STEP(pA0, pA1, pB0, pB1, t + 1, (t + 4 < NT), (t + 2 < NT), (t + 2 < NT));     ENDW(t + 1); RESC(); ROT();
  }
  STEP(pB0, pB1, pA0, pA1, NT - 1, false, false, false); RESC();
  { float sacc = pB0[0] + pB0[1]; _Pragma("unroll") for (int r = 2; r < 16; ++r) sacc += pB0[r]; _Pragma("unroll") for (int r = 0; r < 16; ++r) sacc += pB1[r]; l_reg += sacc;
    pw0 = (u32x4){PKW(pB0, 0), PKW(pB0, 2), PKW(pB0, 4), PKW(pB0, 6)}; pw1 = (u32x4){PKW(pB0, 8), PKW(pB0, 10), PKW(pB0, 12), PKW(pB0, 14)}; pw2 = (u32x4){PKW(pB1, 0), PKW(pB1, 2), PKW(pB1, 4), PKW(pB1, 6)}; pw3 = (u32x4){PKW(pB1, 8), PKW(pB1, 10), PKW(pB1, 12), PKW(pB1, 14)};
    SBAR(); pv(o, vb0 + sl_cur, PAF(0), PAF(1), PAF(2), PAF(3)); }
  #undef PKW
  #undef PAF
  #undef VFR
  #undef PIN
  #undef MX3
  #undef GAPA
  #undef GAPB
  #undef EX
  #undef VRD
  #undef KRD
  #undef STEP
  #undef ENDW
  { auto rr = __builtin_amdgcn_permlane32_swap(__float_as_uint(l_reg), __float_as_uint(l_reg), false, false); l_reg = __uint_as_float(rr[0]) + __uint_as_float(rr[1]); }
  if (hi == 0) wsf[32 + r32] = l_reg; asm volatile("s_waitcnt lgkmcnt(0)" ::: "memory");
  float rli[16];
  #pragma unroll
  for (int r = 0; r < 16; ++r) rli[r] = __builtin_amdgcn_rcpf(wsf[32 + crow(r, hi)]);
  bf16* Ow = O + (rowbase + q0 + wid * QBLK) * OPITCH + ocol;
  { bf16* stg = (bf16*)(shm + LDS_OST) + wid * 2048;
    #pragma unroll
    for (int r = 0; r < 16; ++r) { const int orow = crow(r, hi);
      #pragma unroll
      for (int d0 = 0; d0 < 2; ++d0) stg[orow * 64 + d0 * 32 + r32] = __float2bfloat16(o[d0][r] * rli[r]); }
    asm volatile("s_waitcnt lgkmcnt(0)" ::: "memory");
    #pragma unroll
    for (int i = 0; i < 4; ++i) { const int row = i * 8 + (lane >> 3), ch = lane & 7; const u32x4 v = *(const u32x4*)(stg + row * 64 + ch * 8); ATTN_STORE16(Ow + (long)row * OPITCH + ch * 8, v); } }
  asm volatile("s_waitcnt lgkmcnt(0)\n\ts_barrier" ::: "memory");
  #undef DMA_K
  #undef DMA_V
  #undef CMASK
  #undef START
  #undef RESC
  #undef ROT
}
constexpr int PS_QB = 128, PS_LK = 0, PS_LV = 3 * 8192, PS_VSLOT = 16384, PS_LP = PS_LV + 4 * PS_VSLOT, PS_PSLOT = 16384, PS_LF = PS_LP + 2 * PS_PSLOT, PS_BYTES = PS_LF + 4 * 512;
#define WAIT_BAR(N) asm volatile("s_waitcnt vmcnt(" #N ") lgkmcnt(0)\n\ts_barrier" ::: "memory")
#define SBAR() __builtin_amdgcn_sched_barrier(0)
template<int THRL, int MODE> __device__ __forceinline__ void attn_unit_ps(int b, int qcol, int vcol, int ocol, int qb, const bf16* Q, const bf16* __restrict__ K, const bf16* __restrict__ V, bf16* O, char* shm, const int wave_s, f32x16 (&keep)[4], const float lam) {
  int tid = tid_of(wave_s); asm volatile("" : "+v"(tid)); const int lane = tid & 63, r32 = lane & 31, hi = lane >> 5; const int wid = __builtin_amdgcn_readfirstlane(tid >> 6);
  const int role = wid >> 2, w = wid & 3;
  const long rowbase = (long)b * SEQ; const int q0 = qb * PS_QB;
  const bf16* Kh = K + rowbase * DM + qcol, *Vh = V + rowbase * DM + vcol;
  const unsigned lds0 = (unsigned)(uintptr_t)shm;
  const lds_cptr shm3 = (lds_cptr)shm;
  const bf16* ksrc = Kh + (long)lane * DM + wid * 8;
  const bf16* vsrc0 = Vh + (long)(16 * (wid & 3) + (lane >> 2)) * DM + (wid >> 2) * 32 + (lane & 3) * 8;
  const unsigned kdst = lds0 + PS_LK + wid * 1024, vdst = lds0 + PS_LV + wid * 1024;
  #define DMA_K(t, slot) glds16(ksrc + (long)(t) * KVBLK * DM, (unsigned)__builtin_amdgcn_readfirstlane(kdst + (slot)))
  #define DMA_V(t, slot) do { glds16(vsrc0 + (long)(t) * KVBLK * DM, (unsigned)__builtin_amdgcn_readfirstlane(vdst + (slot))); glds16(vsrc0 + (long)(t) * KVBLK * DM + 64, (unsigned)__builtin_amdgcn_readfirstlane(vdst + (slot) + 8192)); } while (0)
  const int NT = (q0 + PS_QB) / KVBLK;
  int ks_prev = 0, ks_cur = 0, ks_next = 8192;
  #define KROT() do { ks_prev = ks_cur; ks_cur = ks_next; ks_next = (ks_next == 2 * 8192) ? 0 : ks_next + 8192; } while (0)
  #define VSL(t) ((((t)) & 3) * PS_VSLOT)
  LAS float* fw = (LAS float*)((LAS char*)shm3 + PS_LF + w * 512);
  LAS unsigned* flagw = (LAS unsigned*)((LAS char*)shm3 + PS_LF + w * 512 + 256);
  const lds_cptr vfrag0 = shm3 + PS_LV + ((lane >> 4) & 1) * 32 + (lane & 3) * 8 + (4 * hi + ((lane & 15) >> 2)) * 64;
  LAS char* pbase = (LAS char*)shm3 + PS_LP + w * 4096 + lane * 16;
  DMA_K(0, 0); DMA_V(0, VSL(0)); DMA_K(1, 8192);
  if (role == 0) {
    const bf16* Qw = Q + (rowbase + q0 + w * QBLK) * DM + qcol;
    const lds_cptr kp0 = shm3 + PS_LK + hi * 1024 + r32 * 16;
    const char* Kbase = shm + PS_LK; bf16x8 kf[8];
    bf16x8 qr[4];
    #pragma unroll
    for (int d0 = 0; d0 < 4; ++d0) qr[d0] = *reinterpret_cast<const bf16x8*>(&Qw[(long)r32 * DM + d0 * 16 + hi * 8]);
    float mhat = 0.f, l_reg = 0.f; f32x16 negm = f32x16{}; asm volatile("" : "+v"(negm));
    const int qrel = w * QBLK + r32;
    #define CMASK(P0, P1, t) do { int jb_ = (t) - (NT - 2); if (jb_ >= 0) cmask(P0, P1, jb_, qrel, hi); } while (0)
    bool resc = false;
    #define START(P0, P1) do { const float rm = rowmax(P0, P1); resc = false; \
      { const float dl = rm; mhat = fadd_s(mhat, dl); \
        _Pragma("unroll") for (int r = 0; r < 16; ++r) { P0[r] = fsub_s(P0[r], dl); P1[r] = fsub_s(P1[r], dl); } \
        _Pragma("unroll") for (int r = 0; r < 16; ++r) negm[r] = -mhat; asm volatile("" : "+v"(negm)); } \
      _Pragma("unroll") for (int r = 0; r < 16; ++r) P0[r] = __builtin_amdgcn_exp2f(P0[r]); } while (0)
    #define RESC(par) do {} while (0)
    f32x16 pA0, pA1, pB0, pB1;
    DMA_K(2, 2 * 8192);
    WAIT_BAR(4);
    qkt(pA0, pA1, Kbase, qr, negm, r32, hi); asm volatile("s_nop 15\n\ts_nop 7" : "+v"(pA0), "+v"(pA1)); CMASK(pA0, pA1, 0);
    START(pA0, pA1);
    _Pragma("unroll") for (int r = 0; r < 16; ++r) pA1[r] = __builtin_amdgcn_exp2f(pA1[r]);
    WAIT_BAR(0);
    DMA_K(3, 0); DMA_V(1, VSL(1));
    KROT();
    kload8(kf, kp0 + ks_cur);
    WAIT_BAR(3);
    u32x4 pw0, pw1, pw2, pw3;
    #define PKW(P, B) cvtpk_s(P[B], P[B + 1])
    #define PAF(k) __builtin_bit_cast(bf16x8, pw##k)
    #define VFR(i) (bf16x8){vlo[i][0], vlo[i][1], vlo[i][2], vlo[i][3], vhi[i][0], vhi[i][1], vhi[i][2], vhi[i][3]}
    #define PIN(x) asm volatile("" : "+v"(x))
    #define MX3(a, b, c) __builtin_fmaxf(__builtin_fmaxf((a), (b)), (c))
    #define GAPA(MF, A0, A1, A2, A3, W0, W1, PW) do { MF; sacc += A0; sacc += A1; sacc += A2; sacc += A3; PIN(sacc); W0; W1; PIN(PW); SBAR(); } while (0)
    #define EX(v) __builtin_amdgcn_exp2f(v)
    #define GAPB(X, B) do { X[B] = EX(X[B]); X[B + 1] = EX(X[B + 1]); X[B + 2] = EX(X[B + 2]); X[B + 3] = EX(X[B + 3]); PIN(X); SBAR(); } while (0)
    #define VRD(i) do {} while (0)
    #define KRD(j) do { kload2(kf, kp0 + ks_next, j); SBAR(); } while (0)
    #define PUB(k) (*(LAS u32x4*)(pp_ + (k) * 1024) = pw##k)
    #define STEP(C0, C1, P0, P1, t) do { SBAR(); \
      LAS char* pp_ = pbase + ((t) & 1) * PS_PSLOT; \
      VRD(0); SBAR(); float sacc = (P0[0] + P0[1]); \
      GAPA(C0 = __builtin_amdgcn_mfma_f32_32x32x16_bf16(kf[0], qr[0], negm, 0, 0, 0), P0[2], P0[3], P0[4], P0[5],     pw0[0] = PKW(P0, 0), pw0[1] = PKW(P0, 2), pw0); \
      VRD(4); SBAR(); GAPA(C1 = __builtin_amdgcn_mfma_f32_32x32x16_bf16(kf[1], qr[0], negm, 0, 0, 0), P0[6], P0[7], P0[8], P0[9],     pw0[2] = PKW(P0, 4), pw0[3] = PKW(P0, 6), pw0); \
      PUB(0); VRD(1); SBAR(); GAPA(C0 = __builtin_amdgcn_mfma_f32_32x32x16_bf16(kf[2], qr[1], C0, 0, 0, 0),   P0[10], P0[11], P0[12], P0[13], pw1[0] = PKW(P0, 8), pw1[1] = PKW(P0, 10), pw1); \
      VRD(5); SBAR(); GAPA(C1 = __builtin_amdgcn_mfma_f32_32x32x16_bf16(kf[3], qr[1], C1, 0, 0, 0),   P0[14], P0[15], P1[0], P1[1],   pw1[2] = PKW(P0, 12), pw1[3] = PKW(P0, 14), pw1); \
      PUB(1); VRD(2); SBAR(); GAPA(C0 = __builtin_amdgcn_mfma_f32_32x32x16_bf16(kf[4], qr[2], C0, 0, 0, 0),   P1[2], P1[3], P1[4], P1[5],     pw2[0] = PKW(P1, 0), pw2[1] = PKW(P1, 2), pw2); \
      VRD(6); SBAR(); GAPA(C1 = __builtin_amdgcn_mfma_f32_32x32x16_bf16(kf[5], qr[2], C1, 0, 0, 0),   P1[6], P1[7], P1[8], P1[9],     pw2[2] = PKW(P1, 4), pw2[3] = PKW(P1, 6), pw2); \
      PUB(2); VRD(3); SBAR(); GAPA(C0 = __builtin_amdgcn_mfma_f32_32x32x16_bf16(kf[6], qr[3], C0, 0, 0, 0),   P1[10], P1[11], P1[12], P1[13], pw3[0] = PKW(P1, 8), pw3[1] = PKW(P1, 10), pw3); \
      VRD(7); SBAR(); GAPA(C1 = __builtin_amdgcn_mfma_f32_32x32x16_bf16(kf[7], qr[3], C1, 0, 0, 0),   P1[14], P1[15], 0.f, 0.f,       pw3[2] = PKW(P1, 12), pw3[3] = PKW(P1, 14), pw3); \
      PUB(3); l_reg += sacc; \
      DMA_K((t) + 3, ks_cur); DMA_V((t) + 1, VSL((t) + 1)); \
      CMASK(C0, C1, t); \
      { float a = MX3(C0[0], C0[1], C1[0]), b_ = MX3(C0[2], C0[3], C1[1]); a = MX3(a, C1[2], C1[3]); \
        _Pragma("unroll") for (int r = 4; r < 16; r += 4) { a = MX3(a, C0[r], C0[r + 1]); b_ = MX3(b_, C0[r + 2], C0[r + 3]); a = MX3(a, C1[r], C1[r + 1]); b_ = MX3(b_, C1[r + 2], C1[r + 3]); } \
        float rm = __builtin_fmaxf(a, b_); { auto rr = __builtin_amdgcn_permlane32_swap(__float_as_uint(rm), __float_as_uint(rm), false, false); rm = __builtin_fmaxf(__uint_as_float(rr[0]), __uint_as_float(rr[1])); } \
        resc = false; \
        if (__builtin_expect(__any(rm > (float)THRL), 0)) { const float dl = __builtin_fmaxf(rm, 0.f); mhat += dl; \
          _Pragma("unroll") for (int r = 0; r < 16; ++r) { C0[r] -= dl; C1[r] -= dl; } \
          _Pragma("unroll") for (int r = 0; r < 16; ++r) negm[r] = -mhat; asm volatile("" : "+v"(negm)); \
          const float f = __builtin_amdgcn_exp2f(-dl); l_reg *= f; if (hi == 0) fw[((t) & 1) * 32 + r32] = f; resc = true; } \
        if (lane == 0) flagw[(t) & 1] = resc ? 1u : 0u; } \
      SBAR(); \
      GAPB(C0, 0); GAPB(C0, 4); KRD(0); GAPB(C0, 8); KRD(1); GAPB(C0, 12); KRD(2); GAPB(C1, 0); KRD(3); GAPB(C1, 4); GAPB(C1, 8); GAPB(C1, 12); \
      } while (0)
    int t = 1;
    #undef CMASK
    #define CMASK(P0, P1, t) do {} while (0)
    for (; t + 3 < NT; t += 2) {
      STEP(pB0, pB1, pA0, pA1, t);       WAIT_BAR(3); RESC(t & 1); KROT();
      STEP(pA0, pA1, pB0, pB1, t + 1);   WAIT_BAR(3); RESC((t + 1) & 1); KROT();
    }
    #undef CMASK
    #define CMASK(P0, P1, t) do { int jb_ = (t) - (NT - 2); if (jb_ >= 0) cmask(P0, P1, jb_, qrel, hi); } while (0)
    if (t + 1 < NT) {
      STEP(pB0, pB1, pA0, pA1, t);       WAIT_BAR(3); RESC(t & 1); KROT();
      STEP(pA0, pA1, pB0, pB1, t + 1);   WAIT_BAR(3); RESC((t + 1) & 1); KROT();
      t += 2;
    }
    STEP(pB0, pB1, pA0, pA1, NT - 1);    WAIT_BAR(3); RESC((NT - 1) & 1);
    { float sacc = pB0[0] + pB0[1]; _Pragma("unroll") for (int r = 2; r < 16; ++r) sacc += pB0[r]; _Pragma("unroll") for (int r = 0; r < 16; ++r) sacc += pB1[r]; l_reg += sacc;
      pw0 = (u32x4){PKW(pB0, 0), PKW(pB0, 2), PKW(pB0, 4), PKW(pB0, 6)}; pw1 = (u32x4){PKW(pB0, 8), PKW(pB0, 10), PKW(pB0, 12), PKW(pB0, 14)}; pw2 = (u32x4){PKW(pB1, 0), PKW(pB1, 2), PKW(pB1, 4), PKW(pB1, 6)}; pw3 = (u32x4){PKW(pB1, 8), PKW(pB1, 10), PKW(pB1, 12), PKW(pB1, 14)};
      LAS char* pp_ = pbase + (NT & 1) * PS_PSLOT; PUB(0); PUB(1); PUB(2); PUB(3);
      { auto rr = __builtin_amdgcn_permlane32_swap(__float_as_uint(l_reg), __float_as_uint(l_reg), false, false); l_reg = __uint_as_float(rr[0]) + __uint_as_float(rr[1]); }
      if (hi == 0) fw[80 + r32] = l_reg;
      }
    asm volatile("s_waitcnt vmcnt(0) lgkmcnt(0)\n\ts_barrier" ::: "memory");
    #undef PKW
    #undef PAF
    #undef VFR
    #undef MX3
    #undef GAPA
    #undef GAPB
    #undef EX
    #undef VRD
    #undef KRD
    #undef PUB
    #undef STEP
    #undef CMASK
    #undef START
    #undef RESC
    asm volatile("s_barrier" ::: "memory");
  } else {
    f32x16 o[4]; o[0] = f32x16{}; o[1] = f32x16{}; o[2] = f32x16{}; o[3] = f32x16{};
    DMA_K(2, 2 * 8192);
    WAIT_BAR(4);
    WAIT_BAR(0);
    DMA_K(3, 0); DMA_V(1, VSL(1));
    KROT();
    WAIT_BAR(3);
    #define VPV(tt) do { const LAS char* pp_ = pbase + (((tt) + 1) & 1) * PS_PSLOT; \
        const bf16x8 pa0 = __builtin_bit_cast(bf16x8, *(const LAS u32x4*)(pp_)), pa1 = __builtin_bit_cast(bf16x8, *(const LAS u32x4*)(pp_ + 1024)), pa2 = __builtin_bit_cast(bf16x8, *(const LAS u32x4*)(pp_ + 2048)), pa3 = __builtin_bit_cast(bf16x8, *(const LAS u32x4*)(pp_ + 3072)); \
        _Pragma("unroll") for (int hf = 0; hf < 2; ++hf) { const lds_cptr vp_ = vfrag0 + hf * 8192 + VSL(tt); s16x4 vl[8], vh[8]; \
          _Pragma("unroll") for (int i = 0; i < 8; ++i) { vl[i] = vtr(vp_ + ((i >> 2) * 4096 + (i & 3) * 1024)); vh[i] = vtr(vp_ + ((i >> 2) * 4096 + (i & 3) * 1024 + 512)); } \
          _Pragma("unroll") for (int i = 0; i < 4; ++i) { const bf16x8 pa = i == 0 ? pa0 : i == 1 ? pa1 : i == 2 ? pa2 : pa3; \
            o[2 * hf] = __builtin_amdgcn_mfma_f32_32x32x16_bf16(pa, (bf16x8){vl[i][0], vl[i][1], vl[i][2], vl[i][3], vh[i][0], vh[i][1], vh[i][2], vh[i][3]}, o[2 * hf], 0, 0, 0); \
            o[2 * hf + 1] = __builtin_amdgcn_mfma_f32_32x32x16_bf16(pa, (bf16x8){vl[i + 4][0], vl[i + 4][1], vl[i + 4][2], vl[i + 4][3], vh[i + 4][0], vh[i + 4][1], vh[i + 4][2], vh[i + 4][3]}, o[2 * hf + 1], 0, 0, 0); } } } while (0)
    #define VRESC(s) do { if (__builtin_amdgcn_readfirstlane(flagw[(s) & 1]) != 0u) { \
        _Pragma("unroll") for (int d_ = 0; d_ < 4; ++d_) _Pragma("unroll") for (int r = 0; r < 16; ++r) o[d_][r] *= fw[((s) & 1) * 32 + crow(r, hi)]; } } while (0)
    for (int t = 1; t < NT; ++t) {
      DMA_K(t + 3, ks_cur); DMA_V(t + 1, VSL(t + 1));
      if (t >= 2) { VPV(t - 2); VRESC(t - 1); }
      WAIT_BAR(3); KROT();
    }
    VPV(NT - 2); VRESC(NT - 1);
    asm volatile("s_waitcnt vmcnt(0) lgkmcnt(0)\n\ts_barrier" ::: "memory");
    VPV(NT - 1);
    asm volatile("s_waitcnt lgkmcnt(0)\n\ts_barrier" ::: "memory");
    #undef VPV
    #undef VRESC
    float rli[16];
    #pragma unroll
    for (int r = 0; r < 16; ++r) rli[r] = __builtin_amdgcn_rcpf(fw[80 + crow(r, hi)]);
    if constexpr (MODE == 0) {
      #pragma unroll
      for (int d0 = 0; d0 < 4; ++d0)
        #pragma unroll
        for (int r = 0; r < 16; ++r) keep[d0][r] = o[d0][r] * rli[r];
    } else {
      bf16* Ow = O + (rowbase + q0 + w * QBLK) * DM + ocol;
      bf16* stg = (bf16*)(shm + PS_LP) + w * 4096;
      #pragma unroll
      for (int r = 0; r < 16; ++r) { const int orow = crow(r, hi); float dv[4]; float ss = 0.f;
        #pragma unroll
        for (int d0 = 0; d0 < 4; ++d0) { dv[d0] = keep[d0][r] - lam * (o[d0][r] * rli[r]); ss += dv[d0] * dv[d0]; }
        ss += swz_xor<1>(ss); ss += swz_xor<2>(ss); ss += swz_xor<4>(ss); ss += swz_xor<8>(ss); ss += swz_xor<16>(ss);
        const float rstd = __builtin_amdgcn_rsqf(ss * (1.f / 128.f) + SUBLN_EPS);
        #pragma unroll
        for (int d0 = 0; d0 < 4; ++d0) stg[orow * 128 + d0 * 32 + r32] = __float2bfloat16(dv[d0] * rstd); }
      asm volatile("s_waitcnt lgkmcnt(0)" ::: "memory");
      #pragma unroll
      for (int i = 0; i < 8; ++i) { const int row = i * 4 + (lane >> 4), ch = lane & 15; const u32x4 v = *(const u32x4*)(stg + row * 128 + ch * 8); *(u32x4*)(Ow + (long)row * DM + ch * 8) = v; }
    }
  }
  asm volatile("s_waitcnt lgkmcnt(0)\n\ts_barrier" ::: "memory");
  #undef DMA_K
  #undef DMA_V
  #undef KROT
  #undef VSL
  #undef PIN
}
#undef SBAR
#undef WAIT_BAR
constexpr int ATTN_LDS_BYTES = LDS_BYTES;
static_assert(PS_BYTES <= 131072, "P-sharing attention LDS");

#undef SBAR
#undef WAIT_BAR
}

constexpr size_t MiB = 1u << 20;
constexpr size_t WS_CTL = 0, CTL_ZERO_BYTES = 1 * MiB;
constexpr size_t WS_ROPE = 1 * MiB;
constexpr size_t WS_MISC = 2 * MiB;
constexpr size_t WS_WA = 8 * MiB;
constexpr size_t WS_WB = 36 * MiB;
constexpr size_t WS_XN = 214 * MiB;
constexpr size_t WS_P16 = 342 * MiB;
constexpr size_t WS_PROJ = 374 * MiB;
constexpr size_t WS_R = 502 * MiB;
constexpr size_t WS_HB0 = 1142 * MiB;
constexpr size_t WS_SSP0 = 1270 * MiB, WS_SSP1 = 1274 * MiB;
constexpr size_t WS_SCAN = 1278 * MiB;
constexpr size_t WS_END = 1296 * MiB;
constexpr size_t MS_SPL = 0;
constexpr size_t MS_BC = 64 * 1024;
constexpr size_t MS_TOPE = 128 * 1024;
constexpr size_t MS_TOPG = MS_TOPE + 512 * 1024;
constexpr size_t MS_RANK = MS_TOPG + 512 * 1024;
constexpr int SLOTS_PER_PASS = NTOK + NE * 256;
constexpr size_t MS_STOK = MS_RANK + 512 * 1024;
constexpr size_t MS_SGATE = MS_STOK + 2 * (size_t)SLOTS_PER_PASS * 4;
constexpr size_t MS_SRS = MS_SGATE + 2 * (size_t)SLOTS_PER_PASS * 4;
static_assert(MS_SRS + 2 * (size_t)SLOTS_PER_PASS * 4 <= 6 * MiB, "misc map");
constexpr size_t WA_QKV = 0, WA_O = 6 * MiB, WA_GU = 8 * MiB, WA_D = 19 * MiB, WA_PG = 25 * MiB, WA_PP = 27 * MiB;
constexpr size_t WB_IN = 0, WB_GT = 4 * MiB, WB_OUT = 5 * MiB, WB_PG = 7 * MiB, WB_PP = 9 * MiB, WB_MGU = 10 * MiB, WB_MD = 122 * MiB;
constexpr size_t R_Q = 0, R_K = 128 * MiB, R_V = 256 * MiB, R_O2 = 384 * MiB, R_OA = 384 * MiB, R_HID = 128 * MiB;
constexpr size_t R_XL = 0, R_Y = 128 * MiB, R_U = 256 * MiB, R_LA = 384 * MiB, R_BT = 512 * MiB, R_HY = 0, R_MHID = 0, R_MHID1 = 400 * MiB, R_H8 = 512 * MiB, R_H8B = 256 * MiB, R_XS8 = 256 * MiB;
constexpr int CW_TMO = 0, CW_BAR = 4096;

constexpr int RING_OFF = 0, RING_BYTES = 131072;
constexpr int LDSCTL_OFF = RING_BYTES, MISC_OFF = LDSCTL_OFF + 320;
constexpr int LDS_BYTES = 147456;
constexpr int MW_CNT = 16, MW_TST = 32;

#define XB_TMO      128
#define XB_XCNT(j)  (256  + 64 * (j))
#define XB_XSUB(j)  (1280 + 64 * (j))
#define XB_XGEN(j)  (2304 + 64 * (j))
#define XB_TOP      3328
#define XB_TOPGEN   3392
#define XCD_BAR_WORDS 3456
#define XB_SPIN_CAP (1u << 18)
__device__ __forceinline__ unsigned xb_ld(unsigned* p)              { return __hip_atomic_load(p, __ATOMIC_RELAXED, __HIP_MEMORY_SCOPE_AGENT); }
__device__ __forceinline__ unsigned xb_add(unsigned* p, unsigned v) { return __hip_atomic_fetch_add(p, v, __ATOMIC_RELAXED, __HIP_MEMORY_SCOPE_AGENT); }
__device__ __forceinline__ unsigned xb_xcc_id() { return (unsigned)__builtin_amdgcn_s_getreg((3 << 11) | 20) & 0xFu; }
#define XB_SPIN(cond, bar) do { unsigned _sp = 0; while (cond) { __builtin_amdgcn_s_sleep(1); \
    if ((++_sp & 255u) == 0u) { if (xb_ld(&(bar)[XB_TMO])) break; if (_sp > XB_SPIN_CAP) { atomicAdd(&(bar)[XB_TMO], 1u); break; } } } } while (0)
struct XcdBarrier { unsigned* bar; unsigned x; volatile LAS unsigned* st; };
__device__ __forceinline__ XcdBarrier xcd_barrier_post(unsigned* bar, volatile LAS unsigned* st, const int wave_s) {
    XcdBarrier b; b.bar = bar; b.x = xb_xcc_id(); b.st = st;
    if (tid_of(wave_s) == 0) (void)xb_add(&bar[XB_XCNT(b.x)], 1u);
    return b;
}
__device__ __forceinline__ void xcd_barrier_complete(unsigned* bar, unsigned x, unsigned& nloc, unsigned& nx) {
    const unsigned G = gridDim.x * gridDim.y * gridDim.z;
    unsigned sum, cnt, mine, sp = 0u;
    for (;;) {
        sum = 0u; cnt = 0u; mine = 0u;
#pragma unroll
        for (unsigned j = 0; j < 16; ++j) { const unsigned c = xb_ld(&bar[XB_XCNT(j)]); sum += c; cnt += (c > 0u) ? 1u : 0u; mine = (j == x) ? c : mine; }
        if (sum == G) break;
        __builtin_amdgcn_s_sleep(1);
        if ((++sp & 255u) == 0u) { if (xb_ld(&bar[XB_TMO])) break; if (sp > XB_SPIN_CAP) { atomicAdd(&bar[XB_TMO], 1u); break; } }
    }
    nloc = mine > 0u ? mine : 1u; nx = cnt > 0u ? cnt : 1u;
}
__device__ __forceinline__ void xcd_barrier(const XcdBarrier& b, const int wave_s) {
    asm volatile("s_waitcnt vmcnt(0)" ::: "memory");
    __syncthreads();
    if (tid_of(wave_s) == 0) {
        unsigned* bar = b.bar;
        __builtin_amdgcn_s_waitcnt(0);
        unsigned nloc = b.st[0], nx = b.st[1];
        if (nloc == 0u) { xcd_barrier_complete(bar, b.x, nloc, nx); b.st[0] = nloc; b.st[1] = nx; }
        const unsigned old = xb_add(&bar[XB_XSUB(b.x)], 1u);
        const unsigned gen = old / nloc;
        if (old + 1u == (gen + 1u) * nloc) {
            __builtin_amdgcn_fence(__ATOMIC_RELEASE, "agent");
            asm volatile("s_waitcnt vmcnt(0)" ::: "memory");
            const unsigned og = xb_add(&bar[XB_TOP], 1u);
            const unsigned tg = og / nx;
            if (og + 1u == (tg + 1u) * nx) xb_add(&bar[XB_TOPGEN], 1u);
            else XB_SPIN(xb_ld(&bar[XB_TOPGEN]) == tg, bar);
            __builtin_amdgcn_fence(__ATOMIC_ACQUIRE, "agent");
            xb_add(&bar[XB_XGEN(b.x)], 1u);
            asm volatile("s_waitcnt vmcnt(0)" ::: "memory");
        } else {
            XB_SPIN(xb_ld(&bar[XB_XGEN(b.x)]) == gen, bar);
            __builtin_amdgcn_fence(__ATOMIC_ACQUIRE, "agent");
            asm volatile("s_waitcnt vmcnt(0)" ::: "memory");
        }
    }
    __syncthreads();
}

#define LDS_WAIT() asm volatile("s_waitcnt lgkmcnt(0)" ::: "memory")
__device__ __forceinline__ float wave_sum(float v) {
    v += swz_xor<1>(v); v += swz_xor<2>(v); v += swz_xor<4>(v); v += swz_xor<8>(v); v += swz_xor<16>(v);
    return add_x32(v);
}
__device__ __forceinline__ void tr_item(const float* W, int ldsrc, int k0, int nsrc0, bf16_t* WT, int ldd, int vrow0, int dk0, const float* gain, float gscale, LAS float* scr, int lane) {
#pragma unroll 16
    for (int i = 0; i < 32; ++i) { const int kk = 2 * i + (lane >> 5); float v = W[(size_t)(k0 + kk) * ldsrc + nsrc0 + (lane & 31)]; if (gain) v *= gain[k0 + kk] * gscale; scr[kk * 33 + (lane & 31)] = v; }
    LDS_WAIT(); asm volatile("" ::: "memory");
    const int c = lane & 7;
#pragma unroll
    for (int j = 0; j < 4; ++j) { const int n = (lane >> 3) + 8 * j; const LAS float* s = scr + (8 * c) * 33 + n;
        u32x4 o; o.x = cvt_pk_bf16(s[0 * 33], s[1 * 33]); o.y = cvt_pk_bf16(s[2 * 33], s[3 * 33]); o.z = cvt_pk_bf16(s[4 * 33], s[5 * 33]); o.w = cvt_pk_bf16(s[6 * 33], s[7 * 33]);
        *(GAS u32x4*)(WT + (size_t)(vrow0 + n) * ldd + dk0 + 8 * c) = o; }
    LDS_WAIT(); asm volatile("" ::: "memory");
}

__device__ __forceinline__ void tr_item_fp8(const float* W, int ldsrc, int k0, int nsrc0, unsigned char* WT8, int ldd8, int vrow0, int dk0, const float* gain, float gscale, LAS float* scr, int lane) {
#pragma unroll 16
    for (int i = 0; i < 32; ++i) { const int kk = 2 * i + (lane >> 5); float v = W[(size_t)(k0 + kk) * ldsrc + nsrc0 + (lane & 31)]; v *= gain ? gain[k0 + kk] * gscale : gscale; scr[kk * 33 + (lane & 31)] = v; }
    LDS_WAIT(); asm volatile("" ::: "memory");
    const int c = lane & 7;
#pragma unroll
    for (int j = 0; j < 4; ++j) { const int n = (lane >> 3) + 8 * j; const LAS float* s = scr + (8 * c) * 33 + n;
        u32x2 o; o.x = pk_fp8x4(s[0 * 33], s[1 * 33], s[2 * 33], s[3 * 33]); o.y = pk_fp8x4(s[4 * 33], s[5 * 33], s[6 * 33], s[7 * 33]);
        *(GAS u32x2*)(WT8 + (size_t)(vrow0 + n) * ldd8 + dk0 + 8 * c) = o; }
    LDS_WAIT(); asm volatile("" ::: "memory");
}

__device__ __forceinline__ void tr_item64(const float* W, int ldsrc, int k0, int nsrc0, bf16_t* WT, int ldd, int vrow0, int dk0, const float* gain, LAS unsigned* scr, int lane) {
    float v[64];
    const float* src = W + (size_t)k0 * ldsrc + nsrc0 + lane;
#pragma unroll
    for (int i = 0; i < 64; ++i) v[i] = src[(size_t)i * ldsrc];
    if (gain) {
#pragma unroll
        for (int i = 0; i < 64; ++i) v[i] *= gain[k0 + i]; }
#pragma unroll
    for (int kp = 0; kp < 32; ++kp) scr[kp * 65 + lane] = cvt_pk_bf16(v[2 * kp], v[2 * kp + 1]);
    LDS_WAIT(); asm volatile("" ::: "memory");
    const int c = lane & 7;
#pragma unroll
    for (int j = 0; j < 8; ++j) { const int n = (lane >> 3) + 8 * j; const LAS unsigned* s = scr + (4 * c) * 65 + n;
        u32x4 o; o.x = s[0]; o.y = s[65]; o.z = s[130]; o.w = s[195];
        *(GAS u32x4*)(WT + (size_t)(vrow0 + n) * ldd + dk0 + 8 * c) = o; }
    LDS_WAIT(); asm volatile("" ::: "memory");
}

__device__ __forceinline__ void tr_item64_fp8(const float* W, int ldsrc, int k0, int nsrc0, unsigned char* WT, int ldd8, int vrow0, int dk0, const float* gain, float sc, LAS unsigned* scr, int lane) {
    float v[64];
    const float* src = W + (size_t)k0 * ldsrc + nsrc0 + lane;
#pragma unroll
    for (int i = 0; i < 64; ++i) v[i] = src[(size_t)i * ldsrc];
#pragma unroll
    for (int i = 0; i < 64; ++i) v[i] *= gain ? gain[k0 + i] * sc : sc;
#pragma unroll
    for (int kq = 0; kq < 16; ++kq) scr[kq * 65 + lane] = pk_fp8x4(v[4 * kq], v[4 * kq + 1], v[4 * kq + 2], v[4 * kq + 3]);
    LDS_WAIT(); asm volatile("" ::: "memory");
    const int c = lane & 3;
#pragma unroll
    for (int j = 0; j < 4; ++j) { const int n = (lane >> 2) + 16 * j; const LAS unsigned* s = scr + (4 * c) * 65 + n;
        u32x4 o; o.x = s[0]; o.y = s[65]; o.z = s[130]; o.w = s[195];
        *(GAS u32x4*)(WT + (size_t)(vrow0 + n) * ldd8 + dk0 + 16 * c) = o; }
    LDS_WAIT(); asm volatile("" ::: "memory");
}

typedef f32x4 (&AccRef)[2][2][4][2];
#define EPI_FENCE() asm volatile("" ::: "memory")
__device__ __forceinline__ void load_rstd8(float (&rs)[2][4], const float* ssp, int row0, int fq) {
    f32x4 p[2][4];
#pragma unroll
    for (int ai = 0; ai < 2; ++ai)
#pragma unroll
        for (int m = 0; m < 4; ++m) p[ai][m] = *(const f32x4*)(ssp + (size_t)(row0 + ai * 128 + m * 16) * 16 + fq * 4);
#pragma unroll
    for (int ai = 0; ai < 2; ++ai)
#pragma unroll
        for (int m = 0; m < 4; ++m) { float s = (p[ai][m][0] + p[ai][m][1]) + (p[ai][m][2] + p[ai][m][3]); s += swz_xor<16>(s); s = add_x32(s); rs[ai][m] = __builtin_amdgcn_rsqf(s * (1.f / D) + NORM_EPS); }
}
#define EPI_PIN(ai) asm volatile("" : "+v"(acc[ai][0][0][0]), "+v"(acc[ai][0][0][1]), "+v"(acc[ai][0][1][0]), "+v"(acc[ai][0][1][1]), "+v"(acc[ai][0][2][0]), "+v"(acc[ai][0][2][1]), "+v"(acc[ai][0][3][0]), "+v"(acc[ai][0][3][1]), \
    "+v"(acc[ai][1][0][0]), "+v"(acc[ai][1][0][1]), "+v"(acc[ai][1][1][0]), "+v"(acc[ai][1][1][1]), "+v"(acc[ai][1][2][0]), "+v"(acc[ai][1][2][1]), "+v"(acc[ai][1][3][0]), "+v"(acc[ai][1][3][1]) :: "memory")
#define EPI_PIN2(ai, m0) asm volatile("" : "+v"(acc[ai][0][m0][0]), "+v"(acc[ai][0][m0][1]), "+v"(acc[ai][0][m0 + 1][0]), "+v"(acc[ai][0][m0 + 1][1]), "+v"(acc[ai][1][m0][0]), "+v"(acc[ai][1][m0][1]), "+v"(acc[ai][1][m0 + 1][0]), "+v"(acc[ai][1][m0 + 1][1]) :: "memory")
__device__ __forceinline__ int moe_expert(const volatile LAS unsigned* tst, int pm) { int e = 0;
#pragma unroll
    for (int q = 1; q < NE; ++q) e += (pm >= (int)tst[q]) ? 1 : 0; return e; }
__device__ __forceinline__ u32x4 pack8(const f32x4 a, const f32x4 b) { u32x4 w; w.x = cvt_pk_bf16(a[0], a[1]); w.y = cvt_pk_bf16(a[2], a[3]); w.z = cvt_pk_bf16(b[0], b[1]); w.w = cvt_pk_bf16(b[2], b[3]); return w; }
__device__ __forceinline__ float sumsq8(const f32x4 a, const f32x4 b) { return ((a[0] * a[0] + a[1] * a[1]) + (a[2] * a[2] + a[3] * a[3])) + ((b[0] * b[0] + b[1] * b[1]) + (b[2] * b[2] + b[3] * b[3])); }

struct EpiQKV {
    static constexpr bool PERM = true, IDEMP = false;
    bf16_t* Q; bf16_t* K; bf16_t* V; const float* ssp; float zs; int pad_;
    __device__ __forceinline__ void operator()(AccRef acc, const pg8::Unit& u, int wr, int wc, int fr, int fq) const {
        const int rl0 = wr * 64 + fr, row0 = u.pm * 256 + rl0; float rs8[2][4]; load_rstd8(rs8, ssp, row0, fq);
#pragma unroll
        for (int ai = 0; ai < 2; ++ai)
#pragma unroll
            for (int m = 0; m < 4; ++m) rs8[ai][m] *= zs;
        if (u.pn < 8) {
            bf16_t* base = (u.pn < 4) ? Q : K; const float sc0 = (u.pn < 4) ? C2 : 1.0f;
            const int col = ((u.pn & 3) * 4 + wc) * 64 + 8 * fq;
            float inv[8];
#pragma unroll
            for (int q = 0; q < 8; ++q) inv[q] = __builtin_amdgcn_exp2f(-0.41524101186092029f * (float)(8 * fq + q));
#pragma unroll
            for (int ai = 0; ai < 2; ++ai)
#pragma unroll
                for (int m = 0; m < 4; ++m) { const int row = row0 + ai * 128 + m * 16; const float pos = (float)(row & (SEQ - 1)); const float sc = sc0 * rs8[ai][m];
#pragma unroll
                    for (int n = 0; n < 2; ++n) { f32x4 c, s;
#pragma unroll
                        for (int e = 0; e < 4; ++e) { const float ang = pos * inv[4 * n + e]; const float rev = ang * 0.15915494309189535f; const float fr_ = rev - __builtin_rintf(rev);
                            c[e] = __builtin_amdgcn_cosf(fr_) * sc; s[e] = __builtin_amdgcn_sinf(fr_) * sc; }
                        const f32x4 l = acc[ai][0][m][n], h = acc[ai][1][m][n];
                        acc[ai][0][m][n] = l * c - h * s; acc[ai][1][m][n] = h * c + l * s; } }
#pragma unroll
            for (int ai = 0; ai < 2; ++ai)
#pragma unroll
                for (int m = 0; m < 4; ++m) { bf16_t* rp = base + (size_t)(row0 + ai * 128 + m * 16) * D + col;
                    *(u32x4*)rp = pack8(acc[ai][0][m][0], acc[ai][0][m][1]); *(u32x4*)(rp + 32) = pack8(acc[ai][1][m][0], acc[ai][1][m][1]); }
        } else {
            const int col = (u.pn - 8) * 256 + wc * 32 + 8 * fq;
#pragma unroll
            for (int ai = 0; ai < 2; ++ai)
#pragma unroll
                for (int m = 0; m < 4; ++m) { bf16_t* rp = V + (size_t)(row0 + ai * 128 + m * 16) * D + col; const float rs = rs8[ai][m];
#pragma unroll
                    for (int bj = 0; bj < 2; ++bj) *(u32x4*)(rp + bj * 128) = pack8(acc[ai][bj][m][0] * rs, acc[ai][bj][m][1] * rs); }
        }
    }
};
__device__ __forceinline__ void add_bf8(f32x4& a0, f32x4& a1, const u32x4 w, const float sc) {
    a0[0] = bf_lo(w.x) + a0[0] * sc; a0[1] = bf_hi(w.x) + a0[1] * sc; a0[2] = bf_lo(w.y) + a0[2] * sc; a0[3] = bf_hi(w.y) + a0[3] * sc;
    a1[0] = bf_lo(w.z) + a1[0] * sc; a1[1] = bf_hi(w.z) + a1[1] * sc; a1[2] = bf_lo(w.w) + a1[2] * sc; a1[3] = bf_hi(w.w) + a1[3] * sc; }
struct EpiRes {
    static constexpr bool PERM = true, IDEMP = false;
    const bf16_t* in; bf16_t* out; float* ssp; unsigned char* out8; float es; int pad_;
    __device__ __forceinline__ void operator()(AccRef acc, const pg8::Unit& u, int wr, int wc, int fr, int fq) const {
        const int row0 = u.pm * 256 + wr * 64 + fr, col0 = u.pn * 256 + wc * 32 + 8 * fq;
#pragma unroll
        for (int ai = 0; ai < 2; ++ai) { u32x4 w[4][2];
#pragma unroll
            for (int m = 0; m < 4; ++m)
#pragma unroll
                for (int bj = 0; bj < 2; ++bj) w[m][bj] = *(const u32x4*)(in + (size_t)(row0 + ai * 128 + m * 16) * D + col0 + bj * 128);
#pragma unroll
            for (int m = 0; m < 4; ++m)
#pragma unroll
                for (int bj = 0; bj < 2; ++bj) add_bf8(acc[ai][bj][m][0], acc[ai][bj][m][1], w[m][bj], es);
            EPI_PIN(ai); }
        EPI_FENCE();
#pragma unroll
        for (int ai = 0; ai < 2; ++ai)
#pragma unroll
            for (int m = 0; m < 4; ++m) { const int row = row0 + ai * 128 + m * 16; const size_t off = (size_t)row * D + col0; float s = 0.f;
#pragma unroll
                for (int bj = 0; bj < 2; ++bj) { const f32x4 x0 = acc[ai][bj][m][0], x1 = acc[ai][bj][m][1]; *(u32x4*)(out + off + bj * 128) = pack8(x0, x1); s += sumsq8(x0, x1);
                    if (out8) { u32x2 q; q.x = pk_fp8x4(x0[0], x0[1], x0[2], x0[3]); q.y = pk_fp8x4(x1[0], x1[1], x1[2], x1[3]); *(u32x2*)(out8 + off + bj * 128) = q; } }
                s += swz_xor<16>(s); s = add_x32(s);
                if (fq == 0) ssp[(size_t)row * 16 + u.pn * 4 + wc] = s; }
    }
};
struct EpiSwiGLU {
    static constexpr bool PERM = true, IDEMP = true;
    bf16_t* out; const float* ssp; const float* srs; int ldc; int f8; int f8o; int pad_;
    __device__ __forceinline__ void operator()(AccRef acc, const pg8::Unit& u, int wr, int wc, int fr, int fq) const {
        const int rl0 = wr * 64 + fr, row0 = u.pm * 256 + rl0, col0 = u.pn * 128 + wc * 32 + 8 * fq; float rs8[2][4];
        if (srs) {
#pragma unroll
            for (int ai = 0; ai < 2; ++ai)
#pragma unroll
                for (int m = 0; m < 4; ++m) rs8[ai][m] = srs[row0 + ai * 128 + m * 16];
        } else load_rstd8(rs8, ssp, row0, fq);
#pragma unroll
        for (int ai = 0; ai < 2; ++ai)
#pragma unroll
            for (int m = 0; m < 4; ++m) { f32x4 h[2]; const float rs = f8 ? rs8[ai][m] * (1.0f / W8_SCALE) : rs8[ai][m];
                const float c1 = -1.4426950408889634f * rs, c2 = f8o ? rs * rs * H8_SCALE : rs * rs;
#pragma unroll
                for (int n = 0; n < 2; ++n) { const f32x4 ag = acc[ai][0][m][n], au = acc[ai][1][m][n];
#pragma unroll
                    for (int e = 0; e < 4; ++e) h[n][e] = (ag[e] * au[e]) * c2 * __builtin_amdgcn_rcpf(1.0f + __builtin_amdgcn_exp2f(ag[e] * c1)); }
                if (f8o) { u32x2 q; q.x = pk_fp8x4_m3(h[0][0], h[0][1], h[0][2], h[0][3]); q.y = pk_fp8x4_m3(h[1][0], h[1][1], h[1][2], h[1][3]);
                    *(u32x2*)((unsigned char*)out + (size_t)(row0 + ai * 128 + m * 16) * ldc + col0) = q; }
                else *(u32x4*)(out + (size_t)(row0 + ai * 128 + m * 16) * ldc + col0) = pack8(h[0], h[1]); }
    }
};
struct EpiLruIn {
    static constexpr bool PERM = true, IDEMP = true;
    bf16_t* XL; bf16_t* Y; const float* ssp;
    __device__ __forceinline__ void operator()(AccRef acc, const pg8::Unit& u, int wr, int wc, int fr, int fq) const {
        const int rl0 = wr * 64 + fr, row0 = u.pm * 256 + rl0, col0 = (u.pn & 3) * 256 + wc * 32 + 8 * fq; const bool isy = u.pn >= 4; bf16_t* base = isy ? Y : XL; float rs8[2][4]; load_rstd8(rs8, ssp, row0, fq);
#pragma unroll
        for (int ai = 0; ai < 2; ++ai)
#pragma unroll
            for (int m = 0; m < 4; ++m) { bf16_t* rp = base + (size_t)(row0 + ai * 128 + m * 16) * D + col0; const float rs = rs8[ai][m];
#pragma unroll
                for (int bj = 0; bj < 2; ++bj) { f32x4 v[2] = {acc[ai][bj][m][0] * rs, acc[ai][bj][m][1] * rs};
                    if (isy) {
#pragma unroll
                        for (int n = 0; n < 2; ++n)
#pragma unroll
                            for (int e = 0; e < 4; ++e) { const float x = v[n][e]; const float z = 0.7978845608028654f * (x + 0.044715f * x * x * x); v[n][e] = x * fast_sigmoid(2.0f * z); } }
                    *(u32x4*)(rp + bj * 128) = pack8(v[0], v[1]); } }
    }
};
struct EpiGates {
    static constexpr bool PERM = true, IDEMP = false;
    const bf16_t* U; const float* ba; const float* bx; const float* spl; bf16_t* LA; bf16_t* BT;
    __device__ __forceinline__ void operator()(AccRef acc, const pg8::Unit& u, int wr, int wc, int fr, int fq) const {
        const int row0 = u.pm * 256 + wr * 64 + fr, ch0 = u.pn * 128 + wc * 32 + 8 * fq;
        f32x4 vba[2], vbx[2], vsp[2]; u32x4 uu[2][4];
#pragma unroll
        for (int n = 0; n < 2; ++n) { vba[n] = *(const f32x4*)(ba + ch0 + 4 * n); vbx[n] = *(const f32x4*)(bx + ch0 + 4 * n); vsp[n] = *(const f32x4*)(spl + ch0 + 4 * n); }
#pragma unroll
        for (int ai = 0; ai < 2; ++ai)
#pragma unroll
            for (int m = 0; m < 4; ++m) uu[ai][m] = *(const u32x4*)(U + (size_t)(row0 + ai * 128 + m * 16) * D + ch0);
#pragma unroll
        for (int ai = 0; ai < 2; ++ai)
#pragma unroll
            for (int m = 0; m < 4; ++m) { const u32x4 q = uu[ai][m];
                const float uf[8] = {bf_lo(q.x), bf_hi(q.x), bf_lo(q.y), bf_hi(q.y), bf_lo(q.z), bf_hi(q.z), bf_lo(q.w), bf_hi(q.w)};
#pragma unroll
                for (int n = 0; n < 2; ++n)
#pragma unroll
                    for (int e = 0; e < 4; ++e) { const float r = fast_sigmoid(acc[ai][0][m][n][e] + vba[n][e]), ig = fast_sigmoid(acc[ai][1][m][n][e] + vbx[n][e]);
                        const float l = -8.0f * r * vsp[n][e]; const float a2 = __builtin_amdgcn_exp2f(2.8853900817779268f * l);
                        acc[ai][0][m][n][e] = l; acc[ai][1][m][n][e] = __builtin_sqrtf(fmaxf(1.0f - a2, 0.f)) * ig * uf[4 * n + e]; } }
        EPI_FENCE();
#pragma unroll
        for (int ai = 0; ai < 2; ++ai)
#pragma unroll
            for (int m = 0; m < 4; ++m) { const size_t off = (size_t)(row0 + ai * 128 + m * 16) * D + ch0;
                *(u32x4*)(LA + off) = pack8(acc[ai][0][m][0], acc[ai][0][m][1]); *(u32x4*)(BT + off) = pack8(acc[ai][1][m][0], acc[ai][1][m][1]); }
    }
};
struct EpiBf16 {
    static constexpr bool PERM = true, IDEMP = true;
    bf16_t* out;
    __device__ __forceinline__ void operator()(AccRef acc, const pg8::Unit& u, int wr, int wc, int fr, int fq) const {
        const int row0 = u.pm * 256 + wr * 64 + fr, col0 = u.pn * 256 + wc * 32 + 8 * fq;
#pragma unroll
        for (int ai = 0; ai < 2; ++ai)
#pragma unroll
            for (int m = 0; m < 4; ++m) { bf16_t* rp = out + (size_t)(row0 + ai * 128 + m * 16) * D + col0;
#pragma unroll
                for (int bj = 0; bj < 2; ++bj) *(u32x4*)(rp + bj * 128) = pack8(acc[ai][bj][m][0], acc[ai][bj][m][1]); }
    }
};
struct EpiPleGate {
    static constexpr bool PERM = true, IDEMP = false;
    const bf16_t* in; const bf16_t* proj; const float* ssp_in; bf16_t* out; float* ssp; unsigned char* out8; float es; float zs;
    __device__ __forceinline__ void operator()(AccRef acc, const pg8::Unit& u, int wr, int wc, int fr, int fq) const {
        const int rl0 = wr * 64 + fr, row0 = u.pm * 256 + rl0, col0 = u.pn * 256 + wc * 32 + 8 * fq; float rs8[2][4]; load_rstd8(rs8, ssp_in, row0, fq);
#pragma unroll
        for (int ai = 0; ai < 2; ++ai)
#pragma unroll
          for (int mp = 0; mp < 4; mp += 2) { u32x4 hw[4][2], pw[4][2];
#pragma unroll
            for (int m = mp; m < mp + 2; ++m)
#pragma unroll
                for (int bj = 0; bj < 2; ++bj) { const size_t off = (size_t)(row0 + ai * 128 + m * 16) * D + col0 + bj * 128; hw[m][bj] = *(const u32x4*)(in + off); pw[m][bj] = *(const u32x4*)(proj + off); }
#pragma unroll
            for (int m = mp; m < mp + 2; ++m) { const float rs = rs8[ai][m] * zs;
#pragma unroll
                for (int bj = 0; bj < 2; ++bj) { const u32x4 pp = pw[m][bj]; f32x4 a0 = acc[ai][bj][m][0] * rs, a1 = acc[ai][bj][m][1] * rs;
                    a0[0] = fast_sigmoid(a0[0]) * bf_lo(pp.x); a0[1] = fast_sigmoid(a0[1]) * bf_hi(pp.x); a0[2] = fast_sigmoid(a0[2]) * bf_lo(pp.y); a0[3] = fast_sigmoid(a0[3]) * bf_hi(pp.y);
                    a1[0] = fast_sigmoid(a1[0]) * bf_lo(pp.z); a1[1] = fast_sigmoid(a1[1]) * bf_hi(pp.z); a1[2] = fast_sigmoid(a1[2]) * bf_lo(pp.w); a1[3] = fast_sigmoid(a1[3]) * bf_hi(pp.w);
                    add_bf8(a0, a1, hw[m][bj], es); acc[ai][bj][m][0] = a0; acc[ai][bj][m][1] = a1; } }
            if (mp == 0) EPI_PIN2(ai, 0); else EPI_PIN2(ai, 2); }
        EPI_FENCE();
#pragma unroll
        for (int ai = 0; ai < 2; ++ai)
#pragma unroll
            for (int m = 0; m < 4; ++m) { const int row = row0 + ai * 128 + m * 16; const size_t off = (size_t)row * D + col0; float s = 0.f;
#pragma unroll
                for (int bj = 0; bj < 2; ++bj) { const f32x4 x0 = acc[ai][bj][m][0], x1 = acc[ai][bj][m][1]; *(u32x4*)(out + off + bj * 128) = pack8(x0, x1); s += sumsq8(x0, x1);
                    if (out8) { u32x2 q; q.x = pk_fp8x4(x0[0], x0[1], x0[2], x0[3]); q.y = pk_fp8x4(x1[0], x1[1], x1[2], x1[3]); *(u32x2*)(out8 + off + bj * 128) = q; } }
                s += swz_xor<16>(s); s = add_x32(s);
                if (fq == 0) ssp[(size_t)row * 16 + u.pn * 4 + wc] = s; }
    }
};
struct EpiMoeDown {
    static constexpr bool PERM = true, IDEMP = false;
    const bf16_t* in; bf16_t* out; const int* stok; const float* sgate; float* ssp; const volatile LAS unsigned* cnt; const volatile LAS unsigned* tst; unsigned char* out8; float es; int last_pass;
    __device__ __forceinline__ void operator()(AccRef acc, const pg8::Unit& u, int wr, int wc, int fr, int fq) const {
        const int e = moe_expert(tst, u.pm); const int nvalid = (int)cnt[e] - (u.pm - (int)tst[e]) * 256;
        const int r0 = wr * 64 + fr, col0 = u.pn * 256 + wc * 32 + 8 * fq;
        int tok[2][4]; float g[2][4];
#pragma unroll
        for (int ai = 0; ai < 2; ++ai)
#pragma unroll
            for (int m = 0; m < 4; ++m) { const int r = r0 + ai * 128 + m * 16; tok[ai][m] = -1; g[ai][m] = 0.f; if (r < nvalid) { tok[ai][m] = stok[u.pm * 256 + r]; g[ai][m] = sgate[u.pm * 256 + r] * es; } }
#pragma unroll
        for (int ai = 0; ai < 2; ++ai) { u32x4 w[4][2];
#pragma unroll
            for (int m = 0; m < 4; ++m)
#pragma unroll
                for (int bj = 0; bj < 2; ++bj) { w[m][bj] = (u32x4){0u, 0u, 0u, 0u}; if (tok[ai][m] >= 0) w[m][bj] = *(const u32x4*)(in + (size_t)tok[ai][m] * D + col0 + bj * 128); }
#pragma unroll
            for (int m = 0; m < 4; ++m)
#pragma unroll
                for (int bj = 0; bj < 2; ++bj) add_bf8(acc[ai][bj][m][0], acc[ai][bj][m][1], w[m][bj], g[ai][m]);
            EPI_PIN(ai); }
        EPI_FENCE();
#pragma unroll
        for (int ai = 0; ai < 2; ++ai)
#pragma unroll
            for (int m = 0; m < 4; ++m) { const bool ok = tok[ai][m] >= 0; const size_t off = (size_t)(ok ? tok[ai][m] : 0) * D + col0; float s = 0.f;
#pragma unroll
                for (int bj = 0; bj < 2; ++bj) { const f32x4 x0 = acc[ai][bj][m][0], x1 = acc[ai][bj][m][1]; if (ok) *(u32x4*)(out + off + bj * 128) = pack8(x0, x1); s += sumsq8(x0, x1);
                    if (last_pass && ok) { u32x2 q; q.x = pk_fp8x4(x0[0], x0[1], x0[2], x0[3]); q.y = pk_fp8x4(x1[0], x1[1], x1[2], x1[3]); *(u32x2*)(out8 + off + bj * 128) = q; } }
                if (last_pass) { s += swz_xor<16>(s); s = add_x32(s); if (ok && fq == 0) ssp[(size_t)tok[ai][m] * 16 + u.pn * 4 + wc] = s; } }
    }
};

#ifndef MOE_FP8
#define MOE_FP8 1
#endif
#ifndef FFN8_MASK
#define FFN8_MASK 0x4u
#endif
#define FFN8(li) (((FFN8_MASK) >> (li)) & 1u)
#ifndef DN8_MASK
#define DN8_MASK 0x5u
#endif
#define DN8(li) (((DN8_MASK) >> (li)) & 1u)
#ifndef QKV8_MASK
#define QKV8_MASK 0x4u
#endif
#define QKV8(li) (((QKV8_MASK) >> (li)) & 1u)
#ifndef FFN_FP8
#define FFN_FP8 0
#endif
constexpr int FFN_ESZ = FFN_FP8 ? 1 : 2;
constexpr int MOE_ESZ = MOE_FP8 ? 1 : 2;
struct DenseSched {
    pg8::StaticOrder ord; const char* A; const char* B; size_t a_tstep, b_tstep; const float* ssp;
    __device__ __forceinline__ bool next(int i, pg8::Unit& u) const { return ord.next(i, u); }
    __device__ __forceinline__ const char* abase(const pg8::Unit& u) const { return A + (size_t)u.pm * a_tstep; }
    __device__ __forceinline__ const char* bbase(const pg8::Unit& u) const { return B + (size_t)u.pn * b_tstep; }
    __device__ __forceinline__ int arow(const pg8::Unit&, int) const { return 0; }
    __device__ __forceinline__ int rsrow(const pg8::Unit& u, int r) const { return u.pm * 256 + r; }
};
struct GatesSched {
    pg8::StaticOrder ord; const char* A; const char* B; const float* ssp;
    __device__ __forceinline__ bool next(int i, pg8::Unit& u) const { return ord.next(i, u); }
    __device__ __forceinline__ const char* abase(const pg8::Unit& u) const { return A + (size_t)u.pm * (256 * D * 2) + (size_t)u.pn * 256; }
    __device__ __forceinline__ const char* bbase(const pg8::Unit& u) const { return B + (size_t)u.pn * (256 * 128 * 2); }
    __device__ __forceinline__ int arow(const pg8::Unit&, int) const { return 0; }
    __device__ __forceinline__ int rsrow(const pg8::Unit&, int) const { return -1; }
};
struct MoeGuSched {
    pg8::StaticOrder ord; const char* A; const char* B; const int* stok; const float* ssp; const volatile LAS unsigned* cnt; const volatile LAS unsigned* tst;
    __device__ __forceinline__ bool next(int i, pg8::Unit& u) const { return ord.next(i, u); }
    __device__ __forceinline__ const char* abase(const pg8::Unit& u) const { return MOE_FP8 ? A + (size_t)u.pm * (256 * D) : A; }
    __device__ __forceinline__ const char* bbase(const pg8::Unit& u) const { return B + (size_t)moe_expert(tst, u.pm) * ((size_t)2 * FFE * D * MOE_ESZ) + (size_t)u.pn * (256 * D * MOE_ESZ); }
    __device__ __forceinline__ int arow(const pg8::Unit& u, int r) const { const int e = moe_expert(tst, u.pm); const int nvalid = (int)cnt[e] - (u.pm - (int)tst[e]) * 256; return r < nvalid ? stok[u.pm * 256 + r] : 0; }
    __device__ __forceinline__ int rsrow(const pg8::Unit& u, int r) const { const int e = moe_expert(tst, u.pm); const int nvalid = (int)cnt[e] - (u.pm - (int)tst[e]) * 256; return r < nvalid ? stok[u.pm * 256 + r] : -1; }
};
struct MoeDownSched {
    pg8::StaticOrder ord; const char* A; const char* B; const float* ssp; const volatile LAS unsigned* tst;
    __device__ __forceinline__ bool next(int i, pg8::Unit& u) const { return ord.next(i, u); }
    __device__ __forceinline__ const char* abase(const pg8::Unit& u) const { return A + (size_t)u.pm * ((size_t)256 * FFE * MOE_ESZ); }
    __device__ __forceinline__ const char* bbase(const pg8::Unit& u) const { return B + (size_t)moe_expert(tst, u.pm) * ((size_t)D * FFE * MOE_ESZ) + (size_t)u.pn * ((size_t)256 * FFE * MOE_ESZ); }
    __device__ __forceinline__ int arow(const pg8::Unit&, int) const { return 0; }
    __device__ __forceinline__ int rsrow(const pg8::Unit&, int) const { return -1; }
};

#ifndef PH_MASK
#define PH_MASK 0xffffffffu
#endif
#define PH_ON(k) (((PH_MASK) >> (k)) & 1u)
#ifndef DUP_MASK
#define DUP_MASK 0u
#endif
#define DUP_FOR(k) for (int rep_ = (((DUP_MASK) >> (k)) & 1u) ? 0 : 1; rep_ < 2; ++rep_)
#define ES_ const float es_ = (rep_ == 1) ? 1.0f : 0.0f; (void)es_
struct Args { const float* in[34]; float* out; unsigned char* ws; int nlayers; int pad; };

#define MOE_CONV_BODY \
                { const float* wg = INP(31) + (size_t)j * NE * D * FFE; const float* wu = INP(32) + (size_t)j * NE * D * FFE; bf16_t* dst = (bf16_t*)(ws + WS_WB + WB_MGU); \
                  for (int it = gw; it < NE * 16 * 112; it += NGW) { const int e = it / (16 * 112), r = it % (16 * 112), kb = r / 112, vb = r % 112; const int vrow0 = vb * 64, pn = vrow0 >> 8, v = vrow0 & 255; \
                      if (MOE_FP8) tr_item64_fp8((v < 128 ? wg : wu) + (size_t)e * D * FFE, FFE, kb * 64, pn * 128 + (v & 127), (unsigned char*)dst + (size_t)e * 2 * FFE * D, D, vrow0, kb * 64, g_ffn_next, W8_SCALE, scr64, lane); \
                      else tr_item64((v < 128 ? wg : wu) + (size_t)e * D * FFE, FFE, kb * 64, pn * 128 + (v & 127), dst + (size_t)e * 2 * FFE * D, D, vrow0, kb * 64, g_ffn_next, scr64, lane); } } \
                { const float* wd = INP(33) + (size_t)j * NE * FFE * D; bf16_t* dst = (bf16_t*)(ws + WS_WB + WB_MD); \
                  for (int it = gw; it < NE * 56 * 16; it += NGW) { const int e = it / (56 * 16), r = it % (56 * 16), kb = r / 16, vb = r % 16; \
                      if (MOE_FP8) tr_item64_fp8(wd + (size_t)e * FFE * D, D, kb * 64, vb * 64, (unsigned char*)dst + (size_t)e * D * FFE, FFE, vb * 64, kb * 64, nullptr, W8_SCALE, scr64, lane); \
                      else tr_item64(wd + (size_t)e * FFE * D, D, kb * 64, vb * 64, dst + (size_t)e * D * FFE, FFE, vb * 64, kb * 64, nullptr, scr64, lane); } }
__global__ void __launch_bounds__(512, 2) fwd_kernel(Args args) {
    extern __shared__ __attribute__((aligned(16))) unsigned char lds_raw[];
    LAS unsigned char* lds = (LAS unsigned char*)lds_raw;
    volatile LAS unsigned* MISC = (volatile LAS unsigned*)(lds + MISC_OFF);
    const int wave_s = __builtin_amdgcn_readfirstlane((int)threadIdx.x >> 6);
    for (int u = tid_of(wave_s); u < (LDS_BYTES - LDSCTL_OFF) / 4; u += 512) ((LAS unsigned*)(lds + LDSCTL_OFF))[u] = 0u;
    __syncthreads();
    XcdBarrier bar = xcd_barrier_post((unsigned*)(args.ws + WS_CTL) + CW_BAR, MISC + 8, wave_s);
#define GRID_BAR() xcd_barrier(bar, wave_s)
#define INP(i) ({ int _ix = (i); asm volatile("" : "+s"(_ix)); args.in[_ix]; })
#define PH_LOCALS \
    int tid = tid_of(wave_s); asm volatile("" : "+v"(tid)); const int lane = tid & 63; const int wave = __builtin_amdgcn_readfirstlane(tid >> 6); \
    int G = (int)gridDim.x; int bx = (int)blockIdx.x; asm volatile("" : "+s"(G), "+s"(bx)); \
    const int vcu = (G % 8 == 0) ? (bx % 8) * (G / 8) + bx / 8 : bx; const int gw = vcu * 8 + wave, NGW = G * 8; \
    size_t z_ = 0; asm volatile("" : "+s"(z_)); unsigned char* ws = args.ws + z_; \
    int cur_ = cur; asm volatile("" : "+s"(cur_)); \
    bf16_t* HC = (bf16_t*)(ws + (cur_ ? WS_HB0 : WS_XN)); bf16_t* HO = (bf16_t*)(ws + (cur_ ? WS_XN : WS_HB0));        \
    float* SC = (float*)(ws + (cur_ ? WS_SSP0 : WS_SSP1)); float* SO = (float*)(ws + (cur_ ? WS_SSP1 : WS_SSP0));        \
    bf16_t* P16 = (bf16_t*)(ws + WS_P16); bf16_t* PROJ = (bf16_t*)(ws + WS_PROJ); \
    unsigned char* R = ws + WS_R; unsigned char* MS = ws + WS_MISC; \
    LAS float* scr = (LAS float*)(lds + RING_OFF + wave * 16384); LAS unsigned* scr64 = (LAS unsigned*)(lds + RING_OFF + wave * 16384); \
    (void)lane; (void)vcu; (void)gw; (void)NGW; (void)HC; (void)HO; (void)SC; (void)SO; (void)P16; (void)PROJ; (void)R; (void)MS; (void)scr; (void)scr64
#define LAYER_LOCALS \
    int li_ = li; asm volatile("" : "+s"(li_)); const int j = li_ >> 1; const bool is_attn = !(li_ & 1); \
    unsigned char* W = ws + (is_attn ? WS_WA : WS_WB); \
    const float* g_mix = INP(2) + li_ * D; const float* g_ffn = INP(3) + li_ * D; const float* g_ple = INP(4) + li_ * D; \
    (void)j; (void)W; (void)g_mix; (void)g_ffn; (void)g_ple

    int cur = 0;
    const int nlayers = args.nlayers;
    for (int li = 0; li < DEPTH; ++li) {
        if (li >= nlayers) break;
        const bool is_attn = !(li & 1);
        if (PH_ON(0)) DUP_FOR(0) { ES_; PH_LOCALS; LAYER_LOCALS;
            { const float* wg = INP(7) + (size_t)li * D * D; unsigned char* dst = W + (is_attn ? WA_PG : WB_PG);
              for (int it = gw; it < 16 * 16; it += NGW) { const int kb = it / 16, vb = it % 16; tr_item64_fp8(wg, D, kb * 64, vb * 64, dst, D, vb * 64, kb * 64, g_ple, W8_SCALE, scr64, lane); } }
            { const float* wp = INP(6) + (size_t)li * DPLE * D; bf16_t* dst = (bf16_t*)(W + (is_attn ? WA_PP : WB_PP));
              for (int it = gw; it < 4 * 32; it += NGW) { const int kb = it / 32, vb = it % 32; tr_item(wp, D, kb * 64, vb * 32, dst, DPLE, vb * 32, kb * 64, nullptr, 1.f, scr, lane); } }
            if (is_attn) {
                const float* wq = INP(8) + (size_t)j * D * D; const float* wk = INP(9) + (size_t)j * D * D; const float* wv = INP(10) + (size_t)j * D * D;
                bf16_t* dqkv = (bf16_t*)(W + WA_QKV);
                for (int it = gw; it < 16 * 96; it += NGW) { const int kb = it / 96, vb = it % 96; const int vrow0 = vb * 32, pn = vrow0 >> 8, v = vrow0 & 255;
                    const float* src; int nsrc0;
                    if (pn < 8) { src = pn < 4 ? wq : wk; nsrc0 = ((pn & 3) * 4 + ((v & 127) >> 5)) * 64 + (v >> 7) * 32; }
                    else { src = wv; nsrc0 = (pn - 8) * 256 + v; }
                    if (QKV8(li_)) tr_item_fp8(src, D, kb * 64, nsrc0, (unsigned char*)dqkv, D, vrow0, kb * 64, g_mix, W8_SCALE, scr, lane);
                    else tr_item(src, D, kb * 64, nsrc0, dqkv, D, vrow0, kb * 64, g_mix, 1.f, scr, lane); }
                { const float* wo = INP(11) + (size_t)j * D * D; const float* sg = INP(16) + j * 128; bf16_t* dst = (bf16_t*)(W + WA_O);
                  const float linit = 0.8f - 0.6f * __expf(-0.3f * (float)li_);
                  for (int it = gw; it < 16 * 32; it += NGW) { const int kb = it / 32, vb = it % 32; tr_item(wo, D, kb * 64, vb * 32, dst, D, vb * 32, kb * 64, sg + ((kb * 64) & 127) - kb * 64, 1.0f - linit, scr, lane); } }
                { const float* wg = INP(17) + (size_t)j * D * FF; const float* wu = INP(18) + (size_t)j * D * FF; bf16_t* dst = (bf16_t*)(W + WA_GU);
                  for (int it = gw; it < 16 * 88; it += NGW) { const int kb = it / 88, vb = it % 88; const int vrow0 = vb * 64, pn = vrow0 >> 8, v = vrow0 & 255;
                      if (FFN8(li_)) tr_item64_fp8(v < 128 ? wg : wu, FF, kb * 64, pn * 128 + (v & 127), (unsigned char*)dst, D, vrow0, kb * 64, g_ffn, W8_SCALE, scr64, lane);
                      else tr_item64(v < 128 ? wg : wu, FF, kb * 64, pn * 128 + (v & 127), dst, D, vrow0, kb * 64, g_ffn, scr64, lane); } }
                { const float* wd = INP(19) + (size_t)j * FF * D; bf16_t* dst = (bf16_t*)(W + WA_D);
                  for (int it = gw; it < 44 * 16; it += NGW) { const int kb = it / 16, vb = it % 16;
                      if (DN8(li_)) tr_item64_fp8(wd, D, kb * 64, vb * 64, (unsigned char*)dst, FF, vb * 64, kb * 64, nullptr, W8_SCALE, scr64, lane);
                      else tr_item64(wd, D, kb * 64, vb * 64, dst, FF, vb * 64, kb * 64, nullptr, scr64, lane); } }
            } else {
                { const float* wx = INP(20) + (size_t)j * D * D; const float* wy = INP(21) + (size_t)j * D * D; bf16_t* dst = (bf16_t*)(W + WB_IN);
                  for (int it = gw; it < 16 * 64; it += NGW) { const int kb = it / 64, vb = it % 64; const int vrow0 = vb * 32;
                      tr_item(vrow0 < D ? wx : wy, D, kb * 64, vrow0 & (D - 1), dst, D, vrow0, kb * 64, g_mix, 1.f, scr, lane); } }
                { const float* wa = INP(24) + (size_t)j * NE * 128 * 128; const float* wxg = INP(26) + (size_t)j * NE * 128 * 128; bf16_t* dst = (bf16_t*)(W + WB_GT);
                  for (int it = gw; it < 8 * 2 * 8; it += NGW) { const int n = it >> 4, kb = (it >> 3) & 1, vb = it & 7; const int v0 = vb * 32;
                      tr_item((v0 < 128 ? wa : wxg) + (size_t)n * 128 * 128, 128, kb * 64, v0 & 127, dst + (size_t)n * 256 * 128, 128, v0, kb * 64, nullptr, 1.f, scr, lane); } }
                { const float* wo = INP(29) + (size_t)j * D * D; bf16_t* dst = (bf16_t*)(W + WB_OUT);
                  for (int it = gw; it < 16 * 32; it += NGW) { const int kb = it / 32, vb = it % 32; tr_item(wo, D, kb * 64, vb * 32, dst, D, vb * 32, kb * 64, nullptr, 1.f, scr, lane); } }
                { const float* lam = INP(28) + j * D; float* spl = (float*)(MS + MS_SPL);
                  for (int it = bx * 512 + tid; it < D; it += G * 512) { const float xx = __expf(-lam[it]); spl[it] = xx * (1.0f - xx * (0.5f - xx * (0.33333333f - 0.25f * xx))); } }
            }
            { const f32x4* ps = (const f32x4*)(INP(1) + (size_t)li * NTOK * DPLE); u32x2* pd = (u32x2*)P16;
              const size_t stride = (size_t)G * 512;
              for (size_t it = (size_t)bx * 512 + tid; it < (size_t)NTOK * DPLE / 4; it += 8 * stride) { f32x4 v[8];
#pragma unroll
                  for (int q = 0; q < 8; ++q) { const size_t ix = it + q * stride; v[q] = (ix < (size_t)NTOK * DPLE / 4) ? ps[ix] : (f32x4){0.f, 0.f, 0.f, 0.f}; }
#pragma unroll
                  for (int q = 0; q < 8; ++q) { const size_t ix = it + q * stride; if (ix < (size_t)NTOK * DPLE / 4) { u32x2 o; o.x = cvt_pk_bf16(v[q][0], v[q][1]); o.y = cvt_pk_bf16(v[q][2], v[q][3]); pd[ix] = o; } } } }
            if (li_ == 0) for (int m = gw; m < NTOK; m += NGW) {
                const f32x4* xr = (const f32x4*)(INP(0) + (size_t)m * D) + lane; f32x4 v[4]; float s2 = 0.f;
#pragma unroll
                for (int q = 0; q < 4; ++q) { v[q] = xr[64 * q]; s2 += (v[q][0] * v[q][0] + v[q][1] * v[q][1]) + (v[q][2] * v[q][2] + v[q][3] * v[q][3]); }
                s2 = wave_sum(s2);
                u32x2* o8 = (u32x2*)(HC + (size_t)m * D) + lane;
#pragma unroll
                for (int q = 0; q < 4; ++q) { u32x2 o; o.x = cvt_pk_bf16(v[q][0], v[q][1]); o.y = cvt_pk_bf16(v[q][2], v[q][3]); o8[64 * q] = o; }
                if (lane < 16) SC[(size_t)m * 16 + lane] = (lane == 0) ? s2 : 0.f;
            }
        }
        GRID_BAR();

        if (is_attn) {
            if (PH_ON(1)) DUP_FOR(1) { ES_; PH_LOCALS; LAYER_LOCALS; DenseSched S; S.ord.init(NTOK / 256, 12, G, bx); S.A = (const char*)HC; S.B = (const char*)(W + WA_QKV); S.a_tstep = (size_t)256 * D * 2; S.b_tstep = (size_t)256 * D * 2;
              S.ssp = nullptr;
              if (QKV8(li_)) { S.A = (const char*)(R + R_H8); S.a_tstep = (size_t)256 * D; S.b_tstep = (size_t)256 * D; EpiQKV E{(bf16_t*)(R + R_Q), (bf16_t*)(R + R_K), (bf16_t*)(R + R_V), SC, 1.0f / W8_SCALE, 0};
                pg8::gemm_phase<EpiQKV, DenseSched, false, true>(lds + RING_OFF, (LAS float*)(lds + MISC_OFF + 1024), D / 2, D / 2, D / 2, S, E, wave_s); }
              else { EpiQKV E{(bf16_t*)(R + R_Q), (bf16_t*)(R + R_K), (bf16_t*)(R + R_V), SC, 1.0f, 0};
                pg8::gemm_phase<EpiQKV, DenseSched, false, false>(lds + RING_OFF, (LAS float*)(lds + MISC_OFF + 1024), D, D, D, S, E, wave_s); } }
            GRID_BAR();
            if (PH_ON(2)) DUP_FOR(2) { ES_; PH_LOCALS; LAYER_LOCALS; const attn_body::bf16* Qp = (const attn_body::bf16*)(R + R_Q); const attn_body::bf16* Kp = (const attn_body::bf16*)(R + R_K); const attn_body::bf16* Vp = (const attn_body::bf16*)(R + R_V);
              attn_body::bf16* Op = (attn_body::bf16*)(R + R_OA);
              const float* g_ffn_next = INP(3) + (li_ + 1) * D; bool conv_done = false; const int conv_at = vcu & 15;
#define MOE_CONVERT() do { __syncthreads(); MOE_CONV_BODY __syncthreads(); conv_done = true; } while (0)
              int ii = 0;
              const float l1_ = wave_sum(INP(12)[j * 64 + lane] * INP(13)[j * 64 + lane]), l2_ = wave_sum(INP(14)[j * 64 + lane] * INP(15)[j * 64 + lane]);
              const float lam = __expf(l1_) - __expf(l2_) + (0.8f - 0.6f * __expf(-0.3f * (float)li_));
              attn_body::f32x16 keep[4];
#pragma unroll
              for (int d0 = 0; d0 < 4; ++d0) keep[d0] = attn_body::f32x16{};
              for (int item = vcu; item < 4096; item += G, ++ii) {
                  if (!conv_done && ii >= conv_at) MOE_CONVERT();
                  const int c = item & 31, xx = (item >> 5) & 7, step = item >> 8; const int bh = xx * 16 + step; const int b = bh >> 3, head = bh & 7; const int qb = (step & 1) ? 31 - c : c;
                  attn_body::attn_unit_ps<8, 0>(b, (2 * head) * 64, head * 128, head * 128, qb, Qp, Kp, Vp, Op, (char*)lds_raw + RING_OFF, wave_s, keep, lam);
                  attn_body::attn_unit_ps<8, 1>(b, (2 * head + 1) * 64, head * 128, head * 128, qb, Qp, Kp, Vp, Op, (char*)lds_raw + RING_OFF, wave_s, keep, lam);
              }
              if (!conv_done) MOE_CONVERT();
#undef MOE_CONVERT
              }
            GRID_BAR();
            if (PH_ON(4)) DUP_FOR(4) { ES_; PH_LOCALS; LAYER_LOCALS; DenseSched S; S.ord.init(NTOK / 256, 4, G, bx); S.A = (const char*)(R + R_OA); S.B = (const char*)(W + WA_O); S.a_tstep = (size_t)256 * D * 2; S.b_tstep = (size_t)256 * D * 2;
              S.ssp = nullptr; EpiRes E{HC, HO, SO, FFN8(li_) ? (unsigned char*)(R + R_H8) : nullptr, es_, 0};
              pg8::gemm_phase<EpiRes, DenseSched, false, false>(lds + RING_OFF, (LAS float*)(lds + MISC_OFF + 1024), D, D, D, S, E, wave_s); }
            GRID_BAR(); cur ^= 1;
        } else {
            if (PH_ON(5)) DUP_FOR(5) { ES_; PH_LOCALS; LAYER_LOCALS; DenseSched S; S.ord.init(NTOK / 256, 8, G, bx); S.A = (const char*)HC; S.B = (const char*)(W + WB_IN); S.a_tstep = (size_t)256 * D * 2; S.b_tstep = (size_t)256 * D * 2;
              S.ssp = nullptr; EpiLruIn E{(bf16_t*)(R + R_XL), (bf16_t*)(R + R_Y), SC};
              pg8::gemm_phase<EpiLruIn, DenseSched, false, false>(lds + RING_OFF, (LAS float*)(lds + MISC_OFF + 1024), D, D, D, S, E, wave_s); }
            GRID_BAR();
            if (PH_ON(6)) DUP_FOR(6) { ES_; PH_LOCALS; LAYER_LOCALS; const bf16_t* XL = (const bf16_t*)(R + R_XL); bf16_t* U = (bf16_t*)(R + R_U); const float* cw = INP(22) + (size_t)j * 4 * D; const float* cb = INP(23) + j * D;
              for (int it = gw; it < (NTOK / 32) * 2; it += NGW) { const int chunk = it >> 1, c0 = (it & 1) * 512 + lane * 8; const int row0 = chunk * 32; const int t0 = row0 & (SEQ - 1);
                  float w[4][8], bb[8];
#pragma unroll
                  for (int k = 0; k < 4; ++k) { const f32x4 a = *(const f32x4*)(cw + k * D + c0), b = *(const f32x4*)(cw + k * D + c0 + 4);
#pragma unroll
                      for (int e = 0; e < 4; ++e) { w[k][e] = a[e]; w[k][4 + e] = b[e]; } }
                  { const f32x4 a = *(const f32x4*)(cb + c0), b = *(const f32x4*)(cb + c0 + 4);
#pragma unroll
                    for (int e = 0; e < 4; ++e) { bb[e] = a[e]; bb[4 + e] = b[e]; } }
                  float x0[8], x1[8], x2[8];
#pragma unroll
                  for (int e = 0; e < 8; ++e) { x0[e] = 0.f; x1[e] = 0.f; x2[e] = 0.f; }
                  if (t0 > 0) {
                      const u32x4 q0 = *(const u32x4*)(XL + (size_t)(row0 - 3) * D + c0), q1 = *(const u32x4*)(XL + (size_t)(row0 - 2) * D + c0), q2 = *(const u32x4*)(XL + (size_t)(row0 - 1) * D + c0);
                      const unsigned a0[4] = {q0.x, q0.y, q0.z, q0.w}, a1[4] = {q1.x, q1.y, q1.z, q1.w}, a2[4] = {q2.x, q2.y, q2.z, q2.w};
#pragma unroll
                      for (int q = 0; q < 4; ++q) { x0[2 * q] = bf_lo(a0[q]); x0[2 * q + 1] = bf_hi(a0[q]); x1[2 * q] = bf_lo(a1[q]); x1[2 * q + 1] = bf_hi(a1[q]); x2[2 * q] = bf_lo(a2[q]); x2[2 * q + 1] = bf_hi(a2[q]); }
                  }
                  for (int r8 = 0; r8 < 32; r8 += 8) {
                      u32x4 qq[8];
#pragma unroll
                      for (int r = 0; r < 8; ++r) qq[r] = *(const u32x4*)(XL + (size_t)(row0 + r8 + r) * D + c0);
#pragma unroll
                      for (int r = 0; r < 8; ++r) { const unsigned aq[4] = {qq[r].x, qq[r].y, qq[r].z, qq[r].w}; float x3[8], o[8];
#pragma unroll
                          for (int q = 0; q < 4; ++q) { x3[2 * q] = bf_lo(aq[q]); x3[2 * q + 1] = bf_hi(aq[q]); }
#pragma unroll
                          for (int e = 0; e < 8; ++e) { o[e] = bb[e] + w[0][e] * x0[e] + w[1][e] * x1[e] + w[2][e] * x2[e] + w[3][e] * x3[e]; x0[e] = x1[e]; x1[e] = x2[e]; x2[e] = x3[e]; }
                          qq[r].x = cvt_pk_bf16(o[0], o[1]); qq[r].y = cvt_pk_bf16(o[2], o[3]); qq[r].z = cvt_pk_bf16(o[4], o[5]); qq[r].w = cvt_pk_bf16(o[6], o[7]); }
#pragma unroll
                      for (int r = 0; r < 8; ++r) *(u32x4*)(U + (size_t)(row0 + r8 + r) * D + c0) = qq[r];
                  } } }
            GRID_BAR();
            if (PH_ON(7)) DUP_FOR(7) { ES_; PH_LOCALS; LAYER_LOCALS; GatesSched S; S.ord.init(NTOK / 256, 8, G, bx); S.A = (const char*)(R + R_U); S.B = (const char*)(W + WB_GT);
              EpiGates E{(const bf16_t*)(R + R_U), INP(25) + j * D, INP(27) + j * D, (const float*)(MS + MS_SPL), (bf16_t*)(R + R_LA), (bf16_t*)(R + R_BT)};
              S.ssp = nullptr; pg8::gemm_phase<EpiGates, GatesSched, false, false>(lds + RING_OFF, (LAS float*)(lds + MISC_OFF + 1024), 128, D, 128, S, E, wave_s); }
            GRID_BAR();
            if (PH_ON(8)) DUP_FOR(8) { ES_; PH_LOCALS; LAYER_LOCALS; const bf16_t* LA = (const bf16_t*)(R + R_LA); const bf16_t* BT = (const bf16_t*)(R + R_BT);
              LAS float* cs = (LAS float*)(lds + RING_OFF);
              float* CS = (float*)(ws + WS_SCAN); float* CST = (float*)(ws + WS_SCAN + 16 * MiB);
              for (int item = bx; item < NB * 16; item += G) { const int b = item >> 4, cg = (item >> 1) & 7, half = item & 1, c0 = cg * 128 + lane * 2; const size_t base = ((size_t)b * SEQ + half * 2048 + wave * 256) * D + c0;
                  float P0[8], P1[8], h0[8], h1[8]; const char* pla[8]; const char* pbt[8];
#pragma unroll
                  for (int q = 0; q < 8; ++q) { P0[q] = 1.f; P1[q] = 1.f; h0[q] = 0.f; h1[q] = 0.f; const size_t o = (base + (size_t)q * 32 * D) * 2; pla[q] = (const char*)LA + o; pbt[q] = (const char*)BT + o; }
#pragma unroll 1
                  for (int t2 = 0; t2 < 32; t2 += 2) {
                      unsigned la[2][8], bt[2][8];
#pragma unroll
                      for (int s = 0; s < 2; ++s)
#pragma unroll
                          for (int q = 0; q < 8; ++q) { la[s][q] = *(const unsigned*)(pla[q] + s * (D * 2)); bt[s][q] = *(const unsigned*)(pbt[q] + s * (D * 2)); }
#pragma unroll
                      for (int s = 0; s < 2; ++s)
#pragma unroll
                          for (int q = 0; q < 8; ++q) { const float a0 = __builtin_amdgcn_exp2f(1.4426950408889634f * bf_lo(la[s][q])), a1 = __builtin_amdgcn_exp2f(1.4426950408889634f * bf_hi(la[s][q]));
                              h0[q] = a0 * h0[q] + bf_lo(bt[s][q]); h1[q] = a1 * h1[q] + bf_hi(bt[s][q]); P0[q] *= a0; P1[q] *= a1; }
#pragma unroll
                      for (int q = 0; q < 8; ++q) { pla[q] += 2 * D * 2; pbt[q] += 2 * D * 2; } }
#pragma unroll
                  for (int q = 0; q < 8; ++q) { const int sg = wave * 8 + q; cs[(sg * 2 + 0) * 128 + lane * 2] = P0[q]; cs[(sg * 2 + 0) * 128 + lane * 2 + 1] = P1[q]; cs[(sg * 2 + 1) * 128 + lane * 2] = h0[q]; cs[(sg * 2 + 1) * 128 + lane * 2 + 1] = h1[q]; }
                  __syncthreads();
                  if (tid < 128) { float pc = 1.f, hc = 0.f; float* csg = CS + (size_t)item * (64 * 2 * 128) + tid;
                      for (int sg = 0; sg < 64; ++sg) { csg[(sg * 2 + 0) * 128] = pc; csg[(sg * 2 + 1) * 128] = hc; const float p = cs[(sg * 2 + 0) * 128 + tid], h = cs[(sg * 2 + 1) * 128 + tid]; hc = p * hc + h; pc = p * pc; }
                      CST[item * 256 + tid] = pc; CST[item * 256 + 128 + tid] = hc; }
                  __syncthreads();
              } }
            GRID_BAR();
            if (PH_ON(8)) DUP_FOR(8) { ES_; PH_LOCALS; LAYER_LOCALS; const bf16_t* LA = (const bf16_t*)(R + R_LA); const bf16_t* BT = (const bf16_t*)(R + R_BT); const bf16_t* Y = (const bf16_t*)(R + R_Y); bf16_t* HY = (bf16_t*)(R + R_HY);
              const float* CS = (const float*)(ws + WS_SCAN); const float* CST = (const float*)(ws + WS_SCAN + 16 * MiB);
              for (int item = bx; item < NB * 16; item += G) { const int b = item >> 4, cg = (item >> 1) & 7, half = item & 1, c0 = cg * 128 + lane * 2; const size_t base = ((size_t)b * SEQ + half * 2048 + wave * 256) * D + c0;
                  float h0[8], h1[8]; const char* pla[8]; const char* pbt[8]; const char* py[8]; char* phy[8];
                  f32x2 hs = (f32x2){0.f, 0.f}; if (half) hs = *(const f32x2*)(CST + (item - 1) * 256 + 128 + lane * 2);
#pragma unroll
                  for (int q = 0; q < 8; ++q) { const float* cp = CS + (size_t)item * (64 * 2 * 128) + ((wave * 8 + q) * 2) * 128 + lane * 2; const f32x2 pc = *(const f32x2*)cp, hc = *(const f32x2*)(cp + 128);
                      h0[q] = pc[0] * hs[0] + hc[0]; h1[q] = pc[1] * hs[1] + hc[1];
                      const size_t o = (base + (size_t)q * 32 * D) * 2; pla[q] = (const char*)LA + o; pbt[q] = (const char*)BT + o; py[q] = (const char*)Y + o; phy[q] = (char*)HY + o; }
#pragma unroll 1
                  for (int t2 = 0; t2 < 32; t2 += 2) {
                      unsigned la[2][8], bt[2][8], yy[2][8];
#pragma unroll
                      for (int s = 0; s < 2; ++s)
#pragma unroll
                          for (int q = 0; q < 8; ++q) { la[s][q] = *(const unsigned*)(pla[q] + s * (D * 2)); bt[s][q] = *(const unsigned*)(pbt[q] + s * (D * 2)); yy[s][q] = *(const unsigned*)(py[q] + s * (D * 2)); }
#pragma unroll
                      for (int s = 0; s < 2; ++s)
#pragma unroll
                          for (int q = 0; q < 8; ++q) { const float a0 = __builtin_amdgcn_exp2f(1.4426950408889634f * bf_lo(la[s][q])), a1 = __builtin_amdgcn_exp2f(1.4426950408889634f * bf_hi(la[s][q]));
                              h0[q] = a0 * h0[q] + bf_lo(bt[s][q]); h1[q] = a1 * h1[q] + bf_hi(bt[s][q]); yy[s][q] = cvt_pk_bf16(h0[q] * bf_lo(yy[s][q]), h1[q] * bf_hi(yy[s][q])); }
#pragma unroll
                      for (int s = 0; s < 2; ++s)
#pragma unroll
                          for (int q = 0; q < 8; ++q) *(unsigned*)(phy[q] + s * (D * 2)) = yy[s][q];
#pragma unroll
                      for (int q = 0; q < 8; ++q) { pla[q] += 2 * D * 2; pbt[q] += 2 * D * 2; py[q] += 2 * D * 2; phy[q] += 2 * D * 2; } }
              } }
            GRID_BAR();
            if (PH_ON(9)) DUP_FOR(9) { ES_; PH_LOCALS; LAYER_LOCALS; DenseSched S; S.ord.init(NTOK / 256, 4, G, bx); S.A = (const char*)(R + R_HY); S.B = (const char*)(W + WB_OUT); S.a_tstep = (size_t)256 * D * 2; S.b_tstep = (size_t)256 * D * 2;
              S.ssp = nullptr; EpiRes E{HC, HO, SO, nullptr, es_, 0};
              pg8::gemm_phase<EpiRes, DenseSched, false, false>(lds + RING_OFF, (LAS float*)(lds + MISC_OFF + 1024), D, D, D, S, E, wave_s); }
            GRID_BAR(); cur ^= 1;
        }

        if (is_attn) {
            if (FFN8(li)) {
            if (PH_ON(10)) DUP_FOR(10) { ES_; PH_LOCALS; LAYER_LOCALS; DenseSched S; S.ord.init(NTOK / 256, 22, G, bx); S.A = (const char*)(R + R_H8); S.B = (const char*)(W + WA_GU); S.a_tstep = (size_t)256 * D * 1; S.b_tstep = (size_t)256 * D * 1;
              S.ssp = nullptr; EpiSwiGLU E{(bf16_t*)(R + R_HID), SC, nullptr, FF, 1, 1, 0};
              pg8::gemm_phase<EpiSwiGLU, DenseSched, false, true>(lds + RING_OFF, (LAS float*)(lds + MISC_OFF + 1024), D * 1 / 2, D * 1 / 2, D * 1 / 2, S, E, wave_s); }
            } else {
            if (PH_ON(10)) DUP_FOR(10) { ES_; PH_LOCALS; LAYER_LOCALS; DenseSched S; S.ord.init(NTOK / 256, 22, G, bx); S.A = (const char*)HC; S.B = (const char*)(W + WA_GU); S.a_tstep = (size_t)256 * D * 2; S.b_tstep = (size_t)256 * D * 2;
              S.ssp = nullptr; EpiSwiGLU E{(bf16_t*)(R + R_HID), SC, nullptr, FF, 0, (int)DN8(li_), 0};
              pg8::gemm_phase<EpiSwiGLU, DenseSched, false, false>(lds + RING_OFF, (LAS float*)(lds + MISC_OFF + 1024), D * 2 / 2, D * 2 / 2, D * 2 / 2, S, E, wave_s); }
            }
            GRID_BAR();
            if (DN8(li)) {
            if (PH_ON(11)) DUP_FOR(11) { ES_; PH_LOCALS; LAYER_LOCALS; DenseSched S; S.ord.init(NTOK / 256, 4, G, bx); S.A = (const char*)(R + R_HID); S.B = (const char*)(W + WA_D); S.a_tstep = (size_t)256 * FF * 1; S.b_tstep = (size_t)256 * FF * 1;
              S.ssp = nullptr; EpiRes E{HC, HO, SO, (unsigned char*)(R + R_H8), es_ * (1.0f / (W8_SCALE * H8_SCALE)), 0};
              pg8::gemm_phase<EpiRes, DenseSched, false, true>(lds + RING_OFF, (LAS float*)(lds + MISC_OFF + 1024), FF * 1 / 2, FF * 1 / 2, FF * 1 / 2, S, E, wave_s); }
            } else {
            if (PH_ON(11)) DUP_FOR(11) { ES_; PH_LOCALS; LAYER_LOCALS; DenseSched S; S.ord.init(NTOK / 256, 4, G, bx); S.A = (const char*)(R + R_HID); S.B = (const char*)(W + WA_D); S.a_tstep = (size_t)256 * FF * 2; S.b_tstep = (size_t)256 * FF * 2;
              S.ssp = nullptr; EpiRes E{HC, HO, SO, (unsigned char*)(R + R_H8), es_, 0};
              pg8::gemm_phase<EpiRes, DenseSched, false, false>(lds + RING_OFF, (LAS float*)(lds + MISC_OFF + 1024), FF * 2 / 2, FF * 2 / 2, FF * 2 / 2, S, E, wave_s); }
            }
            GRID_BAR(); cur ^= 1;
        } else {
            if (PH_ON(12)) DUP_FOR(12) { ES_; PH_LOCALS; LAYER_LOCALS; LAS float* wr_l = (LAS float*)(lds + RING_OFF);
              LAS int* e_l = (LAS int*)(lds + RING_OFF + 32768);
              LAS unsigned* bc_l = (LAS unsigned*)(lds + RING_OFF + 32768 + 2048);
              LAS float* lg_l = (LAS float*)(lds + RING_OFF + 32768 + 4096);
              const float* wrt = INP(30) + (size_t)j * D * NE;
              for (int it = tid; it < D * NE; it += 512) { const int k = it >> 3, e = it & 7, q = k >> 9, r = k & 511; wr_l[((q * 8 + (r & 7)) * 64 + (r >> 3)) * 8 + e] = wrt[it] * g_ffn[k]; }
              int* TOPE = (int*)(MS + MS_TOPE); float* TOPG = (float*)(MS + MS_TOPG); int* RANK = (int*)(MS + MS_RANK); int* BC = (int*)(MS + MS_BC);
              const bool b0 = lane & 1, b1 = lane & 2, b2 = lane & 4; const int eidx = 4 * (lane & 1) + (lane & 2) + ((lane >> 2) & 1);
              for (int vb = bx; vb < NTOK / 256; vb += G) {
                  if (tid < 16) bc_l[tid] = 0u;
                  __syncthreads();
                  for (int r8 = 0; r8 < 32; r8 += 8) {
                      u32x4 xw[8][2];
#pragma unroll
                      for (int rr = 0; rr < 8; ++rr) { const u32x4* xr = (const u32x4*)(HC + (size_t)(vb * 256 + wave * 32 + r8 + rr) * D) + lane; xw[rr][0] = xr[0]; xw[rr][1] = xr[64]; }
#pragma unroll
                      for (int rr = 0; rr < 8; ++rr) { float lg[8];
#pragma unroll
                          for (int e = 0; e < 8; ++e) lg[e] = 0.f;
#pragma unroll
                          for (int q = 0; q < 2; ++q) { const unsigned ww[4] = {xw[rr][q].x, xw[rr][q].y, xw[rr][q].z, xw[rr][q].w};
#pragma unroll
                              for (int c = 0; c < 8; ++c) { const float xv = (c & 1) ? bf_hi(ww[c >> 1]) : bf_lo(ww[c >> 1]); const LAS float* wp = wr_l + ((q * 8 + c) * 64 + lane) * 8; const f32x4 w0 = *(const LAS f32x4*)wp, w1 = *(const LAS f32x4*)(wp + 4);
#pragma unroll
                                  for (int e = 0; e < 4; ++e) { lg[e] += xv * w0[e]; lg[4 + e] += xv * w1[e]; } } }
                          float r4[4], r2[2];
#pragma unroll
                          for (int i = 0; i < 4; ++i) { const float snd = b0 ? lg[i] : lg[4 + i], kp = b0 ? lg[4 + i] : lg[i]; r4[i] = kp + swz_xor<1>(snd); }
#pragma unroll
                          for (int i = 0; i < 2; ++i) { const float snd = b1 ? r4[i] : r4[2 + i], kp = b1 ? r4[2 + i] : r4[i]; r2[i] = kp + swz_xor<2>(snd); }
                          float r1 = (b2 ? r2[1] : r2[0]) + swz_xor<4>(b2 ? r2[0] : r2[1]);
                          r1 += swz_xor<8>(r1); r1 += swz_xor<16>(r1); r1 = add_x32(r1);
                          if (lane < 8) lg_l[(wave * 32 + r8 + rr) * 8 + eidx] = r1; } }
                  __syncthreads();
                  if (tid < 256) { const int m = vb * 256 + tid; const float rstd = rstd_of(SC, m); float lg[8];
                      { const f32x4 a = *(const LAS f32x4*)(lg_l + tid * 8), b = *(const LAS f32x4*)(lg_l + tid * 8 + 4);
#pragma unroll
                        for (int e = 0; e < 4; ++e) { lg[e] = a[e] * rstd; lg[4 + e] = b[e] * rstd; } }
                      int e0 = 0; float v0 = lg[0];
#pragma unroll
                      for (int e = 1; e < 8; ++e) if (lg[e] > v0) { v0 = lg[e]; e0 = e; }
                      int e1 = -1; float v1 = -INFINITY;
#pragma unroll
                      for (int e = 0; e < 8; ++e) if (e != e0 && lg[e] > v1) { v1 = lg[e]; e1 = e; }
                      const float g0 = 1.0f / (1.0f + __expf(v1 - v0));
                      e_l[tid] = e0; e_l[256 + tid] = e1; TOPE[m * 2] = e0; TOPE[m * 2 + 1] = e1; TOPG[m * 2] = g0; TOPG[m * 2 + 1] = 1.0f - g0; }
                  __syncthreads();
                  if (tid < 256) { const int me0 = e_l[tid], me1 = e_l[256 + tid]; int r0 = 0, r1 = 0;
                      for (int q = 0; q < tid; ++q) { r0 += (e_l[q] == me0) ? 1 : 0; r1 += (e_l[256 + q] == me1) ? 1 : 0; }
                      const int m = vb * 256 + tid; RANK[m * 2] = r0; RANK[m * 2 + 1] = r1;
                      atomicAdd((unsigned*)&bc_l[me0], 1u); atomicAdd((unsigned*)&bc_l[8 + me1], 1u); }
                  __syncthreads();
                  if (tid < 16) BC[vb * 16 + tid] = (int)bc_l[tid];
                  __syncthreads();
              } }
            GRID_BAR();
            if (PH_ON(13)) DUP_FOR(13) { ES_; PH_LOCALS; LAYER_LOCALS; LAS int* bcl = (LAS int*)(lds + RING_OFF);
              const int* BC = (const int*)(MS + MS_BC); const int* TOPE = (const int*)(MS + MS_TOPE); const float* TOPG = (const float*)(MS + MS_TOPG); const int* RANK = (const int*)(MS + MS_RANK);
              int* STOK = (int*)(MS + MS_STOK); float* SGATE = (float*)(MS + MS_SGATE); float* SRS = (float*)(MS + MS_SRS);
              for (int it = tid; it < 256 * 16; it += 512) bcl[it] = BC[it];
              __syncthreads();
              if (tid < 16) { int run = 0; for (int vb = 0; vb < 256; ++vb) { const int c = bcl[vb * 16 + tid]; bcl[vb * 16 + tid] = run; run += c; } MISC[MW_CNT + tid] = (unsigned)run; }
              __syncthreads();
              if (tid < 2) { int ts = 0; for (int e = 0; e < 8; ++e) { MISC[MW_TST + tid * 9 + e] = (unsigned)ts; ts += ((int)MISC[MW_CNT + tid * 8 + e] + 255) >> 8; } MISC[MW_TST + tid * 9 + 8] = (unsigned)ts; }
              __syncthreads();
              LAS int* sl_l = (LAS int*)(lds + RING_OFF + 16384);
              for (int vb = bx; vb < NTOK / 256; vb += G) {
                  if (tid < 256) { const int m = vb * 256 + tid; const float rsm = rstd_of(SC, m);
#pragma unroll
                      for (int k = 0; k < 2; ++k) { const int e = TOPE[m * 2 + k]; const int slot = (int)MISC[MW_TST + k * 9 + e] * 256 + bcl[vb * 16 + k * 8 + e] + RANK[m * 2 + k];
                          STOK[k * SLOTS_PER_PASS + slot] = m; SGATE[k * SLOTS_PER_PASS + slot] = TOPG[m * 2 + k]; SRS[k * SLOTS_PER_PASS + slot] = rsm; sl_l[k * 256 + tid] = slot; } }
                  __syncthreads();
                  if (MOE_FP8) {
                      unsigned char* XS8 = R + R_XS8;
                      for (int t4 = wave * 32; t4 < wave * 32 + 32; t4 += 8) { u32x4 v[8];
#pragma unroll
                          for (int q = 0; q < 8; ++q) { const u32x4* hp = (const u32x4*)(HC + (size_t)(vb * 256 + t4 + q) * D + lane * 16); const u32x4 a = hp[0], b = hp[1];
                              v[q].x = pk_fp8x4(bf_lo(a.x), bf_hi(a.x), bf_lo(a.y), bf_hi(a.y)); v[q].y = pk_fp8x4(bf_lo(a.z), bf_hi(a.z), bf_lo(a.w), bf_hi(a.w));
                              v[q].z = pk_fp8x4(bf_lo(b.x), bf_hi(b.x), bf_lo(b.y), bf_hi(b.y)); v[q].w = pk_fp8x4(bf_lo(b.z), bf_hi(b.z), bf_lo(b.w), bf_hi(b.w)); }
#pragma unroll
                          for (int q = 0; q < 8; ++q) { const int s0 = sl_l[t4 + q], s1 = sl_l[256 + t4 + q];
                              *(u32x4*)(XS8 + (size_t)s0 * D + lane * 16) = v[q]; *(u32x4*)(XS8 + ((size_t)SLOTS_PER_PASS + s1) * D + lane * 16) = v[q]; } } }
                  __syncthreads();
              }
              __syncthreads();
            }
            GRID_BAR();
            static_assert(MOE_FP8 != 0, "the merged MoE phase parts read the pre-gathered e4m3 tokens");
            for (int k = 0; k < 3; ++k) {
#define MOE_LOCALS(kk) int k_ = (kk); asm volatile("" : "+s"(k_)); const volatile LAS unsigned* cnt = MISC + MW_CNT + k_ * 8; const volatile LAS unsigned* tst = MISC + MW_TST + k_ * 9; const int MT = (int)tst[8]; \
                const int* stok = (const int*)(MS + MS_STOK) + k_ * SLOTS_PER_PASS; const float* sgate = (const float*)(MS + MS_SGATE) + k_ * SLOTS_PER_PASS; (void)cnt; (void)sgate
                if (k >= 1) if (PH_ON(15)) DUP_FOR(15) { ES_; PH_LOCALS; LAYER_LOCALS; MOE_LOCALS(k - 1); MoeDownSched S; S.ord.init(MT, 4, G, bx); S.A = (const char*)(R + (k_ ? R_MHID1 : R_MHID)); S.B = (const char*)(W + WB_MD); S.tst = tst;
                  EpiMoeDown E{HC, HO, stok, sgate, SO, cnt, tst, (unsigned char*)(R + R_H8B), MOE_FP8 ? es_ * (1.0f / (W8_SCALE * H8_SCALE)) : es_, k_};
                  S.ssp = nullptr; pg8::gemm_phase<EpiMoeDown, MoeDownSched, false, MOE_FP8 != 0>(lds + RING_OFF, (LAS float*)(lds + MISC_OFF + 1024), FFE * MOE_ESZ / 2, FFE * MOE_ESZ / 2, FFE * MOE_ESZ / 2, S, E, wave_s); }
                if (k < 2) if (PH_ON(14)) DUP_FOR(14) { ES_; PH_LOCALS; LAYER_LOCALS; MOE_LOCALS(k); MoeGuSched S; S.ord.init(MT, 28, G, bx); if (k_ == 1) S.ord.comp(((int)MISC[MW_TST + 8] * 4) % G, 3);
                  S.A = (const char*)(R + R_XS8) + (size_t)k_ * SLOTS_PER_PASS * D; S.B = (const char*)(W + WB_MGU); S.stok = stok; S.cnt = cnt; S.tst = tst;
                  S.ssp = nullptr; EpiSwiGLU E{(bf16_t*)(R + (k_ ? R_MHID1 : R_MHID)), nullptr, (const float*)(MS + MS_SRS) + k_ * SLOTS_PER_PASS, FFE, MOE_FP8, MOE_FP8, 0};
                  pg8::gemm_phase<EpiSwiGLU, MoeGuSched, MOE_FP8 == 0, MOE_FP8 != 0>(lds + RING_OFF, (LAS float*)(lds + MISC_OFF + 1024), D * MOE_ESZ / 2, D * MOE_ESZ / 2, D * MOE_ESZ / 2, S, E, wave_s); }
                if (k < 2) { GRID_BAR(); if (k >= 1) cur ^= 1; }
            }
        }

        if (PH_ON(16)) DUP_FOR(16) { ES_; PH_LOCALS; LAYER_LOCALS; DenseSched S; S.ord.init(NTOK / 256, 4, G, bx); if (!is_attn) S.ord.comp(((int)MISC[MW_TST + 9 + 8] * 4) % G, 4); S.A = (const char*)P16; S.B = (const char*)(W + (is_attn ? WA_PP : WB_PP)); S.a_tstep = (size_t)256 * DPLE * 2; S.b_tstep = (size_t)256 * DPLE * 2;
          S.ssp = nullptr; EpiBf16 E{PROJ};
          pg8::gemm_phase<EpiBf16, DenseSched, false, false>(lds + RING_OFF, (LAS float*)(lds + MISC_OFF + 1024), DPLE, DPLE, DPLE, S, E, wave_s); }
        if (!is_attn) { GRID_BAR(); cur ^= 1; }
        if (PH_ON(17)) DUP_FOR(17) { ES_; PH_LOCALS; LAYER_LOCALS; DenseSched S; S.ord.init(NTOK / 256, 4, G, bx); S.A = (const char*)(R + (is_attn ? R_H8 : R_H8B)); S.B = (const char*)(W + (is_attn ? WA_PG : WB_PG)); S.a_tstep = (size_t)256 * D; S.b_tstep = (size_t)256 * D;
          S.ssp = nullptr; EpiPleGate E{HC, PROJ, SC, HO, SO, (li_ + 1 < DEPTH && QKV8(li_ + 1)) ? (unsigned char*)(R + R_H8) : nullptr, es_, 1.0f / W8_SCALE};
          pg8::gemm_phase<EpiPleGate, DenseSched, false, true>(lds + RING_OFF, (LAS float*)(lds + MISC_OFF + 1024), D / 2, D / 2, D / 2, S, E, wave_s); }
        GRID_BAR(); cur ^= 1;
    }

    { PH_LOCALS; const float* ln_final = INP(5); const bool poison = xb_ld(&bar.bar[XB_TMO]) != 0u; float* OUT = args.out;
      const f32x4* gf = (const f32x4*)ln_final + 2 * lane; const f32x4 g00 = gf[0], g01 = gf[1], g10 = gf[128], g11 = gf[129];
      for (int m0 = gw * 4; m0 < NTOK; m0 += NGW * 4) {
        u32x4 w[4][2];
#pragma unroll
        for (int r = 0; r < 4; ++r) { const u32x4* xr = (const u32x4*)(HC + (size_t)(m0 + r) * D) + lane; w[r][0] = xr[0]; w[r][1] = xr[64]; }
        f32x4 v[4][4];
#pragma unroll
        for (int r = 0; r < 4; ++r) { float s = 0.f;
#pragma unroll
            for (int q = 0; q < 2; ++q) { const u32x4 x = w[r][q]; v[r][2 * q] = (f32x4){bf_lo(x.x), bf_hi(x.x), bf_lo(x.y), bf_hi(x.y)}; v[r][2 * q + 1] = (f32x4){bf_lo(x.z), bf_hi(x.z), bf_lo(x.w), bf_hi(x.w)}; s += sumsq8(v[r][2 * q], v[r][2 * q + 1]); }
            float rstd = __builtin_amdgcn_rsqf(wave_sum(s) * (1.f / D) + NORM_EPS); if (poison) rstd = __builtin_nanf("");
            v[r][0] = v[r][0] * rstd * g00; v[r][1] = v[r][1] * rstd * g01; v[r][2] = v[r][2] * rstd * g10; v[r][3] = v[r][3] * rstd * g11; }
#pragma unroll
        for (int r = 0; r < 4; ++r) { f32x4* o = (f32x4*)(OUT + (size_t)(m0 + r) * D) + 2 * lane; o[0] = v[r][0]; o[1] = v[r][1]; o[128] = v[r][2]; o[129] = v[r][3]; }
      } }
}

extern "C" void kernel_launch(void* const* d_in, const int* in_sizes, int n_in, void* d_out, int out_size, void* d_ws, size_t ws_size, hipStream_t stream) {
    static int grid = 0;
    if (grid == 0) {
        if (n_in != 34 || out_size != NTOK * D || ws_size < WS_END) { fprintf(stderr, "kernel_launch: unexpected shapes (n_in %d out %d ws %zu)\n", n_in, out_size, ws_size); grid = -1; return; }
        int dev = 0, cus = 0, per_cu = 0;
        if (hipGetDevice(&dev) != hipSuccess || hipDeviceGetAttribute(&cus, hipDeviceAttributeMultiprocessorCount, dev) != hipSuccess) { grid = -1; return; }
        if (hipFuncSetAttribute((const void*)fwd_kernel, hipFuncAttributeMaxDynamicSharedMemorySize, LDS_BYTES) != hipSuccess) { fprintf(stderr, "kernel_launch: hipFuncSetAttribute failed\n"); grid = -1; return; }
        if (hipOccupancyMaxActiveBlocksPerMultiprocessor(&per_cu, (const void*)fwd_kernel, 512, LDS_BYTES) != hipSuccess || per_cu < 1) { fprintf(stderr, "kernel_launch: occupancy query says %d\n", per_cu); }
        (void)hipGetLastError();
        grid = cus;
    }
    if (grid < 0) return;
    (void)hipMemsetAsync((char*)d_ws + WS_CTL, 0, CTL_ZERO_BYTES, stream);
    Args a{};
    for (int i = 0; i < 34; ++i) a.in[i] = (const float*)d_in[i];
    a.out = (float*)d_out; a.ws = (unsigned char*)d_ws; a.nlayers = DEPTH; a.pad = 0;
    hipLaunchKernelGGL(fwd_kernel, dim3(grid), dim3(512), LDS_BYTES, stream, a);
}
```

```cpp
#include <hip/hip_runtime.h>
#include <hip/hip_bf16.h>
#include <cstdio>
#include <cstdint>
#include <cmath>

#define GAS __attribute__((address_space(1)))
#define LAS __attribute__((address_space(3)))
typedef unsigned short bf16_t;
typedef short bf16x8 __attribute__((ext_vector_type(8)));
typedef float f32x4 __attribute__((ext_vector_type(4)));
typedef float f32x2 __attribute__((ext_vector_type(2)));
typedef unsigned u32x4 __attribute__((ext_vector_type(4)));
typedef unsigned u32x2 __attribute__((ext_vector_type(2)));
typedef int v4i_t __attribute__((ext_vector_type(4)));
typedef int v8i_t __attribute__((ext_vector_type(8)));

constexpr int NB = 16, SEQ = 4096, D = 1024, NTOK = NB * SEQ, DEPTH = 4;
constexpr int FF = 2816, FFE = 3584, NE = 8, DPLE = 256;
constexpr float NORM_EPS = 1e-6f, SUBLN_EPS = 1e-5f;
constexpr float C2 = 0.125f * 1.4426950408889634f;

__device__ __forceinline__ unsigned cvt_pk_bf16(float lo, float hi) { unsigned r; asm volatile("v_cvt_pk_bf16_f32 %0, %1, %2" : "=v"(r) : "v"(lo), "v"(hi)); return r; }
__device__ __forceinline__ float bf_lo(unsigned w) { return __uint_as_float(w << 16); }
__device__ __forceinline__ float bf_hi(unsigned w) { return __uint_as_float(w & 0xffff0000u); }
__device__ __forceinline__ float fast_sigmoid(float x) { return __builtin_amdgcn_rcpf(1.0f + __builtin_amdgcn_exp2f(-1.4426950408889634f * x)); }

template <int M> __device__ __forceinline__ float swz_xor(float v) { return __int_as_float(__builtin_amdgcn_ds_swizzle(__float_as_int(v), (M << 10) | 0x1f)); }
__device__ __forceinline__ float add_x32(float v) { auto rr = __builtin_amdgcn_permlane32_swap(__float_as_uint(v), __float_as_uint(v), false, false); return __uint_as_float(rr[0]) + __uint_as_float(rr[1]); }
__device__ __forceinline__ unsigned pk_fp8x4(float a, float b, float c, float d) {
    a = __builtin_fminf(__builtin_fmaxf(a, -448.f), 448.f); b = __builtin_fminf(__builtin_fmaxf(b, -448.f), 448.f); c = __builtin_fminf(__builtin_fmaxf(c, -448.f), 448.f); d = __builtin_fminf(__builtin_fmaxf(d, -448.f), 448.f);
    int w = 0; w = __builtin_amdgcn_cvt_pk_fp8_f32(a, b, w, false); w = __builtin_amdgcn_cvt_pk_fp8_f32(c, d, w, true); return (unsigned)w; }
__device__ __forceinline__ unsigned pk_fp8x4_m3(float a, float b, float c, float d) {
    a = __builtin_amdgcn_fmed3f(a, -448.f, 448.f); b = __builtin_amdgcn_fmed3f(b, -448.f, 448.f); c = __builtin_amdgcn_fmed3f(c, -448.f, 448.f); d = __builtin_amdgcn_fmed3f(d, -448.f, 448.f);
    int w = 0; w = __builtin_amdgcn_cvt_pk_fp8_f32(a, b, w, false); w = __builtin_amdgcn_cvt_pk_fp8_f32(c, d, w, true); return (unsigned)w; }
constexpr float W8_SCALE = 64.0f, H8_SCALE = 8.0f;
__device__ __forceinline__ int tid_of(int wave_s) { unsigned m_ = ~0u; asm volatile("" : "+s"(m_), "+s"(wave_s)); return wave_s * 64 + (int)__builtin_amdgcn_mbcnt_hi(m_, __builtin_amdgcn_mbcnt_lo(m_, 0u)); }
__device__ __forceinline__ float rstd_of(const float* ssp, int row) {
    const f32x4* p = (const f32x4*)(ssp + (size_t)row * 16); const f32x4 a = p[0], b = p[1], c = p[2], d = p[3];
    const float s = (((a[0] + a[1]) + (a[2] + a[3])) + ((b[0] + b[1]) + (b[2] + b[3]))) + (((c[0] + c[1]) + (c[2] + c[3])) + ((d[0] + d[1]) + (d[2] + d[3])));
    return __builtin_amdgcn_rsqf(s * (1.f / D) + NORM_EPS);
}
namespace pg8 {
constexpr int BM = 256, BK = 64, HALF = 128, HTB = HALF * BK * 2, STAGE_BYTES = 8 * HTB, NXCD = 8, WGM = 8;
__host__ __device__ __forceinline__ int lds_byte(int r, int c) { const int st = (r >> 4) * 2 + (c >> 5), rr = r & 15, cc = c & 31, ob = rr * 64 + cc * 2; return st * 1024 + (ob ^ (((ob >> 9) & 1) << 5)); }
__host__ __device__ __forceinline__ void stage_rc(int b, int& R, int& C) { const int st = b / 1024, sb = b % 1024, swz = sb ^ (((sb >> 9) & 1) << 5); R = (st >> 1) * 16 + swz / 64; C = (st & 1) * 32 + (swz % 64) / 2; }
__host__ __device__ __forceinline__ int perm32(int rho) { const int n = rho >> 4, i = rho & 15; return 8 * (i >> 2) + 4 * n + (i & 3); }

struct Unit { int pm, pn; };
struct StaticOrder {
    int nM, nN, nwg, G, c, heavy, xs;
    __device__ __forceinline__ void init(int nM_, int nN_, int G_, int c_) { nM = nM_; nN = nN_; nwg = nM * nN; G = G_; c = c_; heavy = 0; xs = 0; }
    __device__ __forceinline__ void comp(int heavy_, int xs_) { heavy = heavy_; xs = heavy_ > 0 ? xs_ : 0; }
    __device__ __forceinline__ bool next(int i, Unit& u) const {
        long L = (long)i * G + c;
        if (xs > 0) { const long base = (long)xs * (G - heavy); L = (c < heavy) ? base + (long)i * G + c : (i < xs ? (long)i * (G - heavy) + (c - heavy) : base + (long)(i - xs) * G + c); }
        if (L >= nwg) return false;
        int wgid = (int)L; { const int q = nwg / NXCD, r = nwg % NXCD, xcd = wgid % NXCD, off = wgid / NXCD; wgid = (xcd < r ? xcd * (q + 1) : r * (q + 1) + (xcd - r) * q) + off; }
        const int nig = WGM * nN, gid = wgid / nig, fm = gid * WGM, gsz = (nM - fm) < WGM ? (nM - fm) : WGM;
        u.pm = fm + ((wgid % nig) % gsz); u.pn = (wgid % nig) / gsz; return true;
    }
};

template <class Epi, class Sched, bool GATHER, bool FP8>
__device__ __forceinline__ void gemm_phase(LAS unsigned char* lds, LAS float* rs_lds, const int K, const int lda, const int ldb, const Sched& S, const Epi& E, const int wave_s) {
    int tid = tid_of(wave_s); asm volatile("" : "+v"(tid));
    const int wid = __builtin_amdgcn_readfirstlane(tid >> 6), lane = tid & 63, wr = wid >> 2, wc = wid & 3, fr = lane & 15, fq = lane >> 4;
    int K_ = K; asm volatile("" : "+s"(K_)); const int nt = K_ / BK;
    int sR[2], sC[2];
    unsigned voffB[2], vA[2][2], vN[2][2];
#pragma unroll
    for (int i = 0; i < 2; ++i) { stage_rc(tid * 16 + i * 8192, sR[i], sC[i]); const int Rb = Epi::PERM ? ((sR[i] & ~31) + perm32(sR[i] & 31)) : sR[i];
        voffB[i] = (unsigned)(Rb * ldb + sC[i]) * 2u; }
    const size_t kstep = (size_t)(BK * 2);
    const size_t hstepB = (size_t)HALF * ldb * 2;
    const unsigned ldsw = (unsigned)wid * 1024u;
    const int aoff = lds_byte(wr * 64 + fr, fq * 8), boff = lds_byte(wc * 32 + fr, fq * 8);
#define PG8_SA(b, h) (((b) * 2 + (h)) * HTB)
#define PG8_SB(b, h) ((4 + (b) * 2 + (h)) * HTB)
#define PG8_STAGE(bufoff, gbase, voff) do { _Pragma("unroll") for (int _i = 0; _i < 2; ++_i) \
        __builtin_amdgcn_global_load_lds((const unsigned*)((const char*)(gbase) + (voff)[_i]), (LAS unsigned*)(lds + (bufoff) + ldsw + _i * 8192), 16, 0, 0); } while (0)
#define PG8_LD2(p) __builtin_shufflevector(*(const LAS v4i_t*)(p), *(const LAS v4i_t*)((p) + 1024), 0, 1, 2, 3, 4, 5, 6, 7)
#define PG8_LDA(dst, b, h) do { _Pragma("unroll") for (int m = 0; m < 4; ++m) dst[m] = PG8_LD2(lds + PG8_SA(b, h) + aoff + m * 2048); } while (0)
#define PG8_LDB(dst, b, h) do { _Pragma("unroll") for (int n = 0; n < 2; ++n) dst[n] = PG8_LD2(lds + PG8_SB(b, h) + boff + n * 2048); } while (0)
#define PG8_HALF(x, k) __builtin_bit_cast(bf16x8, __builtin_shufflevector(x, x, 4 * (k), 4 * (k) + 1, 4 * (k) + 2, 4 * (k) + 3))
#define PG8_MMA(ai, bj, At, Bt) do { __builtin_amdgcn_s_setprio(1); _Pragma("unroll") for (int m = 0; m < 4; ++m) _Pragma("unroll") for (int n = 0; n < 2; ++n) { \
        if constexpr (FP8) asm volatile("v_mfma_scale_f32_16x16x128_f8f6f4 %0, %1, %2, %0, %3, %3 op_sel_hi:[0,0,0]" : "+v"(acc[ai][bj][m][n]) : "v"(Bt[n]), "v"(At[m]), "v"(sc127));        \
        else { acc[ai][bj][m][n] = __builtin_amdgcn_mfma_f32_16x16x32_bf16(PG8_HALF(Bt[n], 0), PG8_HALF(At[m], 0), acc[ai][bj][m][n], 0, 0, 0); \
               acc[ai][bj][m][n] = __builtin_amdgcn_mfma_f32_16x16x32_bf16(PG8_HALF(Bt[n], 1), PG8_HALF(At[m], 1), acc[ai][bj][m][n], 0, 0, 0); } } __builtin_amdgcn_s_setprio(0); } while (0)
#define PG8_WAIT_V(n) asm volatile("s_waitcnt vmcnt(" #n ")" ::: "memory")
#define PG8_WAIT_L(n) asm volatile("s_waitcnt lgkmcnt(" #n ")" ::: "memory")
#define PG8_BAR __builtin_amdgcn_s_barrier()
#define PG8_SCHED __builtin_amdgcn_sched_barrier(0)
#define PG8_AOFFS(dst, u) do { _Pragma("unroll") for (int _h = 0; _h < 2; ++_h) _Pragma("unroll") for (int _i = 0; _i < 2; ++_i) { \
        if constexpr (GATHER) dst[_h][_i] = (unsigned)(S.arow(u, _h * HALF + sR[_i]) * lda + sC[_i]) * 2u; else dst[_h][_i] = (unsigned)((_h * HALF + sR[_i]) * lda + sC[_i]) * 2u; } } while (0)
    Unit cur, nxt; int ui = 0;
    if (!S.next(0, cur)) return;
    f32x4 acc[2][2][4][2];
#pragma unroll
    for (int a = 0; a < 2; ++a)
#pragma unroll
        for (int b = 0; b < 2; ++b)
#pragma unroll
            for (int m = 0; m < 4; ++m)
#pragma unroll
                for (int n = 0; n < 2; ++n) acc[a][b][m][n] = (f32x4){0.f, 0.f, 0.f, 0.f};
    v8i_t At[4], B0[2], B1[2]; const int sc127 = 0x7f7f7f7f; (void)sc127;
    const char* cA = S.abase(cur); const char* cB = S.bbase(cur);
    PG8_AOFFS(vA, cur);
    PG8_STAGE(PG8_SB(0, 0), cB, voffB); PG8_STAGE(PG8_SB(0, 1), cB + hstepB, voffB); PG8_STAGE(PG8_SA(0, 0), cA, vA[0]); PG8_STAGE(PG8_SA(0, 1), cA, vA[1]);
    if (wr == 1) PG8_BAR;
    PG8_WAIT_V(2); PG8_BAR;
    PG8_STAGE(PG8_SB(1, 0), cB + kstep, voffB); PG8_STAGE(PG8_SA(1, 0), cA + kstep, vA[0]); PG8_STAGE(PG8_SB(1, 1), cB + hstepB + kstep, voffB);
    PG8_WAIT_V(6); PG8_BAR;
    for (;;) {
        const bool has_next = S.next(ui + 1, nxt);
        const char* nA = cA; const char* nB = cB;
#pragma unroll
        for (int _h = 0; _h < 2; ++_h)
#pragma unroll
            for (int _i = 0; _i < 2; ++_i) vN[_h][_i] = vA[_h][_i];
        if (has_next) { nA = S.abase(nxt); nB = S.bbase(nxt); if constexpr (GATHER) { PG8_AOFFS(vN, nxt); } }
        for (int t = 0; t < nt; t += 2) {
            const bool last = (t == nt - 2);
            const char* a1 = cA + (size_t)(t + 1) * kstep;
            const char* a2 = last ? nA : cA + (size_t)(t + 2) * kstep; const char* b2 = last ? nB : cB + (size_t)(t + 2) * kstep;
            const char* a3 = a2 + kstep; const char* b3 = b2 + kstep;
            unsigned o2[2][2];
#pragma unroll
            for (int _h = 0; _h < 2; ++_h)
#pragma unroll
                for (int _i = 0; _i < 2; ++_i) o2[_h][_i] = (GATHER && last) ? vN[_h][_i] : vA[_h][_i];
            PG8_LDB(B0, 0, 0); PG8_LDB(B1, 0, 1); PG8_SCHED; PG8_LDA(At, 0, 0); PG8_STAGE(PG8_SA(1, 1), a1, vA[1]);
            PG8_WAIT_V(8); PG8_WAIT_L(0); PG8_BAR; PG8_MMA(0, 0, At, B0); PG8_MMA(0, 1, At, B1); PG8_BAR; PG8_SCHED;
            PG8_LDA(At, 0, 1); PG8_STAGE(PG8_SB(0, 0), b2, voffB); PG8_STAGE(PG8_SB(0, 1), b2 + hstepB, voffB); PG8_STAGE(PG8_SA(0, 0), a2, o2[0]);
            PG8_WAIT_V(8); PG8_WAIT_L(0); PG8_BAR; PG8_MMA(1, 0, At, B0); PG8_MMA(1, 1, At, B1); PG8_BAR; PG8_SCHED;
            PG8_LDB(B0, 1, 0); PG8_LDB(B1, 1, 1); PG8_SCHED; PG8_LDA(At, 1, 0); PG8_STAGE(PG8_SA(0, 1), a2, o2[1]);
            PG8_WAIT_V(8); PG8_WAIT_L(0); PG8_BAR; PG8_MMA(0, 0, At, B0); PG8_MMA(0, 1, At, B1); PG8_BAR; PG8_SCHED;
            PG8_LDA(At, 1, 1); PG8_STAGE(PG8_SB(1, 0), b3, voffB); PG8_STAGE(PG8_SB(1, 1), b3 + hstepB, voffB); PG8_STAGE(PG8_SA(1, 0), a3, o2[0]);
            PG8_WAIT_V(8); PG8_WAIT_L(0); PG8_BAR; PG8_MMA(1, 0, At, B0); PG8_MMA(1, 1, At, B1); PG8_BAR; PG8_SCHED;
        }
        if (wr == 0) PG8_BAR;
        E(acc, cur, wr, wc, fr, fq);
#if defined(EPI_DUP) && EPI_DUP
        if constexpr (Epi::IDEMP) { asm volatile("" : "+v"(acc[0][0][0][0]), "+v"(acc[0][1][0][0]), "+v"(acc[1][0][0][0]), "+v"(acc[1][1][0][0]) :: "memory"); E(acc, cur, wr, wc, fr, fq); }
#endif
        if (!has_next) break;
#pragma unroll
        for (int a = 0; a < 2; ++a)
#pragma unroll
            for (int b = 0; b < 2; ++b)
#pragma unroll
                for (int m = 0; m < 4; ++m)
#pragma unroll
                    for (int n = 0; n < 2; ++n) { f32x2 z0, z1; asm volatile("v_mov_b64 %0, 0\n\tv_mov_b64 %1, 0" : "=v"(z0), "=v"(z1)); acc[a][b][m][n] = __builtin_shufflevector(z0, z1, 0, 1, 2, 3); }
        cur = nxt; cA = nA; cB = nB; ++ui;
#pragma unroll
        for (int _h = 0; _h < 2; ++_h)
#pragma unroll
            for (int _i = 0; _i < 2; ++_i) vA[_h][_i] = vN[_h][_i];
        if (wr == 1) PG8_BAR;
    }
    PG8_WAIT_V(0);
    PG8_BAR;
#undef PG8_SA
#undef PG8_SB
#undef PG8_STAGE
#undef PG8_LDA
#undef PG8_LDB
#undef PG8_MMA
#undef PG8_LD2
#undef PG8_HALF
#undef PG8_WAIT_V
#undef PG8_WAIT_L
#undef PG8_BAR
#undef PG8_SCHED
#undef PG8_AOFFS
}
}

namespace attn_body {
using bf16 = __hip_bfloat16;
using s16x4 = __attribute__((ext_vector_type(4))) short;
using f32x16 = __attribute__((ext_vector_type(16))) float;
constexpr int D64 = 64, DM = 1024, OPITCH = 2048;
constexpr int NW = 8, QBLK = 32, QB = QBLK * NW, KVBLK = 64, NQB = SEQ / QB;
__device__ __forceinline__ int crow(int r, int hi) { return (r & 3) + 8 * (r >> 2) + 4 * hi; }
#define SBAR() __builtin_amdgcn_sched_barrier(0)
__device__ __forceinline__ void cmask(f32x16& p0, f32x16& p1, int jb, int qrel, int hi) {
  const float NEG = -INFINITY; int kb = 64 * jb + 4 * hi;
  #pragma unroll
  for (int r = 0; r < 16; ++r) { int kv = kb + (r & 3) + 8 * (r >> 2); if (kv > qrel) p0[r] = NEG; if (kv + 32 > qrel) p1[r] = NEG; }
}
constexpr int NSLOT = 3, SLOTB = 8192;
constexpr int LDS_K = 0, LDS_V = NSLOT * SLOTB, LDS_WS = 2 * NSLOT * SLOTB, LDS_OST = LDS_WS + NW * 64 * 4, LDS_BYTES = LDS_OST + NW * 4096;
__device__ __forceinline__ void glds16(const void* gsrc, unsigned lds_dst) { unsigned keep;
  asm volatile("s_mov_b32 %0, m0\n\ts_mov_b32 m0, %2\n\ts_nop 0\n\tglobal_load_lds_dwordx4 %1, off\n\ts_mov_b32 m0, %0" : "=&s"(keep) : "v"(gsrc), "s"(lds_dst) : "memory"); }
__device__ __forceinline__ float max3f(float a, float b, float c) { float r; asm("v_max3_f32 %0, %1, %2, %3" : "=v"(r) : "v"(a), "v"(b), "v"(c)); return r; }
__device__ __forceinline__ float max2f(float a, float b) { float r; asm("v_max_f32_e32 %0, %1, %2" : "=v"(r) : "v"(a), "v"(b)); return r; }
__device__ __forceinline__ float fadd_s(float a, float b) { float r; asm("v_add_f32_e32 %0, %1, %2" : "=v"(r) : "v"(a), "v"(b)); return r; }
__device__ __forceinline__ float fsub_s(float a, float b) { float r; asm("v_sub_f32_e32 %0, %1, %2" : "=v"(r) : "v"(a), "v"(b)); return r; }
typedef float f32x2_t __attribute__((ext_vector_type(2))); typedef __bf16 bf16x2_t __attribute__((ext_vector_type(2)));
__device__ __forceinline__ unsigned cvtpk_s(float lo, float hi) { f32x2_t v = {lo, hi}; bf16x2_t b = __builtin_convertvector(v, bf16x2_t); return __builtin_bit_cast(unsigned, b); }
#define WAIT_BAR(N) asm volatile("s_waitcnt vmcnt(" #N ") lgkmcnt(0)\n\ts_barrier" ::: "memory")

__device__ __forceinline__ void qkt(f32x16& p0, f32x16& p1, const char* Kslot, const bf16x8* qr, const f32x16& negm, int r32, int hi) {
  const char* kb = Kslot + hi * 1024 + r32 * 16;
  #pragma unroll
  for (int d0 = 0; d0 < 4; ++d0) {
    const bf16x8 b0 = *reinterpret_cast<const bf16x8*>(kb + d0 * 2048);
    const bf16x8 b1 = *reinterpret_cast<const bf16x8*>(kb + d0 * 2048 + 512);
    if (d0 == 0) { p0 = __builtin_amdgcn_mfma_f32_32x32x16_bf16(b0, qr[0], negm, 0, 0, 0); p1 = __builtin_amdgcn_mfma_f32_32x32x16_bf16(b1, qr[0], negm, 0, 0, 0); }
    else { p0 = __builtin_amdgcn_mfma_f32_32x32x16_bf16(b0, qr[d0], p0, 0, 0, 0); p1 = __builtin_amdgcn_mfma_f32_32x32x16_bf16(b1, qr[d0], p1, 0, 0, 0); } }
}
typedef __attribute__((address_space(3))) const char* lds_cptr;
typedef short v4i16_t __attribute__((ext_vector_type(4)));
__device__ __forceinline__ void kload8(bf16x8* kf, lds_cptr kp) {
  kf[0] = *(const __attribute__((address_space(3))) bf16x8*)(kp);        kf[1] = *(const __attribute__((address_space(3))) bf16x8*)(kp + 512);
  kf[2] = *(const __attribute__((address_space(3))) bf16x8*)(kp + 2048); kf[3] = *(const __attribute__((address_space(3))) bf16x8*)(kp + 2560);
  kf[4] = *(const __attribute__((address_space(3))) bf16x8*)(kp + 4096); kf[5] = *(const __attribute__((address_space(3))) bf16x8*)(kp + 4608);
  kf[6] = *(const __attribute__((address_space(3))) bf16x8*)(kp + 6144); kf[7] = *(const __attribute__((address_space(3))) bf16x8*)(kp + 6656);
}
__device__ __forceinline__ void kload2(bf16x8* kf, lds_cptr kp, int j) { kf[2 * j] = *(const __attribute__((address_space(3))) bf16x8*)(kp + j * 2048); kf[2 * j + 1] = *(const __attribute__((address_space(3))) bf16x8*)(kp + j * 2048 + 512); }
__device__ __forceinline__ s16x4 vtr(lds_cptr p) { return __builtin_bit_cast(s16x4, __builtin_amdgcn_ds_read_tr16_b64_v4i16((__attribute__((address_space(3))) v4i16_t*)p)); }
__device__ __forceinline__ float rowmax(const f32x16& p0, const f32x16& p1) {
  float a = max3f(p0[0], p0[1], p1[0]), b = max3f(p0[2], p0[3], p1[1]); a = max3f(a, p1[2], p1[3]);
  #pragma unroll
  for (int r = 4; r < 16; r += 4) { a = max3f(a, p0[r], p0[r + 1]); b = max3f(b, p0[r + 2], p0[r + 3]); a = max3f(a, p1[r], p1[r + 1]); b = max3f(b, p1[r + 2], p1[r + 3]); }
  const float m = max2f(a, b);
  auto rr = __builtin_amdgcn_permlane32_swap(__float_as_uint(m), __float_as_uint(m), false, false);
  return max2f(__uint_as_float(rr[0]), __uint_as_float(rr[1]));
}
__device__ __forceinline__ void pv(f32x16* o, int vb, bf16x8 pa0, bf16x8 pa1, bf16x8 pa2, bf16x8 pa3) {
  #pragma unroll
  for (int d0 = 0; d0 < 2; ++d0) { s16x4 lo[4], hi[4];
    #pragma unroll
    for (int ks = 0; ks < 4; ++ks) {
      asm volatile("ds_read_b64_tr_b16 %0,%1 offset:%c2" : "=&v"(lo[ks]) : "v"(vb), "i"(d0 * 4096 + ks * 1024) : "memory");
      asm volatile("ds_read_b64_tr_b16 %0,%1 offset:%c2" : "=&v"(hi[ks]) : "v"(vb), "i"(d0 * 4096 + ks * 1024 + 512) : "memory"); }
    asm volatile("s_waitcnt lgkmcnt(0)" ::: "memory"); SBAR();
    #define PK(k) (bf16x8){lo[k][0], lo[k][1], lo[k][2], lo[k][3], hi[k][0], hi[k][1], hi[k][2], hi[k][3]}
    o[d0] = __builtin_amdgcn_mfma_f32_32x32x16_bf16(pa0, PK(0), o[d0], 0, 0, 0);
    o[d0] = __builtin_amdgcn_mfma_f32_32x32x16_bf16(pa1, PK(1), o[d0], 0, 0, 0);
    o[d0] = __builtin_amdgcn_mfma_f32_32x32x16_bf16(pa2, PK(2), o[d0], 0, 0, 0);
    o[d0] = __builtin_amdgcn_mfma_f32_32x32x16_bf16(pa3, PK(3), o[d0], 0, 0, 0);
    #undef PK
  }
}
#define ATTN_STORE16(p, v) (*(u32x4*)(p) = (v))
template<int THRL> __device__ __forceinline__ void attn_unit(int b, int qcol, int vcol, int ocol, int qb, const bf16* Q, const bf16* __restrict__ K, const bf16* __restrict__ V, bf16* O, char* shm, const int wave_s) {
  int tid = tid_of(wave_s); asm volatile("" : "+v"(tid)); const int lane = tid & 63, r32 = lane & 31, hi = lane >> 5; const int wid = __builtin_amdgcn_readfirstlane(tid >> 6);
  const long rowbase = (long)b * SEQ; const int q0 = qb * QB;
  const bf16* Qw = Q + (rowbase + q0 + wid * QBLK) * DM + qcol;
  const bf16* Kh = K + rowbase * DM + qcol, *Vh = V + rowbase * DM + vcol;
  const unsigned lds0 = (unsigned)(uintptr_t)shm;
  float* wsf = (float*)(shm + LDS_WS) + wid * 64;
  const bf16* ksrc = Kh + (long)lane * DM + wid * 8;
  const bf16* vsrc = Vh + (long)(16 * (wid & 3) + (lane >> 2)) * DM + (wid >> 2) * 32 + (lane & 3) * 8;
  const unsigned kdst = lds0 + LDS_K + wid * 1024, vdst = lds0 + LDS_V + wid * 1024;
  #define DMA_K(t, slot) glds16(ksrc + (long)(t) * KVBLK * DM, (unsigned)__builtin_amdgcn_readfirstlane(kdst + (slot)))
  #define DMA_V(t, slot) glds16(vsrc + (long)(t) * KVBLK * DM, (unsigned)__builtin_amdgcn_readfirstlane(vdst + (slot)))
  const int vb0 = (int)(lds0 + LDS_V) + ((lane >> 4) & 1) * 32 + (lane & 3) * 8 + (4 * hi + ((lane & 15) >> 2)) * 64;
  const char* Kbase = shm + LDS_K; bf16x8 kf[8];
  const lds_cptr shm3 = (lds_cptr)shm; const lds_cptr kp0 = shm3 + LDS_K + hi * 1024 + r32 * 16; const lds_cptr vp0 = shm3 + LDS_V + ((lane >> 4) & 1) * 32 + (lane & 3) * 8 + (4 * hi + ((lane & 15) >> 2)) * 64;
  const int NT = (q0 + QB) / KVBLK;
  DMA_K(0, 0); DMA_V(0, 0); DMA_K(1, SLOTB);
  bf16x8 qr[4];
  #pragma unroll
  for (int d0 = 0; d0 < 4; ++d0) qr[d0] = *reinterpret_cast<const bf16x8*>(&Qw[(long)r32 * DM + d0 * 16 + hi * 8]);
  float mhat = 0.f, l_reg = 0.f; f32x16 o[2]; o[0] = f32x16{}; o[1] = f32x16{}; f32x16 negm = f32x16{}; asm volatile("" : "+v"(negm));
  const int qrel = wid * QBLK + r32;
  #define CMASK(P0, P1, t) do { int jb_ = (t) - (NT - 4); if (jb_ >= 0) cmask(P0, P1, jb_, qrel, hi); } while (0)
  bool resc = false;
  #define START(P0, P1) do { const float rm = rowmax(P0, P1); resc = false; \
    { const float dl = rm; mhat = fadd_s(mhat, dl); \
      _Pragma("unroll") for (int r = 0; r < 16; ++r) { P0[r] = fsub_s(P0[r], dl); P1[r] = fsub_s(P1[r], dl); } \
      _Pragma("unroll") for (int r = 0; r < 16; ++r) negm[r] = -mhat; asm volatile("" : "+v"(negm)); } \
    _Pragma("unroll") for (int r = 0; r < 16; ++r) P0[r] = __builtin_amdgcn_exp2f(P0[r]); } while (0)
  #define RESC() do { if (resc) { asm volatile("s_waitcnt lgkmcnt(0)" ::: "memory"); \
      _Pragma("unroll") for (int d_ = 0; d_ < 2; ++d_) _Pragma("unroll") for (int r = 0; r < 16; ++r) o[d_][r] *= wsf[crow(r, hi)]; } } while (0)
  f32x16 pA0, pA1, pB0, pB1;
  int sl_prev = 0, sl_cur = 0, sl_next = SLOTB;
  #define ROT() do { sl_prev = sl_cur; sl_cur = sl_next; sl_next = (sl_next == (NSLOT - 1) * SLOTB) ? 0 : sl_next + SLOTB; } while (0)
  DMA_K(2, 2 * SLOTB);
  WAIT_BAR(3);
  qkt(pA0, pA1, Kbase, qr, negm, r32, hi); asm volatile("s_nop 15\n\ts_nop 7" : "+v"(pA0), "+v"(pA1)); CMASK(pA0, pA1, 0);
  START(pA0, pA1);
  _Pragma("unroll") for (int r = 0; r < 16; ++r) pA1[r] = __builtin_amdgcn_exp2f(pA1[r]);
  WAIT_BAR(0);
  DMA_K(3, 0); DMA_V(1, SLOTB);
  ROT();
  kload8(kf, kp0 + sl_cur);
  WAIT_BAR(2);
  s16x4 vlo[8], vhi[8]; u32x4 pw0, pw1, pw2, pw3;
  #define PKW(P, B) cvtpk_s(P[B], P[B + 1])
  #define PAF(k) __builtin_bit_cast(bf16x8, pw##k)
  #define VFR(i) (bf16x8){vlo[i][0], vlo[i][1], vlo[i][2], vlo[i][3], vhi[i][0], vhi[i][1], vhi[i][2], vhi[i][3]}
  #define PIN(x) asm volatile("" : "+v"(x))
  #define MX3(a, b, c) __builtin_fmaxf(__builtin_fmaxf((a), (b)), (c))
  #define GAPA(MF, A0, A1, A2, A3, W0, W1, PW) do { MF; sacc += A0; sacc += A1; sacc += A2; sacc += A3; PIN(sacc); W0; W1; PIN(PW); SBAR(); } while (0)
  #define EX(v) __builtin_amdgcn_exp2f(v)
  #define GAPB(MF, X, B) do { MF; X[B] = EX(X[B]); X[B + 1] = EX(X[B + 1]); X[B + 2] = EX(X[B + 2]); X[B + 3] = EX(X[B + 3]); PIN(X); SBAR(); } while (0)
  #define VRD(i) do { vlo[i] = vtr(vp_ + (((i) >> 2) * 4096 + ((i) & 3) * 1024)); vhi[i] = vtr(vp_ + (((i) >> 2) * 4096 + ((i) & 3) * 1024 + 512)); } while (0)
  #define KRD(G, j) do { if (G) { kload2(kf, kp0 + sl_next, j); SBAR(); } } while (0)
  #define STEP(C0, C1, P0, P1, t, GK, GV, GL) do { SBAR(); \
    const lds_cptr vp_ = vp0 + sl_prev; \
    VRD(0); SBAR(); float sacc = (P0[0] + P0[1]); \
    GAPA(C0 = __builtin_amdgcn_mfma_f32_32x32x16_bf16(kf[0], qr[0], negm, 0, 0, 0), P0[2], P0[3], P0[4], P0[5],     pw0[0] = PKW(P0, 0), pw0[1] = PKW(P0, 2), pw0); \
    VRD(4); SBAR(); GAPA(C1 = __builtin_amdgcn_mfma_f32_32x32x16_bf16(kf[1], qr[0], negm, 0, 0, 0), P0[6], P0[7], P0[8], P0[9],     pw0[2] = PKW(P0, 4), pw0[3] = PKW(P0, 6), pw0); \
    VRD(1); SBAR(); GAPA(C0 = __builtin_amdgcn_mfma_f32_32x32x16_bf16(kf[2], qr[1], C0, 0, 0, 0),   P0[10], P0[11], P0[12], P0[13], pw1[0] = PKW(P0, 8), pw1[1] = PKW(P0, 10), pw1); \
    VRD(5); SBAR(); GAPA(C1 = __builtin_amdgcn_mfma_f32_32x32x16_bf16(kf[3], qr[1], C1, 0, 0, 0),   P0[14], P0[15], P1[0], P1[1],   pw1[2] = PKW(P0, 12), pw1[3] = PKW(P0, 14), pw1); \
    VRD(2); SBAR(); GAPA(C0 = __builtin_amdgcn_mfma_f32_32x32x16_bf16(kf[4], qr[2], C0, 0, 0, 0),   P1[2], P1[3], P1[4], P1[5],     pw2[0] = PKW(P1, 0), pw2[1] = PKW(P1, 2), pw2); \
    VRD(6); SBAR(); GAPA(C1 = __builtin_amdgcn_mfma_f32_32x32x16_bf16(kf[5], qr[2], C1, 0, 0, 0),   P1[6], P1[7], P1[8], P1[9],     pw2[2] = PKW(P1, 4), pw2[3] = PKW(P1, 6), pw2); \
    VRD(3); SBAR(); GAPA(C0 = __builtin_amdgcn_mfma_f32_32x32x16_bf16(kf[6], qr[3], C0, 0, 0, 0),   P1[10], P1[11], P1[12], P1[13], pw3[0] = PKW(P1, 8), pw3[1] = PKW(P1, 10), pw3); \
    VRD(7); SBAR(); GAPA(C1 = __builtin_amdgcn_mfma_f32_32x32x16_bf16(kf[7], qr[3], C1, 0, 0, 0),   P1[14], P1[15], 0.f, 0.f,       pw3[2] = PKW(P1, 12), pw3[3] = PKW(P1, 14), pw3); \
    l_reg += sacc; \
    if (GK) { DMA_K((t) + 3, sl_cur); } if (GV) { DMA_V((t) + 1, sl_next); } \
    CMASK(C0, C1, t); \
    { float a = MX3(C0[0], C0[1], C1[0]), b = MX3(C0[2], C0[3], C1[1]); a = MX3(a, C1[2], C1[3]); \
      _Pragma("unroll") for (int r = 4; r < 16; r += 4) { a = MX3(a, C0[r], C0[r + 1]); b = MX3(b, C0[r + 2], C0[r + 3]); a = MX3(a, C1[r], C1[r + 1]); b = MX3(b, C1[r + 2], C1[r + 3]); } \
      float rm = __builtin_fmaxf(a, b); { auto rr = __builtin_amdgcn_permlane32_swap(__float_as_uint(rm), __float_as_uint(rm), false, false); rm = __builtin_fmaxf(__uint_as_float(rr[0]), __uint_as_float(rr[1])); } \
      resc = false; \
      if (__builtin_expect(__any(rm > (float)THRL), 0)) { const float dl = __builtin_fmaxf(rm, 0.f); mhat += dl; \
        _Pragma("unroll") for (int r = 0; r < 16; ++r) { C0[r] -= dl; C1[r] -= dl; } \
        _Pragma("unroll") for (int r = 0; r < 16; ++r) negm[r] = -mhat; asm volatile("" : "+v"(negm)); \
        const float f = __builtin_amdgcn_exp2f(-dl); l_reg *= f; if (hi == 0) wsf[r32] = f; resc = true; } } \
    SBAR(); \
    GAPB(o[0] = __builtin_amdgcn_mfma_f32_32x32x16_bf16(PAF(0), VFR(0), o[0], 0, 0, 0), C0, 0); \
    GAPB(o[1] = __builtin_amdgcn_mfma_f32_32x32x16_bf16(PAF(0), VFR(4), o[1], 0, 0, 0), C0, 4); \
    KRD(GL, 0); GAPB(o[0] = __builtin_amdgcn_mfma_f32_32x32x16_bf16(PAF(1), VFR(1), o[0], 0, 0, 0), C0, 8); \
    KRD(GL, 1); GAPB(o[1] = __builtin_amdgcn_mfma_f32_32x32x16_bf16(PAF(1), VFR(5), o[1], 0, 0, 0), C0, 12); \
    KRD(GL, 2); GAPB(o[0] = __builtin_amdgcn_mfma_f32_32x32x16_bf16(PAF(2), VFR(2), o[0], 0, 0, 0), C1, 0); \
    KRD(GL, 3); GAPB(o[1] = __builtin_amdgcn_mfma_f32_32x32x16_bf16(PAF(2), VFR(6), o[1], 0, 0, 0), C1, 4); \
    GAPB(o[0] = __builtin_amdgcn_mfma_f32_32x32x16_bf16(PAF(3), VFR(3), o[0], 0, 0, 0), C1, 8); \
    GAPB(o[1] = __builtin_amdgcn_mfma_f32_32x32x16_bf16(PAF(3), VFR(7), o[1], 0, 0, 0), C1, 12); \
    } while (0)
  int t = 1;
  #undef CMASK
  #define CMASK(P0, P1, t) do {} while (0)
  for (; t + 5 < NT; t += 2) {
    STEP(pB0, pB1, pA0, pA1, t, true, true, true);     WAIT_BAR(2); RESC(); ROT();
    STEP(pA0, pA1, pB0, pB1, t + 1, true, true, true);   WAIT_BAR(2); RESC(); ROT();
  }
  #undef CMASK
  #define CMASK(P0, P1, t) do { int jb_ = (t) - (NT - 4); if (jb_ >= 0) cmask(P0, P1, jb_, qrel, hi); } while (0)
  #define ENDW(tt) do { if ((tt) + 3 < NT) { WAIT_BAR(2); } else if ((tt) + 2 < NT) { WAIT_BAR(1); } else { WAIT_BAR(0); } } while (0)
  for (; t + 1 < NT; t += 2) {
    STEP(pB0, pB1, pA0, pA1, t, (t + 3 < NT), (t + 1 < NT), (t + 1 < NT));       ENDW(t);   RESC(); ROT();
    STEP(pA0, pA1, pB0, pB1, t + 1, (t + 4 < NT), (t + 2 < NT), (t + 2 < NT));     ENDW(t + 1); RESC(); ROT();
  }
  STEP(pB0, pB1, pA0, pA1, NT - 1, false, false, false); RESC();
  { float sacc = pB0[0] + pB0[1]; _Pragma("unroll") for (int r = 2; r < 16; ++r) sacc += pB0[r]; _Pragma("unroll") for (int r = 0; r < 16; ++r) sacc += pB1[r]; l_reg += sacc;
    pw0 = (u32x4){PKW(pB0, 0), PKW(pB0, 2), PKW(pB0, 4), PKW(pB0, 6)}; pw1 = (u32x4){PKW(pB0, 8), PKW(pB0, 10), PKW(pB0, 12), PKW(pB0, 14)}; pw2 = (u32x4){PKW(pB1, 0), PKW(pB1, 2), PKW(pB1, 4), PKW(pB1, 6)}; pw3 = (u32x4){PKW(pB1, 8), PKW(pB1, 10), PKW(pB1, 12), PKW(pB1, 14)};
    SBAR(); pv(o, vb0 + sl_cur, PAF(0), PAF(1), PAF(2), PAF(3)); }
  #undef PKW
  #undef PAF
  #undef VFR
  #undef PIN
  #undef MX3
  #undef GAPA
  #undef GAPB
  #undef EX
  #undef VRD
  #undef KRD
  #undef STEP
  #undef ENDW
  { auto rr = __builtin_amdgcn_permlane32_swap(__float_as_uint(l_reg), __float_as_uint(l_reg), false, false); l_reg = __uint_as_float(rr[0]) + __uint_as_float(rr[1]); }
  if (hi == 0) wsf[32 + r32] = l_reg; asm volatile("s_waitcnt lgkmcnt(0)" ::: "memory");
  float rli[16];
  #pragma unroll
  for (int r = 0; r < 16; ++r) rli[r] = __builtin_amdgcn_rcpf(wsf[32 + crow(r, hi)]);
  bf16* Ow = O + (rowbase + q0 + wid * QBLK) * OPITCH + ocol;
  { bf16* stg = (bf16*)(shm + LDS_OST) + wid * 2048;
    #pragma unroll
    for (int r = 0; r < 16; ++r) { const int orow = crow(r, hi);
      #pragma unroll
      for (int d0 = 0; d0 < 2; ++d0) stg[orow * 64 + d0 * 32 + r32] = __float2bfloat16(o[d0][r] * rli[r]); }
    asm volatile("s_waitcnt lgkmcnt(0)" ::: "memory");
    #pragma unroll
    for (int i = 0; i < 4; ++i) { const int row = i * 8 + (lane >> 3), ch = lane & 7; const u32x4 v = *(const u32x4*)(stg + row * 64 + ch * 8); ATTN_STORE16(Ow + (long)row * OPITCH + ch * 8, v); } }
  asm volatile("s_waitcnt lgkmcnt(0)\n\ts_barrier" ::: "memory");
  #undef DMA_K
  #undef DMA_V
  #undef CMASK
  #undef START
  #undef RESC
  #undef ROT
}
constexpr int PS_QB = 128, PS_LK = 0, PS_LV = 3 * 8192, PS_VSLOT = 16384, PS_LP = PS_LV + 4 * PS_VSLOT, PS_PSLOT = 16384, PS_LF = PS_LP + 2 * PS_PSLOT, PS_BYTES = PS_LF + 4 * 512;
#define WAIT_BAR(N) asm volatile("s_waitcnt vmcnt(" #N ") lgkmcnt(0)\n\ts_barrier" ::: "memory")
#define SBAR() __builtin_amdgcn_sched_barrier(0)
template<int THRL, int MODE> __device__ __forceinline__ void attn_unit_ps(int b, int qcol, int vcol, int ocol, int qb, const bf16* Q, const bf16* __restrict__ K, const bf16* __restrict__ V, bf16* O, char* shm, const int wave_s, f32x16 (&keep)[4], const float lam) {
  int tid = tid_of(wave_s); asm volatile("" : "+v"(tid)); const int lane = tid & 63, r32 = lane & 31, hi = lane >> 5; const int wid = __builtin_amdgcn_readfirstlane(tid >> 6);
  const int role = wid >> 2, w = wid & 3;
  const long rowbase = (long)b * SEQ; const int q0 = qb * PS_QB;
  const bf16* Kh = K + rowbase * DM + qcol, *Vh = V + rowbase * DM + vcol;
  const unsigned lds0 = (unsigned)(uintptr_t)shm;
  const lds_cptr shm3 = (lds_cptr)shm;
  const bf16* ksrc = Kh + (long)lane * DM + wid * 8;
  const bf16* vsrc0 = Vh + (long)(16 * (wid & 3) + (lane >> 2)) * DM + (wid >> 2) * 32 + (lane & 3) * 8;
  const unsigned kdst = lds0 + PS_LK + wid * 1024, vdst = lds0 + PS_LV + wid * 1024;
  #define DMA_K(t, slot) glds16(ksrc + (long)(t) * KVBLK * DM, (unsigned)__builtin_amdgcn_readfirstlane(kdst + (slot)))
  #define DMA_V(t, slot) do { glds16(vsrc0 + (long)(t) * KVBLK * DM, (unsigned)__builtin_amdgcn_readfirstlane(vdst + (slot))); glds16(vsrc0 + (long)(t) * KVBLK * DM + 64, (unsigned)__builtin_amdgcn_readfirstlane(vdst + (slot) + 8192)); } while (0)
  const int NT = (q0 + PS_QB) / KVBLK;
  int ks_prev = 0, ks_cur = 0, ks_next = 8192;
  #define KROT() do { ks_prev = ks_cur; ks_cur = ks_next; ks_next = (ks_next == 2 * 8192) ? 0 : ks_next + 8192; } while (0)
  #define VSL(t) ((((t)) & 3) * PS_VSLOT)
  LAS float* fw = (LAS float*)((LAS char*)shm3 + PS_LF + w * 512);
  LAS unsigned* flagw = (LAS unsigned*)((LAS char*)shm3 + PS_LF + w * 512 + 256);
  const lds_cptr vfrag0 = shm3 + PS_LV + ((lane >> 4) & 1) * 32 + (lane & 3) * 8 + (4 * hi + ((lane & 15) >> 2)) * 64;
  LAS char* pbase = (LAS char*)shm3 + PS_LP + w * 4096 + lane * 16;
  DMA_K(0, 0); DMA_V(0, VSL(0)); DMA_K(1, 8192);
  if (role == 0) {
    const bf16* Qw = Q + (rowbase + q0 + w * QBLK) * DM + qcol;
    const lds_cptr kp0 = shm3 + PS_LK + hi * 1024 + r32 * 16;
    const char* Kbase = shm + PS_LK; bf16x8 kf[8];
    bf16x8 qr[4];
    #pragma unroll
    for (int d0 = 0; d0 < 4; ++d0) qr[d0] = *reinterpret_cast<const bf16x8*>(&Qw[(long)r32 * DM + d0 * 16 + hi * 8]);
    float mhat = 0.f, l_reg = 0.f; f32x16 negm = f32x16{}; asm volatile("" : "+v"(negm));
    const int qrel = w * QBLK + r32;
    #define CMASK(P0, P1, t) do { int jb_ = (t) - (NT - 2); if (jb_ >= 0) cmask(P0, P1, jb_, qrel, hi); } while (0)
    bool resc = false;
    #define START(P0, P1) do { const float rm = rowmax(P0, P1); resc = false; \
      { const float dl = rm; mhat = fadd_s(mhat, dl); \
        _Pragma("unroll") for (int r = 0; r < 16; ++r) { P0[r] = fsub_s(P0[r], dl); P1[r] = fsub_s(P1[r], dl); } \
        _Pragma("unroll") for (int r = 0; r < 16; ++r) negm[r] = -mhat; asm volatile("" : "+v"(negm)); } \
      _Pragma("unroll") for (int r = 0; r < 16; ++r) P0[r] = __builtin_amdgcn_exp2f(P0[r]); } while (0)
    #define RESC(par) do {} while (0)
    f32x16 pA0, pA1, pB0, pB1;
    DMA_K(2, 2 * 8192);
    WAIT_BAR(4);
    qkt(pA0, pA1, Kbase, qr, negm, r32, hi); asm volatile("s_nop 15\n\ts_nop 7" : "+v"(pA0), "+v"(pA1)); CMASK(pA0, pA1, 0);
    START(pA0, pA1);
    _Pragma("unroll") for (int r = 0; r < 16; ++r) pA1[r] = __builtin_amdgcn_exp2f(pA1[r]);
    WAIT_BAR(0);
    DMA_K(3, 0); DMA_V(1, VSL(1));
    KROT();
    kload8(kf, kp0 + ks_cur);
    WAIT_BAR(3);
    u32x4 pw0, pw1, pw2, pw3;
    #define PKW(P, B) cvtpk_s(P[B], P[B + 1])
    #define PAF(k) __builtin_bit_cast(bf16x8, pw##k)
    #define VFR(i) (bf16x8){vlo[i][0], vlo[i][1], vlo[i][2], vlo[i][3], vhi[i][0], vhi[i][1], vhi[i][2], vhi[i][3]}
    #define PIN(x) asm volatile("" : "+v"(x))
    #define MX3(a, b, c) __builtin_fmaxf(__builtin_fmaxf((a), (b)), (c))
    #define GAPA(MF, A0, A1, A2, A3, W0, W1, PW) do { MF; sacc += A0; sacc += A1; sacc += A2; sacc += A3; PIN(sacc); W0; W1; PIN(PW); SBAR(); } while (0)
    #define EX(v) __builtin_amdgcn_exp2f(v)
    #define GAPB(X, B) do { X[B] = EX(X[B]); X[B + 1] = EX(X[B + 1]); X[B + 2] = EX(X[B + 2]); X[B + 3] = EX(X[B + 3]); PIN(X); SBAR(); } while (0)
    #define VRD(i) do {} while (0)
    #define KRD(j) do { kload2(kf, kp0 + ks_next, j); SBAR(); } while (0)
    #define PUB(k) (*(LAS u32x4*)(pp_ + (k) * 1024) = pw##k)
    #define STEP(C0, C1, P0, P1, t) do { SBAR(); \
      LAS char* pp_ = pbase + ((t) & 1) * PS_PSLOT; \
      VRD(0); SBAR(); float sacc = (P0[0] + P0[1]); \
      GAPA(C0 = __builtin_amdgcn_mfma_f32_32x32x16_bf16(kf[0], qr[0], negm, 0, 0, 0), P0[2], P0[3], P0[4], P0[5],     pw0[0] = PKW(P0, 0), pw0[1] = PKW(P0, 2), pw0); \
      VRD(4); SBAR(); GAPA(C1 = __builtin_amdgcn_mfma_f32_32x32x16_bf16(kf[1], qr[0], negm, 0, 0, 0), P0[6], P0[7], P0[8], P0[9],     pw0[2] = PKW(P0, 4), pw0[3] = PKW(P0, 6), pw0); \
      PUB(0); VRD(1); SBAR(); GAPA(C0 = __builtin_amdgcn_mfma_f32_32x32x16_bf16(kf[2], qr[1], C0, 0, 0, 0),   P0[10], P0[11], P0[12], P0[13], pw1[0] = PKW(P0, 8), pw1[1] = PKW(P0, 10), pw1); \
      VRD(5); SBAR(); GAPA(C1 = __builtin_amdgcn_mfma_f32_32x32x16_bf16(kf[3], qr[1], C1, 0, 0, 0),   P0[14], P0[15], P1[0], P1[1],   pw1[2] = PKW(P0, 12), pw1[3] = PKW(P0, 14), pw1); \
      PUB(1); VRD(2); SBAR(); GAPA(C0 = __builtin_amdgcn_mfma_f32_32x32x16_bf16(kf[4], qr[2], C0, 0, 0, 0),   P1[2], P1[3], P1[4], P1[5],     pw2[0] = PKW(P1, 0), pw2[1] = PKW(P1, 2), pw2); \
      VRD(6); SBAR(); GAPA(C1 = __builtin_amdgcn_mfma_f32_32x32x16_bf16(kf[5], qr[2], C1, 0, 0, 0),   P1[6], P1[7], P1[8], P1[9],     pw2[2] = PKW(P1, 4), pw2[3] = PKW(P1, 6), pw2); \
      PUB(2); VRD(3); SBAR(); GAPA(C0 = __builtin_amdgcn_mfma_f32_32x32x16_bf16(kf[6], qr[3], C0, 0, 0, 0),   P1[10], P1[11], P1[12], P1[13], pw3[0] = PKW(P1, 8), pw3[1] = PKW(P1, 10), pw3); \
      VRD(7); SBAR(); GAPA(C1 = __builtin_amdgcn_mfma_f32_32x32x16_bf16(kf[7], qr[3], C1, 0, 0, 0),   P1[14], P1[15], 0.f, 0.f,       pw3[2] = PKW(P1, 12), pw3[3] = PKW(P1, 14), pw3); \
      PUB(3); l_reg += sacc; \
      DMA_K((t) + 3, ks_cur); DMA_V((t) + 1, VSL((t) + 1)); \
      CMASK(C0, C1, t); \
      { float a = MX3(C0[0], C0[1], C1[0]), b_ = MX3(C0[2], C0[3], C1[1]); a = MX3(a, C1[2], C1[3]); \
        _Pragma("unroll") for (int r = 4; r < 16; r += 4) { a = MX3(a, C0[r], C0[r + 1]); b_ = MX3(b_, C0[r + 2], C0[r + 3]); a = MX3(a, C1[r], C1[r + 1]); b_ = MX3(b_, C1[r + 2], C1[r + 3]); } \
        float rm = __builtin_fmaxf(a, b_); { auto rr = __builtin_amdgcn_permlane32_swap(__float_as_uint(rm), __float_as_uint(rm), false, false); rm = __builtin_fmaxf(__uint_as_float(rr[0]), __uint_as_float(rr[1])); } \
        resc = false; \
        if (__builtin_expect(__any(rm > (float)THRL), 0)) { const float dl = __builtin_fmaxf(rm, 0.f); mhat += dl; \
          _Pragma("unroll") for (int r = 0; r < 16; ++r) { C0[r] -= dl; C1[r] -= dl; } \
          _Pragma("unroll") for (int r = 0; r < 16; ++r) negm[r] = -mhat; asm volatile("" : "+v"(negm)); \
          const float f = __builtin_amdgcn_exp2f(-dl); l_reg *= f; if (hi == 0) fw[((t) & 1) * 32 + r32] = f; resc = true; } \
        if (lane == 0) flagw[(t) & 1] = resc ? 1u : 0u; } \
      SBAR(); \
      GAPB(C0, 0); GAPB(C0, 4); KRD(0); GAPB(C0, 8); KRD(1); GAPB(C0, 12); KRD(2); GAPB(C1, 0); KRD(3); GAPB(C1, 4); GAPB(C1, 8); GAPB(C1, 12); \
      } while (0)
    int t = 1;
    #undef CMASK
    #define CMASK(P0, P1, t) do {} while (0)
    for (; t + 3 < NT; t += 2) {
      STEP(pB0, pB1, pA0, pA1, t);       WAIT_BAR(3); RESC(t & 1); KROT();
      STEP(pA0, pA1, pB0, pB1, t + 1);   WAIT_BAR(3); RESC((t + 1) & 1); KROT();
    }
    #undef CMASK
    #define CMASK(P0, P1, t) do { int jb_ = (t) - (NT - 2); if (jb_ >= 0) cmask(P0, P1, jb_, qrel, hi); } while (0)
    if (t + 1 < NT) {
      STEP(pB0, pB1, pA0, pA1, t);       WAIT_BAR(3); RESC(t & 1); KROT();
      STEP(pA0, pA1, pB0, pB1, t + 1);   WAIT_BAR(3); RESC((t + 1) & 1); KROT();
      t += 2;
    }
    STEP(pB0, pB1, pA0, pA1, NT - 1);    WAIT_BAR(3); RESC((NT - 1) & 1);
    { float sacc = pB0[0] + pB0[1]; _Pragma("unroll") for (int r = 2; r < 16; ++r) sacc += pB0[r]; _Pragma("unroll") for (int r = 0; r < 16; ++r) sacc += pB1[r]; l_reg += sacc;
      pw0 = (u32x4){PKW(pB0, 0), PKW(pB0, 2), PKW(pB0, 4), PKW(pB0, 6)}; pw1 = (u32x4){PKW(pB0, 8), PKW(pB0, 10), PKW(pB0, 12), PKW(pB0, 14)}; pw2 = (u32x4){PKW(pB1, 0), PKW(pB1, 2), PKW(pB1, 4), PKW(pB1, 6)}; pw3 = (u32x4){PKW(pB1, 8), PKW(pB1, 10), PKW(pB1, 12), PKW(pB1, 14)};
      LAS char* pp_ = pbase + (NT & 1) * PS_PSLOT; PUB(0); PUB(1); PUB(2); PUB(3);
      { auto rr = __builtin_amdgcn_permlane32_swap(__float_as_uint(l_reg), __float_as_uint(l_reg), false, false); l_reg = __uint_as_float(rr[0]) + __uint_as_float(rr[1]); }
      if (hi == 0) fw[80 + r32] = l_reg;
      }
    asm volatile("s_waitcnt vmcnt(0) lgkmcnt(0)\n\ts_barrier" ::: "memory");
    #undef PKW
    #undef PAF
    #undef VFR
    #undef MX3
    #undef GAPA
    #undef GAPB
    #undef EX
    #undef VRD
    #undef KRD
    #undef PUB
    #undef STEP
    #undef CMASK
    #undef START
    #undef RESC
    asm volatile("s_barrier" ::: "memory");
  } else {
    f32x16 o[4]; o[0] = f32x16{}; o[1] = f32x16{}; o[2] = f32x16{}; o[3] = f32x16{};
    DMA_K(2, 2 * 8192);
    WAIT_BAR(4);
    WAIT_BAR(0);
    DMA_K(3, 0); DMA_V(1, VSL(1));
    KROT();
    WAIT_BAR(3);
    #define VPV(tt) do { const LAS char* pp_ = pbase + (((tt) + 1) & 1) * PS_PSLOT; \
        const bf16x8 pa0 = __builtin_bit_cast(bf16x8, *(const LAS u32x4*)(pp_)), pa1 = __builtin_bit_cast(bf16x8, *(const LAS u32x4*)(pp_ + 1024)), pa2 = __builtin_bit_cast(bf16x8, *(const LAS u32x4*)(pp_ + 2048)), pa3 = __builtin_bit_cast(bf16x8, *(const LAS u32x4*)(pp_ + 3072)); \
        _Pragma("unroll") for (int hf = 0; hf < 2; ++hf) { const lds_cptr vp_ = vfrag0 + hf * 8192 + VSL(tt); s16x4 vl[8], vh[8]; \
          _Pragma("unroll") for (int i = 0; i < 8; ++i) { vl[i] = vtr(vp_ + ((i >> 2) * 4096 + (i & 3) * 1024)); vh[i] = vtr(vp_ + ((i >> 2) * 4096 + (i & 3) * 1024 + 512)); } \
          _Pragma("unroll") for (int i = 0; i < 4; ++i) { const bf16x8 pa = i == 0 ? pa0 : i == 1 ? pa1 : i == 2 ? pa2 : pa3; \
            o[2 * hf] = __builtin_amdgcn_mfma_f32_32x32x16_bf16(pa, (bf16x8){vl[i][0], vl[i][1], vl[i][2], vl[i][3], vh[i][0], vh[i][1], vh[i][2], vh[i][3]}, o[2 * hf], 0, 0, 0); \
            o[2 * hf + 1] = __builtin_amdgcn_mfma_f32_32x32x16_bf16(pa, (bf16x8){vl[i + 4][0], vl[i + 4][1], vl[i + 4][2], vl[i + 4][3], vh[i + 4][0], vh[i + 4][1], vh[i + 4][2], vh[i + 4][3]}, o[2 * hf + 1], 0, 0, 0); } } } while (0)
    #define VRESC(s) do { if (__builtin_amdgcn_readfirstlane(flagw[(s) & 1]) != 0u) { \
        _Pragma("unroll") for (int d_ = 0; d_ < 4; ++d_) _Pragma("unroll") for (int r = 0; r < 16; ++r) o[d_][r] *= fw[((s) & 1) * 32 + crow(r, hi)]; } } while (0)
    for (int t = 1; t < NT; ++t) {
      DMA_K(t + 3, ks_cur); DMA_V(t + 1, VSL(t + 1));
      if (t >= 2) { VPV(t - 2); VRESC(t - 1); }
      WAIT_BAR(3); KROT();
    }
    VPV(NT - 2); VRESC(NT - 1);
    asm volatile("s_waitcnt vmcnt(0) lgkmcnt(0)\n\ts_barrier" ::: "memory");
    VPV(NT - 1);
    asm volatile("s_waitcnt lgkmcnt(0)\n\ts_barrier" ::: "memory");
    #undef VPV
    #undef VRESC
    float rli[16];
    #pragma unroll
    for (int r = 0; r < 16; ++r) rli[r] = __builtin_amdgcn_rcpf(fw[80 + crow(r, hi)]);
    if constexpr (MODE == 0) {
      #pragma unroll
      for (int d0 = 0; d0 < 4; ++d0)
        #pragma unroll
        for (int r = 0; r < 16; ++r) keep[d0][r] = o[d0][r] * rli[r];
    } else {
      bf16* Ow = O + (rowbase + q0 + w * QBLK) * DM + ocol;
      bf16* stg = (bf16*)(shm + PS_LP) + w * 4096;
      #pragma unroll
      for (int r = 0; r < 16; ++r) { const int orow = crow(r, hi); float dv[4]; float ss = 0.f;
        #pragma unroll
        for (int d0 = 0; d0 < 4; ++d0) { dv[d0] = keep[d0][r] - lam * (o[d0][r] * rli[r]); ss += dv[d0] * dv[d0]; }
        ss += swz_xor<1>(ss); ss += swz_xor<2>(ss); ss += swz_xor<4>(ss); ss += swz_xor<8>(ss); ss += swz_xor<16>(ss);
        const float rstd = __builtin_amdgcn_rsqf(ss * (1.f / 128.f) + SUBLN_EPS);
        #pragma unroll
        for (int d0 = 0; d0 < 4; ++d0) stg[orow * 128 + d0 * 32 + r32] = __float2bfloat16(dv[d0] * rstd); }
      asm volatile("s_waitcnt lgkmcnt(0)" ::: "memory");
      #pragma unroll
      for (int i = 0; i < 8; ++i) { const int row = i * 4 + (lane >> 4), ch = lane & 15; const u32x4 v = *(const u32x4*)(stg + row * 128 + ch * 8); *(u32x4*)(Ow + (long)row * DM + ch * 8) = v; }
    }
  }
  asm volatile("s_waitcnt lgkmcnt(0)\n\ts_barrier" ::: "memory");
  #undef DMA_K
  #undef DMA_V
  #undef KROT
  #undef VSL
  #undef PIN
}
#undef SBAR
#undef WAIT_BAR
constexpr int ATTN_LDS_BYTES = LDS_BYTES;
static_assert(PS_BYTES <= 131072, "P-sharing attention LDS");

#undef SBAR
#undef WAIT_BAR
}

constexpr size_t MiB = 1u << 20;
constexpr size_t WS_CTL = 0, CTL_ZERO_BYTES = 1 * MiB;
constexpr size_t WS_ROPE = 1 * MiB;
constexpr size_t WS_MISC = 2 * MiB;
constexpr size_t WS_WA = 8 * MiB;
constexpr size_t WS_WB = 36 * MiB;
constexpr size_t WS_XN = 214 * MiB;
constexpr size_t WS_P16 = 342 * MiB;
constexpr size_t WS_PROJ = 374 * MiB;
constexpr size_t WS_R = 502 * MiB;
constexpr size_t WS_HB0 = 1142 * MiB;
constexpr size_t WS_SSP0 = 1270 * MiB, WS_SSP1 = 1274 * MiB;
constexpr size_t WS_SCAN = 1278 * MiB;
constexpr size_t WS_P16B = 1296 * MiB;
constexpr size_t WS_END = 1328 * MiB;
constexpr size_t MS_SPL = 0;
constexpr size_t MS_BC = 64 * 1024;
constexpr size_t MS_TOPE = 128 * 1024;
constexpr size_t MS_TOPG = MS_TOPE + 512 * 1024;
constexpr size_t MS_RANK = MS_TOPG + 512 * 1024;
constexpr int SLOTS_PER_PASS = NTOK + NE * 256;
constexpr size_t MS_STOK = MS_RANK + 512 * 1024;
constexpr size_t MS_SGATE = MS_STOK + 2 * (size_t)SLOTS_PER_PASS * 4;
constexpr size_t MS_SRS = MS_SGATE + 2 * (size_t)SLOTS_PER_PASS * 4;
static_assert(MS_SRS + 2 * (size_t)SLOTS_PER_PASS * 4 <= 6 * MiB, "misc map");
constexpr size_t WA_QKV = 0, WA_O = 6 * MiB, WA_GU = 8 * MiB, WA_D = 19 * MiB, WA_PG = 25 * MiB, WA_PP = 27 * MiB;
constexpr size_t WB_IN = 0, WB_GT = 4 * MiB, WB_OUT = 5 * MiB, WB_PG = 7 * MiB, WB_PP = 9 * MiB, WB_MGU = 10 * MiB, WB_MD = 122 * MiB;
constexpr size_t R_Q = 0, R_K = 128 * MiB, R_V = 256 * MiB, R_O2 = 384 * MiB, R_OA = 384 * MiB, R_HID = 128 * MiB;
constexpr size_t R_XL = 0, R_Y = 128 * MiB, R_U = 256 * MiB, R_LA = 384 * MiB, R_BT = 512 * MiB, R_HY = 0, R_MHID = 0, R_MHID1 = 400 * MiB, R_H8 = 512 * MiB, R_H8B = 256 * MiB, R_XS8 = 256 * MiB;
constexpr int CW_TMO = 0, CW_BAR = 4096;

constexpr int RING_OFF = 0, RING_BYTES = 131072;
constexpr int LDSCTL_OFF = RING_BYTES, MISC_OFF = LDSCTL_OFF + 320;
constexpr int LDS_BYTES = 147456;
constexpr int MW_CNT = 16, MW_TST = 32;

#define XB_TMO      128
#define XB_XCNT(j)  (256  + 64 * (j))
#define XB_XSUB(j)  (1280 + 64 * (j))
#define XB_XGEN(j)  (2304 + 64 * (j))
#define XB_TOP      3328
#define XB_TOPGEN   3392
#define XCD_BAR_WORDS 3456
#define XB_SPIN_CAP (1u << 18)
__device__ __forceinline__ unsigned xb_ld(unsigned* p)              { return __hip_atomic_load(p, __ATOMIC_RELAXED, __HIP_MEMORY_SCOPE_AGENT); }
__device__ __forceinline__ unsigned xb_add(unsigned* p, unsigned v) { return __hip_atomic_fetch_add(p, v, __ATOMIC_RELAXED, __HIP_MEMORY_SCOPE_AGENT); }
__device__ __forceinline__ unsigned xb_xcc_id() { return (unsigned)__builtin_amdgcn_s_getreg((3 << 11) | 20) & 0xFu; }
#define XB_SPIN(cond, bar) do { unsigned _sp = 0; while (cond) { __builtin_amdgcn_s_sleep(1); \
    if ((++_sp & 255u) == 0u) { if (xb_ld(&(bar)[XB_TMO])) break; if (_sp > XB_SPIN_CAP) { atomicAdd(&(bar)[XB_TMO], 1u); break; } } } } while (0)
struct XcdBarrier { unsigned* bar; unsigned x; volatile LAS unsigned* st; };
__device__ __forceinline__ XcdBarrier xcd_barrier_post(unsigned* bar, volatile LAS unsigned* st, const int wave_s) {
    XcdBarrier b; b.bar = bar; b.x = xb_xcc_id(); b.st = st;
    if (tid_of(wave_s) == 0) (void)xb_add(&bar[XB_XCNT(b.x)], 1u);
    return b;
}
__device__ __forceinline__ void xcd_barrier_complete(unsigned* bar, unsigned x, unsigned& nloc, unsigned& nx) {
    const unsigned G = gridDim.x * gridDim.y * gridDim.z;
    unsigned sum, cnt, mine, sp = 0u;
    for (;;) {
        sum = 0u; cnt = 0u; mine = 0u;
#pragma unroll
        for (unsigned j = 0; j < 16; ++j) { const unsigned c = xb_ld(&bar[XB_XCNT(j)]); sum += c; cnt += (c > 0u) ? 1u : 0u; mine = (j == x) ? c : mine; }
        if (sum == G) break;
        __builtin_amdgcn_s_sleep(1);
        if ((++sp & 255u) == 0u) { if (xb_ld(&bar[XB_TMO])) break; if (sp > XB_SPIN_CAP) { atomicAdd(&bar[XB_TMO], 1u); break; } }
    }
    nloc = mine > 0u ? mine : 1u; nx = cnt > 0u ? cnt : 1u;
}
__device__ __forceinline__ void xcd_barrier(const XcdBarrier& b, const int wave_s) {
    asm volatile("s_waitcnt vmcnt(0)" ::: "memory");
    __syncthreads();
    if (tid_of(wave_s) == 0) {
        unsigned* bar = b.bar;
        __builtin_amdgcn_s_waitcnt(0);
        unsigned nloc = b.st[0], nx = b.st[1];
        if (nloc == 0u) { xcd_barrier_complete(bar, b.x, nloc, nx); b.st[0] = nloc; b.st[1] = nx; }
        const unsigned old = xb_add(&bar[XB_XSUB(b.x)], 1u);
        const unsigned gen = old / nloc;
        if (old + 1u == (gen + 1u) * nloc) {
            __builtin_amdgcn_fence(__ATOMIC_RELEASE, "agent");
            asm volatile("s_waitcnt vmcnt(0)" ::: "memory");
            const unsigned og = xb_add(&bar[XB_TOP], 1u);
            const unsigned tg = og / nx;
            if (og + 1u == (tg + 1u) * nx) xb_add(&bar[XB_TOPGEN], 1u);
            else XB_SPIN(xb_ld(&bar[XB_TOPGEN]) == tg, bar);
            __builtin_amdgcn_fence(__ATOMIC_ACQUIRE, "agent");
            xb_add(&bar[XB_XGEN(b.x)], 1u);
            asm volatile("s_waitcnt vmcnt(0)" ::: "memory");
        } else {
            XB_SPIN(xb_ld(&bar[XB_XGEN(b.x)]) == gen, bar);
            __builtin_amdgcn_fence(__ATOMIC_ACQUIRE, "agent");
            asm volatile("s_waitcnt vmcnt(0)" ::: "memory");
        }
    }
    __syncthreads();
}

#define LDS_WAIT() asm volatile("s_waitcnt lgkmcnt(0)" ::: "memory")
__device__ __forceinline__ float wave_sum(float v) {
    v += swz_xor<1>(v); v += swz_xor<2>(v); v += swz_xor<4>(v); v += swz_xor<8>(v); v += swz_xor<16>(v);
    return add_x32(v);
}
__device__ __forceinline__ void tr_item(const float* W, int ldsrc, int k0, int nsrc0, bf16_t* WT, int ldd, int vrow0, int dk0, const float* gain, float gscale, LAS float* scr, int lane) {
#pragma unroll 16
    for (int i = 0; i < 32; ++i) { const int kk = 2 * i + (lane >> 5); float v = W[(size_t)(k0 + kk) * ldsrc + nsrc0 + (lane & 31)]; if (gain) v *= gain[k0 + kk] * gscale; scr[kk * 33 + (lane & 31)] = v; }
    LDS_WAIT(); asm volatile("" ::: "memory");
    const int c = lane & 7;
#pragma unroll
    for (int j = 0; j < 4; ++j) { const int n = (lane >> 3) + 8 * j; const LAS float* s = scr + (8 * c) * 33 + n;
        u32x4 o; o.x = cvt_pk_bf16(s[0 * 33], s[1 * 33]); o.y = cvt_pk_bf16(s[2 * 33], s[3 * 33]); o.z = cvt_pk_bf16(s[4 * 33], s[5 * 33]); o.w = cvt_pk_bf16(s[6 * 33], s[7 * 33]);
        *(GAS u32x4*)(WT + (size_t)(vrow0 + n) * ldd + dk0 + 8 * c) = o; }
    LDS_WAIT(); asm volatile("" ::: "memory");
}

__device__ __forceinline__ void tr_item_fp8(const float* W, int ldsrc, int k0, int nsrc0, unsigned char* WT8, int ldd8, int vrow0, int dk0, const float* gain, float gscale, LAS float* scr, int lane) {
#pragma unroll 16
    for (int i = 0; i < 32; ++i) { const int kk = 2 * i + (lane >> 5); float v = W[(size_t)(k0 + kk) * ldsrc + nsrc0 + (lane & 31)]; v *= gain ? gain[k0 + kk] * gscale : gscale; scr[kk * 33 + (lane & 31)] = v; }
    LDS_WAIT(); asm volatile("" ::: "memory");
    const int c = lane & 7;
#pragma unroll
    for (int j = 0; j < 4; ++j) { const int n = (lane >> 3) + 8 * j; const LAS float* s = scr + (8 * c) * 33 + n;
        u32x2 o; o.x = pk_fp8x4(s[0 * 33], s[1 * 33], s[2 * 33], s[3 * 33]); o.y = pk_fp8x4(s[4 * 33], s[5 * 33], s[6 * 33], s[7 * 33]);
        *(GAS u32x2*)(WT8 + (size_t)(vrow0 + n) * ldd8 + dk0 + 8 * c) = o; }
    LDS_WAIT(); asm volatile("" ::: "memory");
}

__device__ __forceinline__ void tr_item64(const float* W, int ldsrc, int k0, int nsrc0, bf16_t* WT, int ldd, int vrow0, int dk0, const float* gain, LAS unsigned* scr, int lane) {
    float v[64];
    const float* src = W + (size_t)k0 * ldsrc + nsrc0 + lane;
#pragma unroll
    for (int i = 0; i < 64; ++i) v[i] = src[(size_t)i * ldsrc];
    if (gain) {
#pragma unroll
        for (int i = 0; i < 64; ++i) v[i] *= gain[k0 + i]; }
#pragma unroll
    for (int kp = 0; kp < 32; ++kp) scr[kp * 65 + lane] = cvt_pk_bf16(v[2 * kp], v[2 * kp + 1]);
    LDS_WAIT(); asm volatile("" ::: "memory");
    const int c = lane & 7;
#pragma unroll
    for (int j = 0; j < 8; ++j) { const int n = (lane >> 3) + 8 * j; const LAS unsigned* s = scr + (4 * c) * 65 + n;
        u32x4 o; o.x = s[0]; o.y = s[65]; o.z = s[130]; o.w = s[195];
        *(GAS u32x4*)(WT + (size_t)(vrow0 + n) * ldd + dk0 + 8 * c) = o; }
    LDS_WAIT(); asm volatile("" ::: "memory");
}

__device__ __forceinline__ void tr_item64_fp8(const float* W, int ldsrc, int k0, int nsrc0, unsigned char* WT, int ldd8, int vrow0, int dk0, const float* gain, float sc, LAS unsigned* scr, int lane) {
    float v[64];
    const float* src = W + (size_t)k0 * ldsrc + nsrc0 + lane;
#pragma unroll
    for (int i = 0; i < 64; ++i) v[i] = src[(size_t)i * ldsrc];
#pragma unroll
    for (int i = 0; i < 64; ++i) v[i] *= gain ? gain[k0 + i] * sc : sc;
#pragma unroll
    for (int kq = 0; kq < 16; ++kq) scr[kq * 65 + lane] = pk_fp8x4(v[4 * kq], v[4 * kq + 1], v[4 * kq + 2], v[4 * kq + 3]);
    LDS_WAIT(); asm volatile("" ::: "memory");
    const int c = lane & 3;
#pragma unroll
    for (int j = 0; j < 4; ++j) { const int n = (lane >> 2) + 16 * j; const LAS unsigned* s = scr + (4 * c) * 65 + n;
        u32x4 o; o.x = s[0]; o.y = s[65]; o.z = s[130]; o.w = s[195];
        *(GAS u32x4*)(WT + (size_t)(vrow0 + n) * ldd8 + dk0 + 16 * c) = o; }
    LDS_WAIT(); asm volatile("" ::: "memory");
}

typedef f32x4 (&AccRef)[2][2][4][2];
#define EPI_FENCE() asm volatile("" ::: "memory")
__device__ __forceinline__ void load_rstd8(float (&rs)[2][4], const float* ssp, int row0, int fq) {
    f32x4 p[2][4];
#pragma unroll
    for (int ai = 0; ai < 2; ++ai)
#pragma unroll
        for (int m = 0; m < 4; ++m) p[ai][m] = *(const f32x4*)(ssp + (size_t)(row0 + ai * 128 + m * 16) * 16 + fq * 4);
#pragma unroll
    for (int ai = 0; ai < 2; ++ai)
#pragma unroll
        for (int m = 0; m < 4; ++m) { float s = (p[ai][m][0] + p[ai][m][1]) + (p[ai][m][2] + p[ai][m][3]); s += swz_xor<16>(s); s = add_x32(s); rs[ai][m] = __builtin_amdgcn_rsqf(s * (1.f / D) + NORM_EPS); }
}
#define EPI_PIN(ai) asm volatile("" : "+v"(acc[ai][0][0][0]), "+v"(acc[ai][0][0][1]), "+v"(acc[ai][0][1][0]), "+v"(acc[ai][0][1][1]), "+v"(acc[ai][0][2][0]), "+v"(acc[ai][0][2][1]), "+v"(acc[ai][0][3][0]), "+v"(acc[ai][0][3][1]), \
    "+v"(acc[ai][1][0][0]), "+v"(acc[ai][1][0][1]), "+v"(acc[ai][1][1][0]), "+v"(acc[ai][1][1][1]), "+v"(acc[ai][1][2][0]), "+v"(acc[ai][1][2][1]), "+v"(acc[ai][1][3][0]), "+v"(acc[ai][1][3][1]) :: "memory")
#define EPI_PIN2(ai, m0) asm volatile("" : "+v"(acc[ai][0][m0][0]), "+v"(acc[ai][0][m0][1]), "+v"(acc[ai][0][m0 + 1][0]), "+v"(acc[ai][0][m0 + 1][1]), "+v"(acc[ai][1][m0][0]), "+v"(acc[ai][1][m0][1]), "+v"(acc[ai][1][m0 + 1][0]), "+v"(acc[ai][1][m0 + 1][1]) :: "memory")
__device__ __forceinline__ int moe_expert(const volatile LAS unsigned* tst, int pm) { int e = 0;
#pragma unroll
    for (int q = 1; q < NE; ++q) e += (pm >= (int)tst[q]) ? 1 : 0; return e; }
__device__ __forceinline__ u32x4 pack8(const f32x4 a, const f32x4 b) { u32x4 w; w.x = cvt_pk_bf16(a[0], a[1]); w.y = cvt_pk_bf16(a[2], a[3]); w.z = cvt_pk_bf16(b[0], b[1]); w.w = cvt_pk_bf16(b[2], b[3]); return w; }
__device__ __forceinline__ float sumsq8(const f32x4 a, const f32x4 b) { return ((a[0] * a[0] + a[1] * a[1]) + (a[2] * a[2] + a[3] * a[3])) + ((b[0] * b[0] + b[1] * b[1]) + (b[2] * b[2] + b[3] * b[3])); }

struct EpiQKV {
    static constexpr bool PERM = true, IDEMP = false;
    bf16_t* Q; bf16_t* K; bf16_t* V; const float* ssp; float zs; int pad_;
    __device__ __forceinline__ void operator()(AccRef acc, const pg8::Unit& u, int wr, int wc, int fr, int fq) const {
        const int rl0 = wr * 64 + fr, row0 = u.pm * 256 + rl0; float rs8[2][4]; load_rstd8(rs8, ssp, row0, fq);
#pragma unroll
        for (int ai = 0; ai < 2; ++ai)
#pragma unroll
            for (int m = 0; m < 4; ++m) rs8[ai][m] *= zs;
        if (u.pn < 8) {
            bf16_t* base = (u.pn < 4) ? Q : K; const float sc0 = (u.pn < 4) ? C2 : 1.0f;
            const int col = ((u.pn & 3) * 4 + wc) * 64 + 8 * fq;
            float inv[8];
#pragma unroll
            for (int q = 0; q < 8; ++q) inv[q] = __builtin_amdgcn_exp2f(-0.41524101186092029f * (float)(8 * fq + q));
#pragma unroll
            for (int ai = 0; ai < 2; ++ai)
#pragma unroll
                for (int m = 0; m < 4; ++m) { const int row = row0 + ai * 128 + m * 16; const float pos = (float)(row & (SEQ - 1)); const float sc = sc0 * rs8[ai][m];
#pragma unroll
                    for (int n = 0; n < 2; ++n) { f32x4 c, s;
#pragma unroll
                        for (int e = 0; e < 4; ++e) { const float ang = pos * inv[4 * n + e]; const float rev = ang * 0.15915494309189535f; const float fr_ = rev - __builtin_rintf(rev);
                            c[e] = __builtin_amdgcn_cosf(fr_) * sc; s[e] = __builtin_amdgcn_sinf(fr_) * sc; }
                        const f32x4 l = acc[ai][0][m][n], h = acc[ai][1][m][n];
                        acc[ai][0][m][n] = l * c - h * s; acc[ai][1][m][n] = h * c + l * s; } }
#pragma unroll
            for (int ai = 0; ai < 2; ++ai)
#pragma unroll
                for (int m = 0; m < 4; ++m) { bf16_t* rp = base + (size_t)(row0 + ai * 128 + m * 16) * D + col;
                    *(u32x4*)rp = pack8(acc[ai][0][m][0], acc[ai][0][m][1]); *(u32x4*)(rp + 32) = pack8(acc[ai][1][m][0], acc[ai][1][m][1]); }
        } else {
            const int col = (u.pn - 8) * 256 + wc * 32 + 8 * fq;
#pragma unroll
            for (int ai = 0; ai < 2; ++ai)
#pragma unroll
                for (int m = 0; m < 4; ++m) { bf16_t* rp = V + (size_t)(row0 + ai * 128 + m * 16) * D + col; const float rs = rs8[ai][m];
#pragma unroll
                    for (int bj = 0; bj < 2; ++bj) *(u32x4*)(rp + bj * 128) = pack8(acc[ai][bj][m][0] * rs, acc[ai][bj][m][1] * rs); }
        }
    }
};
__device__ __forceinline__ void add_bf8(f32x4& a0, f32x4& a1, const u32x4 w, const float sc) {
    a0[0] = bf_lo(w.x) + a0[0] * sc; a0[1] = bf_hi(w.x) + a0[1] * sc; a0[2] = bf_lo(w.y) + a0[2] * sc; a0[3] = bf_hi(w.y) + a0[3] * sc;
    a1[0] = bf_lo(w.z) + a1[0] * sc; a1[1] = bf_hi(w.z) + a1[1] * sc; a1[2] = bf_lo(w.w) + a1[2] * sc; a1[3] = bf_hi(w.w) + a1[3] * sc; }
struct EpiRes {
    static constexpr bool PERM = true, IDEMP = false;
    const bf16_t* in; bf16_t* out; float* ssp; unsigned char* out8; float es; int pad_;
    __device__ __forceinline__ void operator()(AccRef acc, const pg8::Unit& u, int wr, int wc, int fr, int fq) const {
        const int row0 = u.pm * 256 + wr * 64 + fr, col0 = u.pn * 256 + wc * 32 + 8 * fq;
#pragma unroll
        for (int ai = 0; ai < 2; ++ai) { u32x4 w[4][2];
#pragma unroll
            for (int m = 0; m < 4; ++m)
#pragma unroll
                for (int bj = 0; bj < 2; ++bj) w[m][bj] = *(const u32x4*)(in + (size_t)(row0 + ai * 128 + m * 16) * D + col0 + bj * 128);
#pragma unroll
            for (int m = 0; m < 4; ++m)
#pragma unroll
                for (int bj = 0; bj < 2; ++bj) add_bf8(acc[ai][bj][m][0], acc[ai][bj][m][1], w[m][bj], es);
            EPI_PIN(ai); }
        EPI_FENCE();
#pragma unroll
        for (int ai = 0; ai < 2; ++ai)
#pragma unroll
            for (int m = 0; m < 4; ++m) { const int row = row0 + ai * 128 + m * 16; const size_t off = (size_t)row * D + col0; float s = 0.f;
#pragma unroll
                for (int bj = 0; bj < 2; ++bj) { const f32x4 x0 = acc[ai][bj][m][0], x1 = acc[ai][bj][m][1]; *(u32x4*)(out + off + bj * 128) = pack8(x0, x1); s += sumsq8(x0, x1);
                    if (out8) { u32x2 q; q.x = pk_fp8x4(x0[0], x0[1], x0[2], x0[3]); q.y = pk_fp8x4(x1[0], x1[1], x1[2], x1[3]); *(u32x2*)(out8 + off + bj * 128) = q; } }
                s += swz_xor<16>(s); s = add_x32(s);
                if (fq == 0) ssp[(size_t)row * 16 + u.pn * 4 + wc] = s; }
    }
};
struct EpiSwiGLU {
    static constexpr bool PERM = true, IDEMP = true;
    bf16_t* out; const float* ssp; const float* srs; int ldc; int f8; int f8o; int pad_;
    __device__ __forceinline__ void operator()(AccRef acc, const pg8::Unit& u, int wr, int wc, int fr, int fq) const {
        const int rl0 = wr * 64 + fr, row0 = u.pm * 256 + rl0, col0 = u.pn * 128 + wc * 32 + 8 * fq; float rs8[2][4];
        if (srs) {
#pragma unroll
            for (int ai = 0; ai < 2; ++ai)
#pragma unroll
                for (int m = 0; m < 4; ++m) rs8[ai][m] = srs[row0 + ai * 128 + m * 16];
        } else load_rstd8(rs8, ssp, row0, fq);
#pragma unroll
        for (int ai = 0; ai < 2; ++ai)
#pragma unroll
            for (int m = 0; m < 4; ++m) { f32x4 h[2]; const float rs = f8 ? rs8[ai][m] * (1.0f / W8_SCALE) : rs8[ai][m];
                const float c1 = -1.4426950408889634f * rs, c2 = f8o ? rs * rs * H8_SCALE : rs * rs;
#pragma unroll
                for (int n = 0; n < 2; ++n) { const f32x4 ag = acc[ai][0][m][n], au = acc[ai][1][m][n];
#pragma unroll
                    for (int e = 0; e < 4; ++e) h[n][e] = (ag[e] * au[e]) * c2 * __builtin_amdgcn_rcpf(1.0f + __builtin_amdgcn_exp2f(ag[e] * c1)); }
                if (f8o) { u32x2 q; q.x = pk_fp8x4_m3(h[0][0], h[0][1], h[0][2], h[0][3]); q.y = pk_fp8x4_m3(h[1][0], h[1][1], h[1][2], h[1][3]);
                    *(u32x2*)((unsigned char*)out + (size_t)(row0 + ai * 128 + m * 16) * ldc + col0) = q; }
                else *(u32x4*)(out + (size_t)(row0 + ai * 128 + m * 16) * ldc + col0) = pack8(h[0], h[1]); }
    }
};
struct EpiLruIn {
    static constexpr bool PERM = true, IDEMP = true;
    bf16_t* XL; bf16_t* Y; const float* ssp;
    __device__ __forceinline__ void operator()(AccRef acc, const pg8::Unit& u, int wr, int wc, int fr, int fq) const {
        const int rl0 = wr * 64 + fr, row0 = u.pm * 256 + rl0, col0 = (u.pn & 3) * 256 + wc * 32 + 8 * fq; const bool isy = u.pn >= 4; bf16_t* base = isy ? Y : XL; float rs8[2][4]; load_rstd8(rs8, ssp, row0, fq);
#pragma unroll
        for (int ai = 0; ai < 2; ++ai)
#pragma unroll
            for (int m = 0; m < 4; ++m) { bf16_t* rp = base + (size_t)(row0 + ai * 128 + m * 16) * D + col0; const float rs = rs8[ai][m];
#pragma unroll
                for (int bj = 0; bj < 2; ++bj) { f32x4 v[2] = {acc[ai][bj][m][0] * rs, acc[ai][bj][m][1] * rs};
                    if (isy) {
#pragma unroll
                        for (int n = 0; n < 2; ++n)
#pragma unroll
                            for (int e = 0; e < 4; ++e) { const float x = v[n][e]; const float z = 0.7978845608028654f * (x + 0.044715f * x * x * x); v[n][e] = x * fast_sigmoid(2.0f * z); } }
                    *(u32x4*)(rp + bj * 128) = pack8(v[0], v[1]); } }
    }
};
struct EpiGates {
    static constexpr bool PERM = true, IDEMP = false;
    const bf16_t* U; const float* ba; const float* bx; const float* spl; bf16_t* LA; bf16_t* BT;
    __device__ __forceinline__ void operator()(AccRef acc, const pg8::Unit& u, int wr, int wc, int fr, int fq) const {
        const int row0 = u.pm * 256 + wr * 64 + fr, ch0 = u.pn * 128 + wc * 32 + 8 * fq;
        f32x4 vba[2], vbx[2], vsp[2]; u32x4 uu[2][4];
#pragma unroll
        for (int n = 0; n < 2; ++n) { vba[n] = *(const f32x4*)(ba + ch0 + 4 * n); vbx[n] = *(const f32x4*)(bx + ch0 + 4 * n); vsp[n] = *(const f32x4*)(spl + ch0 + 4 * n); }
#pragma unroll
        for (int ai = 0; ai < 2; ++ai)
#pragma unroll
            for (int m = 0; m < 4; ++m) uu[ai][m] = *(const u32x4*)(U + (size_t)(row0 + ai * 128 + m * 16) * D + ch0);
#pragma unroll
        for (int ai = 0; ai < 2; ++ai)
#pragma unroll
            for (int m = 0; m < 4; ++m) { const u32x4 q = uu[ai][m];
                const float uf[8] = {bf_lo(q.x), bf_hi(q.x), bf_lo(q.y), bf_hi(q.y), bf_lo(q.z), bf_hi(q.z), bf_lo(q.w), bf_hi(q.w)};
#pragma unroll
                for (int n = 0; n < 2; ++n)
#pragma unroll
                    for (int e = 0; e < 4; ++e) { const float r = fast_sigmoid(acc[ai][0][m][n][e] + vba[n][e]), ig = fast_sigmoid(acc[ai][1][m][n][e] + vbx[n][e]);
                        const float l = -8.0f * r * vsp[n][e]; const float a2 = __builtin_amdgcn_exp2f(2.8853900817779268f * l);
                        acc[ai][0][m][n][e] = l; acc[ai][1][m][n][e] = __builtin_sqrtf(fmaxf(1.0f - a2, 0.f)) * ig * uf[4 * n + e]; } }
        EPI_FENCE();
#pragma unroll
        for (int ai = 0; ai < 2; ++ai)
#pragma unroll
            for (int m = 0; m < 4; ++m) { const size_t off = (size_t)(row0 + ai * 128 + m * 16) * D + ch0;
                *(u32x4*)(LA + off) = pack8(acc[ai][0][m][0], acc[ai][0][m][1]); *(u32x4*)(BT + off) = pack8(acc[ai][1][m][0], acc[ai][1][m][1]); }
    }
};
struct EpiBf16 {
    static constexpr bool PERM = true, IDEMP = true;
    bf16_t* out;
    __device__ __forceinline__ void operator()(AccRef acc, const pg8::Unit& u, int wr, int wc, int fr, int fq) const {
        const int row0 = u.pm * 256 + wr * 64 + fr, col0 = u.pn * 256 + wc * 32 + 8 * fq;
#pragma unroll
        for (int ai = 0; ai < 2; ++ai)
#pragma unroll
            for (int m = 0; m < 4; ++m) { bf16_t* rp = out + (size_t)(row0 + ai * 128 + m * 16) * D + col0;
#pragma unroll
                for (int bj = 0; bj < 2; ++bj) *(u32x4*)(rp + bj * 128) = pack8(acc[ai][bj][m][0], acc[ai][bj][m][1]); }
    }
};
struct EpiPleGate {
    static constexpr bool PERM = true, IDEMP = false;
    const bf16_t* in; const bf16_t* proj; const float* ssp_in; bf16_t* out; float* ssp; unsigned char* out8; float es; float zs;
    __device__ __forceinline__ void operator()(AccRef acc, const pg8::Unit& u, int wr, int wc, int fr, int fq) const {
        const int rl0 = wr * 64 + fr, row0 = u.pm * 256 + rl0, col0 = u.pn * 256 + wc * 32 + 8 * fq; float rs8[2][4]; load_rstd8(rs8, ssp_in, row0, fq);
#pragma unroll
        for (int ai = 0; ai < 2; ++ai)
#pragma unroll
          for (int mp = 0; mp < 4; mp += 2) { u32x4 hw[4][2], pw[4][2];
#pragma unroll
            for (int m = mp; m < mp + 2; ++m)
#pragma unroll
                for (int bj = 0; bj < 2; ++bj) { const size_t off = (size_t)(row0 + ai * 128 + m * 16) * D + col0 + bj * 128; hw[m][bj] = *(const u32x4*)(in + off); pw[m][bj] = *(const u32x4*)(proj + off); }
#pragma unroll
            for (int m = mp; m < mp + 2; ++m) { const float rs = rs8[ai][m] * zs;
#pragma unroll
                for (int bj = 0; bj < 2; ++bj) { const u32x4 pp = pw[m][bj]; f32x4 a0 = acc[ai][bj][m][0] * rs, a1 = acc[ai][bj][m][1] * rs;
                    a0[0] = fast_sigmoid(a0[0]) * bf_lo(pp.x); a0[1] = fast_sigmoid(a0[1]) * bf_hi(pp.x); a0[2] = fast_sigmoid(a0[2]) * bf_lo(pp.y); a0[3] = fast_sigmoid(a0[3]) * bf_hi(pp.y);
                    a1[0] = fast_sigmoid(a1[0]) * bf_lo(pp.z); a1[1] = fast_sigmoid(a1[1]) * bf_hi(pp.z); a1[2] = fast_sigmoid(a1[2]) * bf_lo(pp.w); a1[3] = fast_sigmoid(a1[3]) * bf_hi(pp.w);
                    add_bf8(a0, a1, hw[m][bj], es); acc[ai][bj][m][0] = a0; acc[ai][bj][m][1] = a1; } }
            if (mp == 0) EPI_PIN2(ai, 0); else EPI_PIN2(ai, 2); }
        EPI_FENCE();
#pragma unroll
        for (int ai = 0; ai < 2; ++ai)
#pragma unroll
            for (int m = 0; m < 4; ++m) { const int row = row0 + ai * 128 + m * 16; const size_t off = (size_t)row * D + col0; float s = 0.f;
#pragma unroll
                for (int bj = 0; bj < 2; ++bj) { const f32x4 x0 = acc[ai][bj][m][0], x1 = acc[ai][bj][m][1]; *(u32x4*)(out + off + bj * 128) = pack8(x0, x1); s += sumsq8(x0, x1);
                    if (out8) { u32x2 q; q.x = pk_fp8x4(x0[0], x0[1], x0[2], x0[3]); q.y = pk_fp8x4(x1[0], x1[1], x1[2], x1[3]); *(u32x2*)(out8 + off + bj * 128) = q; } }
                s += swz_xor<16>(s); s = add_x32(s);
                if (fq == 0) ssp[(size_t)row * 16 + u.pn * 4 + wc] = s; }
    }
};
struct EpiMoeDown {
    static constexpr bool PERM = true, IDEMP = false;
    const bf16_t* in; bf16_t* out; const int* stok; const float* sgate; float* ssp; const volatile LAS unsigned* cnt; const volatile LAS unsigned* tst; unsigned char* out8; float es; int last_pass;
    __device__ __forceinline__ void operator()(AccRef acc, const pg8::Unit& u, int wr, int wc, int fr, int fq) const {
        const int e = moe_expert(tst, u.pm); const int nvalid = (int)cnt[e] - (u.pm - (int)tst[e]) * 256;
        const int r0 = wr * 64 + fr, col0 = u.pn * 256 + wc * 32 + 8 * fq;
        int tok[2][4]; float g[2][4];
#pragma unroll
        for (int ai = 0; ai < 2; ++ai)
#pragma unroll
            for (int m = 0; m < 4; ++m) { const int r = r0 + ai * 128 + m * 16; tok[ai][m] = -1; g[ai][m] = 0.f; if (r < nvalid) { tok[ai][m] = stok[u.pm * 256 + r]; g[ai][m] = sgate[u.pm * 256 + r] * es; } }
#pragma unroll
        for (int ai = 0; ai < 2; ++ai) { u32x4 w[4][2];
#pragma unroll
            for (int m = 0; m < 4; ++m)
#pragma unroll
                for (int bj = 0; bj < 2; ++bj) { w[m][bj] = (u32x4){0u, 0u, 0u, 0u}; if (tok[ai][m] >= 0) w[m][bj] = *(const u32x4*)(in + (size_t)tok[ai][m] * D + col0 + bj * 128); }
#pragma unroll
            for (int m = 0; m < 4; ++m)
#pragma unroll
                for (int bj = 0; bj < 2; ++bj) add_bf8(acc[ai][bj][m][0], acc[ai][bj][m][1], w[m][bj], g[ai][m]);
            EPI_PIN(ai); }
        EPI_FENCE();
#pragma unroll
        for (int ai = 0; ai < 2; ++ai)
#pragma unroll
            for (int m = 0; m < 4; ++m) { const bool ok = tok[ai][m] >= 0; const size_t off = (size_t)(ok ? tok[ai][m] : 0) * D + col0; float s = 0.f;
#pragma unroll
                for (int bj = 0; bj < 2; ++bj) { const f32x4 x0 = acc[ai][bj][m][0], x1 = acc[ai][bj][m][1]; if (ok) *(u32x4*)(out + off + bj * 128) = pack8(x0, x1); s += sumsq8(x0, x1);
                    if (last_pass && ok) { u32x2 q; q.x = pk_fp8x4(x0[0], x0[1], x0[2], x0[3]); q.y = pk_fp8x4(x1[0], x1[1], x1[2], x1[3]); *(u32x2*)(out8 + off + bj * 128) = q; } }
                if (last_pass) { s += swz_xor<16>(s); s = add_x32(s); if (ok && fq == 0) ssp[(size_t)tok[ai][m] * 16 + u.pn * 4 + wc] = s; } }
    }
};

#ifndef MOE_FP8
#define MOE_FP8 1
#endif
#ifndef FFN8_MASK
#define FFN8_MASK 0x4u
#endif
#define FFN8(li) (((FFN8_MASK) >> (li)) & 1u)
#ifndef DN8_MASK
#define DN8_MASK 0x5u
#endif
#define DN8(li) (((DN8_MASK) >> (li)) & 1u)
#ifndef QKV8_MASK
#define QKV8_MASK 0x4u
#endif
#define QKV8(li) (((QKV8_MASK) >> (li)) & 1u)
#ifndef FFN_FP8
#define FFN_FP8 0
#endif
constexpr int FFN_ESZ = FFN_FP8 ? 1 : 2;
constexpr int MOE_ESZ = MOE_FP8 ? 1 : 2;
struct DenseSched {
    pg8::StaticOrder ord; const char* A; const char* B; size_t a_tstep, b_tstep; const float* ssp;
    __device__ __forceinline__ bool next(int i, pg8::Unit& u) const { return ord.next(i, u); }
    __device__ __forceinline__ const char* abase(const pg8::Unit& u) const { return A + (size_t)u.pm * a_tstep; }
    __device__ __forceinline__ const char* bbase(const pg8::Unit& u) const { return B + (size_t)u.pn * b_tstep; }
    __device__ __forceinline__ int arow(const pg8::Unit&, int) const { return 0; }
    __device__ __forceinline__ int rsrow(const pg8::Unit& u, int r) const { return u.pm * 256 + r; }
};
struct GatesSched {
    pg8::StaticOrder ord; const char* A; const char* B; const float* ssp;
    __device__ __forceinline__ bool next(int i, pg8::Unit& u) const { return ord.next(i, u); }
    __device__ __forceinline__ const char* abase(const pg8::Unit& u) const { return A + (size_t)u.pm * (256 * D * 2) + (size_t)u.pn * 256; }
    __device__ __forceinline__ const char* bbase(const pg8::Unit& u) const { return B + (size_t)u.pn * (256 * 128 * 2); }
    __device__ __forceinline__ int arow(const pg8::Unit&, int) const { return 0; }
    __device__ __forceinline__ int rsrow(const pg8::Unit&, int) const { return -1; }
};
struct MoeGuSched {
    pg8::StaticOrder ord; const char* A; const char* B; const int* stok; const float* ssp; const volatile LAS unsigned* cnt; const volatile LAS unsigned* tst;
    __device__ __forceinline__ bool next(int i, pg8::Unit& u) const { return ord.next(i, u); }
    __device__ __forceinline__ const char* abase(const pg8::Unit& u) const { return MOE_FP8 ? A + (size_t)u.pm * (256 * D) : A; }
    __device__ __forceinline__ const char* bbase(const pg8::Unit& u) const { return B + (size_t)moe_expert(tst, u.pm) * ((size_t)2 * FFE * D * MOE_ESZ) + (size_t)u.pn * (256 * D * MOE_ESZ); }
    __device__ __forceinline__ int arow(const pg8::Unit& u, int r) const { const int e = moe_expert(tst, u.pm); const int nvalid = (int)cnt[e] - (u.pm - (int)tst[e]) * 256; return r < nvalid ? stok[u.pm * 256 + r] : 0; }
    __device__ __forceinline__ int rsrow(const pg8::Unit& u, int r) const { const int e = moe_expert(tst, u.pm); const int nvalid = (int)cnt[e] - (u.pm - (int)tst[e]) * 256; return r < nvalid ? stok[u.pm * 256 + r] : -1; }
};
struct MoeDownSched {
    pg8::StaticOrder ord; const char* A; const char* B; const float* ssp; const volatile LAS unsigned* tst;
    __device__ __forceinline__ bool next(int i, pg8::Unit& u) const { return ord.next(i, u); }
    __device__ __forceinline__ const char* abase(const pg8::Unit& u) const { return A + (size_t)u.pm * ((size_t)256 * FFE * MOE_ESZ); }
    __device__ __forceinline__ const char* bbase(const pg8::Unit& u) const { return B + (size_t)moe_expert(tst, u.pm) * ((size_t)D * FFE * MOE_ESZ) + (size_t)u.pn * ((size_t)256 * FFE * MOE_ESZ); }
    __device__ __forceinline__ int arow(const pg8::Unit&, int) const { return 0; }
    __device__ __forceinline__ int rsrow(const pg8::Unit&, int) const { return -1; }
};

#ifndef PH_MASK
#define PH_MASK 0xffffffffu
#endif
#define PH_ON(k) (((PH_MASK) >> (k)) & 1u)
#ifndef DUP_MASK
#define DUP_MASK 0u
#endif
#define DUP_FOR(k) for (int rep_ = (((DUP_MASK) >> (k)) & 1u) ? 0 : 1; rep_ < 2; ++rep_)
#define ES_ const float es_ = (rep_ == 1) ? 1.0f : 0.0f; (void)es_
struct Args { const float* in[34]; float* out; unsigned char* ws; int nlayers; int pad; };

#define MOE_CONV_BODY \
                { const float* wg = INP(31) + (size_t)j * NE * D * FFE; const float* wu = INP(32) + (size_t)j * NE * D * FFE; bf16_t* dst = (bf16_t*)(ws + WS_WB + WB_MGU); \
                  for (int it = gw; it < NE * 16 * 112; it += NGW) { const int e = it / (16 * 112), r = it % (16 * 112), kb = r / 112, vb = r % 112; const int vrow0 = vb * 64, pn = vrow0 >> 8, v = vrow0 & 255; \
                      if (MOE_FP8) tr_item64_fp8((v < 128 ? wg : wu) + (size_t)e * D * FFE, FFE, kb * 64, pn * 128 + (v & 127), (unsigned char*)dst + (size_t)e * 2 * FFE * D, D, vrow0, kb * 64, g_ffn_next, W8_SCALE, scr64, lane); \
                      else tr_item64((v < 128 ? wg : wu) + (size_t)e * D * FFE, FFE, kb * 64, pn * 128 + (v & 127), dst + (size_t)e * 2 * FFE * D, D, vrow0, kb * 64, g_ffn_next, scr64, lane); } } \
                { const float* wd = INP(33) + (size_t)j * NE * FFE * D; bf16_t* dst = (bf16_t*)(ws + WS_WB + WB_MD); \
                  for (int it = gw; it < NE * 56 * 16; it += NGW) { const int e = it / (56 * 16), r = it % (56 * 16), kb = r / 16, vb = r % 16; \
                      if (MOE_FP8) tr_item64_fp8(wd + (size_t)e * FFE * D, D, kb * 64, vb * 64, (unsigned char*)dst + (size_t)e * D * FFE, FFE, vb * 64, kb * 64, nullptr, W8_SCALE, scr64, lane); \
                      else tr_item64(wd + (size_t)e * FFE * D, D, kb * 64, vb * 64, dst + (size_t)e * D * FFE, FFE, vb * 64, kb * 64, nullptr, scr64, lane); } }
#define INP(i) ({ int _ix = (i); asm volatile("" : "+s"(_ix)); args.in[_ix]; })
#define PH_LOCALS \
    int tid = tid_of(wave_s); asm volatile("" : "+v"(tid)); const int lane = tid & 63; const int wave = __builtin_amdgcn_readfirstlane(tid >> 6); \
    int G = (int)gridDim.x; int bx = (int)blockIdx.x; asm volatile("" : "+s"(G), "+s"(bx)); \
    const int vcu = (G % 8 == 0) ? (bx % 8) * (G / 8) + bx / 8 : bx; const int gw = vcu * 8 + wave, NGW = G * 8; \
    size_t z_ = 0; asm volatile("" : "+s"(z_)); unsigned char* ws = args.ws + z_; \
    int cur_ = cur; asm volatile("" : "+s"(cur_)); \
    bf16_t* HC = (bf16_t*)(ws + (cur_ ? WS_HB0 : WS_XN)); bf16_t* HO = (bf16_t*)(ws + (cur_ ? WS_XN : WS_HB0));        \
    float* SC = (float*)(ws + (cur_ ? WS_SSP0 : WS_SSP1)); float* SO = (float*)(ws + (cur_ ? WS_SSP1 : WS_SSP0));        \
    bf16_t* PROJ = (bf16_t*)(ws + WS_PROJ); \
    unsigned char* R = ws + WS_R; unsigned char* MS = ws + WS_MISC; \
    LAS float* scr = (LAS float*)(lds + RING_OFF + wave * 16384); LAS unsigned* scr64 = (LAS unsigned*)(lds + RING_OFF + wave * 16384); \
    (void)lane; (void)vcu; (void)gw; (void)NGW; (void)HC; (void)HO; (void)SC; (void)SO; (void)PROJ; (void)R; (void)MS; (void)scr; (void)scr64
#define LAYER_LOCALS \
    int li_ = li; asm volatile("" : "+s"(li_)); const int j = li_ >> 1; const bool is_attn = !(li_ & 1); \
    unsigned char* W = ws + (is_attn ? WS_WA : WS_WB); bf16_t* P16 = (bf16_t*)(ws + ((li_ & 1) ? WS_P16B : WS_P16));        \
    const float* g_mix = INP(2) + li_ * D; const float* g_ffn = INP(3) + li_ * D; const float* g_ple = INP(4) + li_ * D; \
    (void)j; (void)W; (void)P16; (void)g_mix; (void)g_ffn; (void)g_ple

__device__ __forceinline__ void prep_layer(const Args& args, LAS unsigned char* lds, const int wave_s, const int li, const int cur) {
    PH_LOCALS; LAYER_LOCALS;
            { const float* wg = INP(7) + (size_t)li * D * D; unsigned char* dst = W + (is_attn ? WA_PG : WB_PG);
              for (int it = gw; it < 16 * 16; it += NGW) { const int kb = it / 16, vb = it % 16; tr_item64_fp8(wg, D, kb * 64, vb * 64, dst, D, vb * 64, kb * 64, g_ple, W8_SCALE, scr64, lane); } }
            { const float* wp = INP(6) + (size_t)li * DPLE * D; bf16_t* dst = (bf16_t*)(W + (is_attn ? WA_PP : WB_PP));
              for (int it = gw; it < 4 * 32; it += NGW) { const int kb = it / 32, vb = it % 32; tr_item(wp, D, kb * 64, vb * 32, dst, DPLE, vb * 32, kb * 64, nullptr, 1.f, scr, lane); } }
            if (is_attn) {
                const float* wq = INP(8) + (size_t)j * D * D; const float* wk = INP(9) + (size_t)j * D * D; const float* wv = INP(10) + (size_t)j * D * D;
                bf16_t* dqkv = (bf16_t*)(W + WA_QKV);
                for (int it = gw; it < 16 * 96; it += NGW) { const int kb = it / 96, vb = it % 96; const int vrow0 = vb * 32, pn = vrow0 >> 8, v = vrow0 & 255;
                    const float* src; int nsrc0;
                    if (pn < 8) { src = pn < 4 ? wq : wk; nsrc0 = ((pn & 3) * 4 + ((v & 127) >> 5)) * 64 + (v >> 7) * 32; }
                    else { src = wv; nsrc0 = (pn - 8) * 256 + v; }
                    if (QKV8(li_)) tr_item_fp8(src, D, kb * 64, nsrc0, (unsigned char*)dqkv, D, vrow0, kb * 64, g_mix, W8_SCALE, scr, lane);
                    else tr_item(src, D, kb * 64, nsrc0, dqkv, D, vrow0, kb * 64, g_mix, 1.f, scr, lane); }
                { const float* wo = INP(11) + (size_t)j * D * D; const float* sg = INP(16) + j * 128; bf16_t* dst = (bf16_t*)(W + WA_O);
                  const float linit = 0.8f - 0.6f * __expf(-0.3f * (float)li_);
                  for (int it = gw; it < 16 * 32; it += NGW) { const int kb = it / 32, vb = it % 32; tr_item(wo, D, kb * 64, vb * 32, dst, D, vb * 32, kb * 64, sg + ((kb * 64) & 127) - kb * 64, 1.0f - linit, scr, lane); } }
                { const float* wg = INP(17) + (size_t)j * D * FF; const float* wu = INP(18) + (size_t)j * D * FF; bf16_t* dst = (bf16_t*)(W + WA_GU);
                  for (int it = gw; it < 16 * 88; it += NGW) { const int kb = it / 88, vb = it % 88; const int vrow0 = vb * 64, pn = vrow0 >> 8, v = vrow0 & 255;
                      if (FFN8(li_)) tr_item64_fp8(v < 128 ? wg : wu, FF, kb * 64, pn * 128 + (v & 127), (unsigned char*)dst, D, vrow0, kb * 64, g_ffn, W8_SCALE, scr64, lane);
                      else tr_item64(v < 128 ? wg : wu, FF, kb * 64, pn * 128 + (v & 127), dst, D, vrow0, kb * 64, g_ffn, scr64, lane); } }
                { const float* wd = INP(19) + (size_t)j * FF * D; bf16_t* dst = (bf16_t*)(W + WA_D);
                  for (int it = gw; it < 44 * 16; it += NGW) { const int kb = it / 16, vb = it % 16;
                      if (DN8(li_)) tr_item64_fp8(wd, D, kb * 64, vb * 64, (unsigned char*)dst, FF, vb * 64, kb * 64, nullptr, W8_SCALE, scr64, lane);
                      else tr_item64(wd, D, kb * 64, vb * 64, dst, FF, vb * 64, kb * 64, nullptr, scr64, lane); } }
            } else {
                { const float* wx = INP(20) + (size_t)j * D * D; const float* wy = INP(21) + (size_t)j * D * D; bf16_t* dst = (bf16_t*)(W + WB_IN);
                  for (int it = gw; it < 16 * 64; it += NGW) { const int kb = it / 64, vb = it % 64; const int vrow0 = vb * 32;
                      tr_item(vrow0 < D ? wx : wy, D, kb * 64, vrow0 & (D - 1), dst, D, vrow0, kb * 64, g_mix, 1.f, scr, lane); } }
                { const float* wa = INP(24) + (size_t)j * NE * 128 * 128; const float* wxg = INP(26) + (size_t)j * NE * 128 * 128; bf16_t* dst = (bf16_t*)(W + WB_GT);
                  for (int it = gw; it < 8 * 2 * 8; it += NGW) { const int n = it >> 4, kb = (it >> 3) & 1, vb = it & 7; const int v0 = vb * 32;
                      tr_item((v0 < 128 ? wa : wxg) + (size_t)n * 128 * 128, 128, kb * 64, v0 & 127, dst + (size_t)n * 256 * 128, 128, v0, kb * 64, nullptr, 1.f, scr, lane); } }
                { const float* wo = INP(29) + (size_t)j * D * D; bf16_t* dst = (bf16_t*)(W + WB_OUT);
                  for (int it = gw; it < 16 * 32; it += NGW) { const int kb = it / 32, vb = it % 32; tr_item(wo, D, kb * 64, vb * 32, dst, D, vb * 32, kb * 64, nullptr, 1.f, scr, lane); } }
                { const float* lam = INP(28) + j * D; float* spl = (float*)(MS + MS_SPL);
                  for (int it = bx * 512 + tid; it < D; it += G * 512) { const float xx = __expf(-lam[it]); spl[it] = xx * (1.0f - xx * (0.5f - xx * (0.33333333f - 0.25f * xx))); } }
            }
            { const f32x4* ps = (const f32x4*)(INP(1) + (size_t)li * NTOK * DPLE); u32x2* pd = (u32x2*)P16;
              const size_t stride = (size_t)G * 512;
              for (size_t it = (size_t)bx * 512 + tid; it < (size_t)NTOK * DPLE / 4; it += 8 * stride) { f32x4 v[8];
#pragma unroll
                  for (int q = 0; q < 8; ++q) { const size_t ix = it + q * stride; v[q] = (ix < (size_t)NTOK * DPLE / 4) ? ps[ix] : (f32x4){0.f, 0.f, 0.f, 0.f}; }
#pragma unroll
                  for (int q = 0; q < 8; ++q) { const size_t ix = it + q * stride; if (ix < (size_t)NTOK * DPLE / 4) { u32x2 o; o.x = cvt_pk_bf16(v[q][0], v[q][1]); o.y = cvt_pk_bf16(v[q][2], v[q][3]); pd[ix] = o; } } } }
            if (li_ == 0) for (int m = gw; m < NTOK; m += NGW) {
                const f32x4* xr = (const f32x4*)(INP(0) + (size_t)m * D) + lane; f32x4 v[4]; float s2 = 0.f;
#pragma unroll
                for (int q = 0; q < 4; ++q) { v[q] = xr[64 * q]; s2 += (v[q][0] * v[q][0] + v[q][1] * v[q][1]) + (v[q][2] * v[q][2] + v[q][3] * v[q][3]); }
                s2 = wave_sum(s2);
                u32x2* o8 = (u32x2*)(HC + (size_t)m * D) + lane;
#pragma unroll
                for (int q = 0; q < 4; ++q) { u32x2 o; o.x = cvt_pk_bf16(v[q][0], v[q][1]); o.y = cvt_pk_bf16(v[q][2], v[q][3]); o8[64 * q] = o; }
                if (lane < 16) SC[(size_t)m * 16 + lane] = (lane == 0) ? s2 : 0.f;
            }
}

__global__ void __launch_bounds__(512, 2) fwd_kernel(Args args) {
    extern __shared__ __attribute__((aligned(16))) unsigned char lds_raw[];
    LAS unsigned char* lds = (LAS unsigned char*)lds_raw;
    volatile LAS unsigned* MISC = (volatile LAS unsigned*)(lds + MISC_OFF);
    const int wave_s = __builtin_amdgcn_readfirstlane((int)threadIdx.x >> 6);
    for (int u = tid_of(wave_s); u < (LDS_BYTES - LDSCTL_OFF) / 4; u += 512) ((LAS unsigned*)(lds + LDSCTL_OFF))[u] = 0u;
    __syncthreads();
    XcdBarrier bar = xcd_barrier_post((unsigned*)(args.ws + WS_CTL) + CW_BAR, MISC + 8, wave_s);
#define GRID_BAR() xcd_barrier(bar, wave_s)
    int cur = 0;
    const int nlayers = args.nlayers;
    prep_layer(args, lds, wave_s, 0, cur);
    GRID_BAR();
    for (int li = 0; li < DEPTH; ++li) {
        if (li >= nlayers) break;
        const bool is_attn = !(li & 1);
        if (is_attn) {
            if (PH_ON(1)) DUP_FOR(1) { ES_; PH_LOCALS; LAYER_LOCALS; DenseSched S; S.ord.init(NTOK / 256, 12, G, bx); S.A = (const char*)HC; S.B = (const char*)(W + WA_QKV); S.a_tstep = (size_t)256 * D * 2; S.b_tstep = (size_t)256 * D * 2;
              S.ssp = nullptr;
              if (QKV8(li_)) { S.A = (const char*)(R + R_H8); S.a_tstep = (size_t)256 * D; S.b_tstep = (size_t)256 * D; EpiQKV E{(bf16_t*)(R + R_Q), (bf16_t*)(R + R_K), (bf16_t*)(R + R_V), SC, 1.0f / W8_SCALE, 0};
                pg8::gemm_phase<EpiQKV, DenseSched, false, true>(lds + RING_OFF, (LAS float*)(lds + MISC_OFF + 1024), D / 2, D / 2, D / 2, S, E, wave_s); }
              else { EpiQKV E{(bf16_t*)(R + R_Q), (bf16_t*)(R + R_K), (bf16_t*)(R + R_V), SC, 1.0f, 0};
                pg8::gemm_phase<EpiQKV, DenseSched, false, false>(lds + RING_OFF, (LAS float*)(lds + MISC_OFF + 1024), D, D, D, S, E, wave_s); } }
            GRID_BAR();
            if (PH_ON(2)) DUP_FOR(2) { ES_; PH_LOCALS; LAYER_LOCALS; const attn_body::bf16* Qp = (const attn_body::bf16*)(R + R_Q); const attn_body::bf16* Kp = (const attn_body::bf16*)(R + R_K); const attn_body::bf16* Vp = (const attn_body::bf16*)(R + R_V);
              attn_body::bf16* Op = (attn_body::bf16*)(R + R_OA);
              const float* g_ffn_next = INP(3) + (li_ + 1) * D; bool conv_done = false; const int conv_at = vcu & 15;
#define MOE_CONVERT() do { __syncthreads(); MOE_CONV_BODY __syncthreads(); conv_done = true; } while (0)
              if ((vcu & 1) && li_ + 1 < args.nlayers) { __syncthreads(); prep_layer(args, lds, wave_s, li_ + 1, cur_); __syncthreads(); }
              int ii = 0;
              const float l1_ = wave_sum(INP(12)[j * 64 + lane] * INP(13)[j * 64 + lane]), l2_ = wave_sum(INP(14)[j * 64 + lane] * INP(15)[j * 64 + lane]);
              const float lam = __expf(l1_) - __expf(l2_) + (0.8f - 0.6f * __expf(-0.3f * (float)li_));
              attn_body::f32x16 keep[4];
#pragma unroll
              for (int d0 = 0; d0 < 4; ++d0) keep[d0] = attn_body::f32x16{};
              for (int item = vcu; item < 4096; item += G, ++ii) {
                  if (!conv_done && ii >= conv_at) MOE_CONVERT();
                  const int c = item & 31, xx = (item >> 5) & 7, step = item >> 8; const int bh = xx * 16 + step; const int b = bh >> 3, head = bh & 7; const int qb = (step & 1) ? 31 - c : c;
                  attn_body::attn_unit_ps<8, 0>(b, (2 * head) * 64, head * 128, head * 128, qb, Qp, Kp, Vp, Op, (char*)lds_raw + RING_OFF, wave_s, keep, lam);
                  attn_body::attn_unit_ps<8, 1>(b, (2 * head + 1) * 64, head * 128, head * 128, qb, Qp, Kp, Vp, Op, (char*)lds_raw + RING_OFF, wave_s, keep, lam);
              }
              if (!conv_done) MOE_CONVERT();
#undef MOE_CONVERT
              if (!(vcu & 1) && li_ + 1 < args.nlayers) { __syncthreads(); prep_layer(args, lds, wave_s, li_ + 1, cur_); __syncthreads(); }
              }
            GRID_BAR();
            if (PH_ON(4)) DUP_FOR(4) { ES_; PH_LOCALS; LAYER_LOCALS; DenseSched S; S.ord.init(NTOK / 256, 4, G, bx); S.A = (const char*)(R + R_OA); S.B = (const char*)(W + WA_O); S.a_tstep = (size_t)256 * D * 2; S.b_tstep = (size_t)256 * D * 2;
              S.ssp = nullptr; EpiRes E{HC, HO, SO, FFN8(li_) ? (unsigned char*)(R + R_H8) : nullptr, es_, 0};
              pg8::gemm_phase<EpiRes, DenseSched, false, false>(lds + RING_OFF, (LAS float*)(lds + MISC_OFF + 1024), D, D, D, S, E, wave_s); }
            GRID_BAR(); cur ^= 1;
        } else {
            if (PH_ON(5)) DUP_FOR(5) { ES_; PH_LOCALS; LAYER_LOCALS; DenseSched S; S.ord.init(NTOK / 256, 8, G, bx); S.A = (const char*)HC; S.B = (const char*)(W + WB_IN); S.a_tstep = (size_t)256 * D * 2; S.b_tstep = (size_t)256 * D * 2;
              S.ssp = nullptr; EpiLruIn E{(bf16_t*)(R + R_XL), (bf16_t*)(R + R_Y), SC};
              pg8::gemm_phase<EpiLruIn, DenseSched, false, false>(lds + RING_OFF, (LAS float*)(lds + MISC_OFF + 1024), D, D, D, S, E, wave_s); }
            GRID_BAR();
            if (PH_ON(6)) DUP_FOR(6) { ES_; PH_LOCALS; LAYER_LOCALS; const bf16_t* XL = (const bf16_t*)(R + R_XL); bf16_t* U = (bf16_t*)(R + R_U); const float* cw = INP(22) + (size_t)j * 4 * D; const float* cb = INP(23) + j * D;
              for (int it = gw; it < (NTOK / 32) * 2; it += NGW) { const int chunk = it >> 1, c0 = (it & 1) * 512 + lane * 8; const int row0 = chunk * 32; const int t0 = row0 & (SEQ - 1);
                  float w[4][8], bb[8];
#pragma unroll
                  for (int k = 0; k < 4; ++k) { const f32x4 a = *(const f32x4*)(cw + k * D + c0), b = *(const f32x4*)(cw + k * D + c0 + 4);
#pragma unroll
                      for (int e = 0; e < 4; ++e) { w[k][e] = a[e]; w[k][4 + e] = b[e]; } }
                  { const f32x4 a = *(const f32x4*)(cb + c0), b = *(const f32x4*)(cb + c0 + 4);
#pragma unroll
                    for (int e = 0; e < 4; ++e) { bb[e] = a[e]; bb[4 + e] = b[e]; } }
                  float x0[8], x1[8], x2[8];
#pragma unroll
                  for (int e = 0; e < 8; ++e) { x0[e] = 0.f; x1[e] = 0.f; x2[e] = 0.f; }
                  if (t0 > 0) {
                      const u32x4 q0 = *(const u32x4*)(XL + (size_t)(row0 - 3) * D + c0), q1 = *(const u32x4*)(XL + (size_t)(row0 - 2) * D + c0), q2 = *(const u32x4*)(XL + (size_t)(row0 - 1) * D + c0);
                      const unsigned a0[4] = {q0.x, q0.y, q0.z, q0.w}, a1[4] = {q1.x, q1.y, q1.z, q1.w}, a2[4] = {q2.x, q2.y, q2.z, q2.w};
#pragma unroll
                      for (int q = 0; q < 4; ++q) { x0[2 * q] = bf_lo(a0[q]); x0[2 * q + 1] = bf_hi(a0[q]); x1[2 * q] = bf_lo(a1[q]); x1[2 * q + 1] = bf_hi(a1[q]); x2[2 * q] = bf_lo(a2[q]); x2[2 * q + 1] = bf_hi(a2[q]); }
                  }
                  for (int r8 = 0; r8 < 32; r8 += 8) {
                      u32x4 qq[8];
#pragma unroll
                      for (int r = 0; r < 8; ++r) qq[r] = *(const u32x4*)(XL + (size_t)(row0 + r8 + r) * D + c0);
#pragma unroll
                      for (int r = 0; r < 8; ++r) { const unsigned aq[4] = {qq[r].x, qq[r].y, qq[r].z, qq[r].w}; float x3[8], o[8];
#pragma unroll
                          for (int q = 0; q < 4; ++q) { x3[2 * q] = bf_lo(aq[q]); x3[2 * q + 1] = bf_hi(aq[q]); }
#pragma unroll
                          for (int e = 0; e < 8; ++e) { o[e] = bb[e] + w[0][e] * x0[e] + w[1][e] * x1[e] + w[2][e] * x2[e] + w[3][e] * x3[e]; x0[e] = x1[e]; x1[e] = x2[e]; x2[e] = x3[e]; }
                          qq[r].x = cvt_pk_bf16(o[0], o[1]); qq[r].y = cvt_pk_bf16(o[2], o[3]); qq[r].z = cvt_pk_bf16(o[4], o[5]); qq[r].w = cvt_pk_bf16(o[6], o[7]); }
#pragma unroll
                      for (int r = 0; r < 8; ++r) *(u32x4*)(U + (size_t)(row0 + r8 + r) * D + c0) = qq[r];
                  } } }
            GRID_BAR();
            if (PH_ON(7)) DUP_FOR(7) { ES_; PH_LOCALS; LAYER_LOCALS; GatesSched S; S.ord.init(NTOK / 256, 8, G, bx); S.A = (const char*)(R + R_U); S.B = (const char*)(W + WB_GT);
              EpiGates E{(const bf16_t*)(R + R_U), INP(25) + j * D, INP(27) + j * D, (const float*)(MS + MS_SPL), (bf16_t*)(R + R_LA), (bf16_t*)(R + R_BT)};
              S.ssp = nullptr; pg8::gemm_phase<EpiGates, GatesSched, false, false>(lds + RING_OFF, (LAS float*)(lds + MISC_OFF + 1024), 128, D, 128, S, E, wave_s); }
            GRID_BAR();
            if (PH_ON(8)) DUP_FOR(8) { ES_; PH_LOCALS; LAYER_LOCALS; const bf16_t* LA = (const bf16_t*)(R + R_LA); const bf16_t* BT = (const bf16_t*)(R + R_BT);
              LAS float* cs = (LAS float*)(lds + RING_OFF);
              float* CS = (float*)(ws + WS_SCAN); float* CST = (float*)(ws + WS_SCAN + 16 * MiB);
              for (int item = bx; item < NB * 16; item += G) { const int b = item >> 4, cg = (item >> 1) & 7, half = item & 1, c0 = cg * 128 + lane * 2; const size_t base = ((size_t)b * SEQ + half * 2048 + wave * 256) * D + c0;
                  float P0[8], P1[8], h0[8], h1[8]; const char* pla[8]; const char* pbt[8];
#pragma unroll
                  for (int q = 0; q < 8; ++q) { P0[q] = 1.f; P1[q] = 1.f; h0[q] = 0.f; h1[q] = 0.f; const size_t o = (base + (size_t)q * 32 * D) * 2; pla[q] = (const char*)LA + o; pbt[q] = (const char*)BT + o; }
#pragma unroll 1
                  for (int t2 = 0; t2 < 32; t2 += 2) {
                      unsigned la[2][8], bt[2][8];
#pragma unroll
                      for (int s = 0; s < 2; ++s)
#pragma unroll
                          for (int q = 0; q < 8; ++q) { la[s][q] = *(const unsigned*)(pla[q] + s * (D * 2)); bt[s][q] = *(const unsigned*)(pbt[q] + s * (D * 2)); }
#pragma unroll
                      for (int s = 0; s < 2; ++s)
#pragma unroll
                          for (int q = 0; q < 8; ++q) { const float a0 = __builtin_amdgcn_exp2f(1.4426950408889634f * bf_lo(la[s][q])), a1 = __builtin_amdgcn_exp2f(1.4426950408889634f * bf_hi(la[s][q]));
                              h0[q] = a0 * h0[q] + bf_lo(bt[s][q]); h1[q] = a1 * h1[q] + bf_hi(bt[s][q]); P0[q] *= a0; P1[q] *= a1; }
#pragma unroll
                      for (int q = 0; q < 8; ++q) { pla[q] += 2 * D * 2; pbt[q] += 2 * D * 2; } }
#pragma unroll
                  for (int q = 0; q < 8; ++q) { const int sg = wave * 8 + q; cs[(sg * 2 + 0) * 128 + lane * 2] = P0[q]; cs[(sg * 2 + 0) * 128 + lane * 2 + 1] = P1[q]; cs[(sg * 2 + 1) * 128 + lane * 2] = h0[q]; cs[(sg * 2 + 1) * 128 + lane * 2 + 1] = h1[q]; }
                  __syncthreads();
                  if (tid < 128) { float pc = 1.f, hc = 0.f; float* csg = CS + (size_t)item * (64 * 2 * 128) + tid;
                      for (int sg = 0; sg < 64; ++sg) { csg[(sg * 2 + 0) * 128] = pc; csg[(sg * 2 + 1) * 128] = hc; const float p = cs[(sg * 2 + 0) * 128 + tid], h = cs[(sg * 2 + 1) * 128 + tid]; hc = p * hc + h; pc = p * pc; }
                      CST[item * 256 + tid] = pc; CST[item * 256 + 128 + tid] = hc; }
                  __syncthreads();
              } }
            GRID_BAR();
            if (PH_ON(8)) DUP_FOR(8) { ES_; PH_LOCALS; LAYER_LOCALS; const bf16_t* LA = (const bf16_t*)(R + R_LA); const bf16_t* BT = (const bf16_t*)(R + R_BT); const bf16_t* Y = (const bf16_t*)(R + R_Y); bf16_t* HY = (bf16_t*)(R + R_HY);
              const float* CS = (const float*)(ws + WS_SCAN); const float* CST = (const float*)(ws + WS_SCAN + 16 * MiB);
              for (int item = bx; item < NB * 16; item += G) { const int b = item >> 4, cg = (item >> 1) & 7, half = item & 1, c0 = cg * 128 + lane * 2; const size_t base = ((size_t)b * SEQ + half * 2048 + wave * 256) * D + c0;
                  float h0[8], h1[8]; const char* pla[8]; const char* pbt[8]; const char* py[8]; char* phy[8];
                  f32x2 hs = (f32x2){0.f, 0.f}; if (half) hs = *(const f32x2*)(CST + (item - 1) * 256 + 128 + lane * 2);
#pragma unroll
                  for (int q = 0; q < 8; ++q) { const float* cp = CS + (size_t)item * (64 * 2 * 128) + ((wave * 8 + q) * 2) * 128 + lane * 2; const f32x2 pc = *(const f32x2*)cp, hc = *(const f32x2*)(cp + 128);
                      h0[q] = pc[0] * hs[0] + hc[0]; h1[q] = pc[1] * hs[1] + hc[1];
                      const size_t o = (base + (size_t)q * 32 * D) * 2; pla[q] = (const char*)LA + o; pbt[q] = (const char*)BT + o; py[q] = (const char*)Y + o; phy[q] = (char*)HY + o; }
#pragma unroll 1
                  for (int t2 = 0; t2 < 32; t2 += 2) {
                      unsigned la[2][8], bt[2][8], yy[2][8];
#pragma unroll
                      for (int s = 0; s < 2; ++s)
#pragma unroll
                          for (int q = 0; q < 8; ++q) { la[s][q] = *(const unsigned*)(pla[q] + s * (D * 2)); bt[s][q] = *(const unsigned*)(pbt[q] + s * (D * 2)); yy[s][q] = *(const unsigned*)(py[q] + s * (D * 2)); }
#pragma unroll
                      for (int s = 0; s < 2; ++s)
#pragma unroll
                          for (int q = 0; q < 8; ++q) { const float a0 = __builtin_amdgcn_exp2f(1.4426950408889634f * bf_lo(la[s][q])), a1 = __builtin_amdgcn_exp2f(1.4426950408889634f * bf_hi(la[s][q]));
                              h0[q] = a0 * h0[q] + bf_lo(bt[s][q]); h1[q] = a1 * h1[q] + bf_hi(bt[s][q]); yy[s][q] = cvt_pk_bf16(h0[q] * bf_lo(yy[s][q]), h1[q] * bf_hi(yy[s][q])); }
#pragma unroll
                      for (int s = 0; s < 2; ++s)
#pragma unroll
                          for (int q = 0; q < 8; ++q) *(unsigned*)(phy[q] + s * (D * 2)) = yy[s][q];
#pragma unroll
                      for (int q = 0; q < 8; ++q) { pla[q] += 2 * D * 2; pbt[q] += 2 * D * 2; py[q] += 2 * D * 2; phy[q] += 2 * D * 2; } }
              } }
            GRID_BAR();
            if (PH_ON(9)) DUP_FOR(9) { ES_; PH_LOCALS; LAYER_LOCALS; DenseSched S; S.ord.init(NTOK / 256, 4, G, bx); S.A = (const char*)(R + R_HY); S.B = (const char*)(W + WB_OUT); S.a_tstep = (size_t)256 * D * 2; S.b_tstep = (size_t)256 * D * 2;
              S.ssp = nullptr; EpiRes E{HC, HO, SO, nullptr, es_, 0};
              pg8::gemm_phase<EpiRes, DenseSched, false, false>(lds + RING_OFF, (LAS float*)(lds + MISC_OFF + 1024), D, D, D, S, E, wave_s); }
            GRID_BAR(); cur ^= 1;
        }

        if (is_attn) {
            if (FFN8(li)) {
            if (PH_ON(10)) DUP_FOR(10) { ES_; PH_LOCALS; LAYER_LOCALS; DenseSched S; S.ord.init(NTOK / 256, 22, G, bx); S.A = (const char*)(R + R_H8); S.B = (const char*)(W + WA_GU); S.a_tstep = (size_t)256 * D * 1; S.b_tstep = (size_t)256 * D * 1;
              S.ssp = nullptr; EpiSwiGLU E{(bf16_t*)(R + R_HID), SC, nullptr, FF, 1, 1, 0};
              pg8::gemm_phase<EpiSwiGLU, DenseSched, false, true>(lds + RING_OFF, (LAS float*)(lds + MISC_OFF + 1024), D * 1 / 2, D * 1 / 2, D * 1 / 2, S, E, wave_s); }
            } else {
            if (PH_ON(10)) DUP_FOR(10) { ES_; PH_LOCALS; LAYER_LOCALS; DenseSched S; S.ord.init(NTOK / 256, 22, G, bx); S.A = (const char*)HC; S.B = (const char*)(W + WA_GU); S.a_tstep = (size_t)256 * D * 2; S.b_tstep = (size_t)256 * D * 2;
              S.ssp = nullptr; EpiSwiGLU E{(bf16_t*)(R + R_HID), SC, nullptr, FF, 0, (int)DN8(li_), 0};
              pg8::gemm_phase<EpiSwiGLU, DenseSched, false, false>(lds + RING_OFF, (LAS float*)(lds + MISC_OFF + 1024), D * 2 / 2, D * 2 / 2, D * 2 / 2, S, E, wave_s); }
            }
            GRID_BAR();
            if (DN8(li)) {
            if (PH_ON(11)) DUP_FOR(11) { ES_; PH_LOCALS; LAYER_LOCALS; DenseSched S; S.ord.init(NTOK / 256, 4, G, bx); S.A = (const char*)(R + R_HID); S.B = (const char*)(W + WA_D); S.a_tstep = (size_t)256 * FF * 1; S.b_tstep = (size_t)256 * FF * 1;
              S.ssp = nullptr; EpiRes E{HC, HO, SO, (unsigned char*)(R + R_H8), es_ * (1.0f / (W8_SCALE * H8_SCALE)), 0};
              pg8::gemm_phase<EpiRes, DenseSched, false, true>(lds + RING_OFF, (LAS float*)(lds + MISC_OFF + 1024), FF * 1 / 2, FF * 1 / 2, FF * 1 / 2, S, E, wave_s); }
            } else {
            if (PH_ON(11)) DUP_FOR(11) { ES_; PH_LOCALS; LAYER_LOCALS; DenseSched S; S.ord.init(NTOK / 256, 4, G, bx); S.A = (const char*)(R + R_HID); S.B = (const char*)(W + WA_D); S.a_tstep = (size_t)256 * FF * 2; S.b_tstep = (size_t)256 * FF * 2;
              S.ssp = nullptr; EpiRes E{HC, HO, SO, (unsigned char*)(R + R_H8), es_, 0};
              pg8::gemm_phase<EpiRes, DenseSched, false, false>(lds + RING_OFF, (LAS float*)(lds + MISC_OFF + 1024), FF * 2 / 2, FF * 2 / 2, FF * 2 / 2, S, E, wave_s); }
            }
            GRID_BAR(); cur ^= 1;
        } else {
            if (PH_ON(12)) DUP_FOR(12) { ES_; PH_LOCALS; LAYER_LOCALS; LAS float* wr_l = (LAS float*)(lds + RING_OFF);
              LAS int* e_l = (LAS int*)(lds + RING_OFF + 32768);
              LAS unsigned* bc_l = (LAS unsigned*)(lds + RING_OFF + 32768 + 2048);
              LAS float* lg_l = (LAS float*)(lds + RING_OFF + 32768 + 4096);
              const float* wrt = INP(30) + (size_t)j * D * NE;
              for (int it = tid; it < D * NE; it += 512) { const int k = it >> 3, e = it & 7, q = k >> 9, r = k & 511; wr_l[((q * 8 + (r & 7)) * 64 + (r >> 3)) * 8 + e] = wrt[it] * g_ffn[k]; }
              int* TOPE = (int*)(MS + MS_TOPE); float* TOPG = (float*)(MS + MS_TOPG); int* RANK = (int*)(MS + MS_RANK); int* BC = (int*)(MS + MS_BC);
              const bool b0 = lane & 1, b1 = lane & 2, b2 = lane & 4; const int eidx = 4 * (lane & 1) + (lane & 2) + ((lane >> 2) & 1);
              for (int vb = bx; vb < NTOK / 256; vb += G) {
                  if (tid < 16) bc_l[tid] = 0u;
                  __syncthreads();
                  for (int r8 = 0; r8 < 32; r8 += 8) {
                      u32x4 xw[8][2];
#pragma unroll
                      for (int rr = 0; rr < 8; ++rr) { const u32x4* xr = (const u32x4*)(HC + (size_t)(vb * 256 + wave * 32 + r8 + rr) * D) + lane; xw[rr][0] = xr[0]; xw[rr][1] = xr[64]; }
#pragma unroll
                      for (int rr = 0; rr < 8; ++rr) { float lg[8];
#pragma unroll
                          for (int e = 0; e < 8; ++e) lg[e] = 0.f;
#pragma unroll
                          for (int q = 0; q < 2; ++q) { const unsigned ww[4] = {xw[rr][q].x, xw[rr][q].y, xw[rr][q].z, xw[rr][q].w};
#pragma unroll
                              for (int c = 0; c < 8; ++c) { const float xv = (c & 1) ? bf_hi(ww[c >> 1]) : bf_lo(ww[c >> 1]); const LAS float* wp = wr_l + ((q * 8 + c) * 64 + lane) * 8; const f32x4 w0 = *(const LAS f32x4*)wp, w1 = *(const LAS f32x4*)(wp + 4);
#pragma unroll
                                  for (int e = 0; e < 4; ++e) { lg[e] += xv * w0[e]; lg[4 + e] += xv * w1[e]; } } }
                          float r4[4], r2[2];
#pragma unroll
                          for (int i = 0; i < 4; ++i) { const float snd = b0 ? lg[i] : lg[4 + i], kp = b0 ? lg[4 + i] : lg[i]; r4[i] = kp + swz_xor<1>(snd); }
#pragma unroll
                          for (int i = 0; i < 2; ++i) { const float snd = b1 ? r4[i] : r4[2 + i], kp = b1 ? r4[2 + i] : r4[i]; r2[i] = kp + swz_xor<2>(snd); }
                          float r1 = (b2 ? r2[1] : r2[0]) + swz_xor<4>(b2 ? r2[0] : r2[1]);
                          r1 += swz_xor<8>(r1); r1 += swz_xor<16>(r1); r1 = add_x32(r1);
                          if (lane < 8) lg_l[(wave * 32 + r8 + rr) * 8 + eidx] = r1; } }
                  __syncthreads();
                  if (tid < 256) { const int m = vb * 256 + tid; const float rstd = rstd_of(SC, m); float lg[8];
                      { const f32x4 a = *(const LAS f32x4*)(lg_l + tid * 8), b = *(const LAS f32x4*)(lg_l + tid * 8 + 4);
#pragma unroll
                        for (int e = 0; e < 4; ++e) { lg[e] = a[e] * rstd; lg[4 + e] = b[e] * rstd; } }
                      int e0 = 0; float v0 = lg[0];
#pragma unroll
                      for (int e = 1; e < 8; ++e) if (lg[e] > v0) { v0 = lg[e]; e0 = e; }
                      int e1 = -1; float v1 = -INFINITY;
#pragma unroll
                      for (int e = 0; e < 8; ++e) if (e != e0 && lg[e] > v1) { v1 = lg[e]; e1 = e; }
                      const float g0 = 1.0f / (1.0f + __expf(v1 - v0));
                      e_l[tid] = e0; e_l[256 + tid] = e1; TOPE[m * 2] = e0; TOPE[m * 2 + 1] = e1; TOPG[m * 2] = g0; TOPG[m * 2 + 1] = 1.0f - g0; }
                  __syncthreads();
                  if (tid < 256) { const int me0 = e_l[tid], me1 = e_l[256 + tid]; int r0 = 0, r1 = 0;
                      for (int q = 0; q < tid; ++q) { r0 += (e_l[q] == me0) ? 1 : 0; r1 += (e_l[256 + q] == me1) ? 1 : 0; }
                      const int m = vb * 256 + tid; RANK[m * 2] = r0; RANK[m * 2 + 1] = r1;
                      atomicAdd((unsigned*)&bc_l[me0], 1u); atomicAdd((unsigned*)&bc_l[8 + me1], 1u); }
                  __syncthreads();
                  if (tid < 16) BC[vb * 16 + tid] = (int)bc_l[tid];
                  __syncthreads();
              } }
            GRID_BAR();
            if (PH_ON(13)) DUP_FOR(13) { ES_; PH_LOCALS; LAYER_LOCALS; LAS int* bcl = (LAS int*)(lds + RING_OFF);
              const int* BC = (const int*)(MS + MS_BC); const int* TOPE = (const int*)(MS + MS_TOPE); const float* TOPG = (const float*)(MS + MS_TOPG); const int* RANK = (const int*)(MS + MS_RANK);
              int* STOK = (int*)(MS + MS_STOK); float* SGATE = (float*)(MS + MS_SGATE); float* SRS = (float*)(MS + MS_SRS);
              for (int it = tid; it < 256 * 16; it += 512) bcl[it] = BC[it];
              __syncthreads();
              if (tid < 16) { int run = 0; for (int vb = 0; vb < 256; ++vb) { const int c = bcl[vb * 16 + tid]; bcl[vb * 16 + tid] = run; run += c; } MISC[MW_CNT + tid] = (unsigned)run; }
              __syncthreads();
              if (tid < 2) { int ts = 0; for (int e = 0; e < 8; ++e) { MISC[MW_TST + tid * 9 + e] = (unsigned)ts; ts += ((int)MISC[MW_CNT + tid * 8 + e] + 255) >> 8; } MISC[MW_TST + tid * 9 + 8] = (unsigned)ts; }
              __syncthreads();
              LAS int* sl_l = (LAS int*)(lds + RING_OFF + 16384);
              for (int vb = bx; vb < NTOK / 256; vb += G) {
                  if (tid < 256) { const int m = vb * 256 + tid; const float rsm = rstd_of(SC, m);
#pragma unroll
                      for (int k = 0; k < 2; ++k) { const int e = TOPE[m * 2 + k]; const int slot = (int)MISC[MW_TST + k * 9 + e] * 256 + bcl[vb * 16 + k * 8 + e] + RANK[m * 2 + k];
                          STOK[k * SLOTS_PER_PASS + slot] = m; SGATE[k * SLOTS_PER_PASS + slot] = TOPG[m * 2 + k]; SRS[k * SLOTS_PER_PASS + slot] = rsm; sl_l[k * 256 + tid] = slot; } }
                  __syncthreads();
                  if (MOE_FP8) {
                      unsigned char* XS8 = R + R_XS8;
                      for (int t4 = wave * 32; t4 < wave * 32 + 32; t4 += 8) { u32x4 v[8];
#pragma unroll
                          for (int q = 0; q < 8; ++q) { const u32x4* hp = (const u32x4*)(HC + (size_t)(vb * 256 + t4 + q) * D + lane * 16); const u32x4 a = hp[0], b = hp[1];
                              v[q].x = pk_fp8x4(bf_lo(a.x), bf_hi(a.x), bf_lo(a.y), bf_hi(a.y)); v[q].y = pk_fp8x4(bf_lo(a.z), bf_hi(a.z), bf_lo(a.w), bf_hi(a.w));
                              v[q].z = pk_fp8x4(bf_lo(b.x), bf_hi(b.x), bf_lo(b.y), bf_hi(b.y)); v[q].w = pk_fp8x4(bf_lo(b.z), bf_hi(b.z), bf_lo(b.w), bf_hi(b.w)); }
#pragma unroll
                          for (int q = 0; q < 8; ++q) { const int s0 = sl_l[t4 + q], s1 = sl_l[256 + t4 + q];
                              *(u32x4*)(XS8 + (size_t)s0 * D + lane * 16) = v[q]; *(u32x4*)(XS8 + ((size_t)SLOTS_PER_PASS + s1) * D + lane * 16) = v[q]; } } }
                  __syncthreads();
              }
              __syncthreads();
            }
            GRID_BAR();
            static_assert(MOE_FP8 != 0, "the merged MoE phase parts read the pre-gathered e4m3 tokens");
            for (int k = 0; k < 3; ++k) {
#define MOE_LOCALS(kk) int k_ = (kk); asm volatile("" : "+s"(k_)); const volatile LAS unsigned* cnt = MISC + MW_CNT + k_ * 8; const volatile LAS unsigned* tst = MISC + MW_TST + k_ * 9; const int MT = (int)tst[8]; \
                const int* stok = (const int*)(MS + MS_STOK) + k_ * SLOTS_PER_PASS; const float* sgate = (const float*)(MS + MS_SGATE) + k_ * SLOTS_PER_PASS; (void)cnt; (void)sgate
                if (k >= 1) if (PH_ON(15)) DUP_FOR(15) { ES_; PH_LOCALS; LAYER_LOCALS; MOE_LOCALS(k - 1); MoeDownSched S; S.ord.init(MT, 4, G, bx); S.A = (const char*)(R + (k_ ? R_MHID1 : R_MHID)); S.B = (const char*)(W + WB_MD); S.tst = tst;
                  EpiMoeDown E{HC, HO, stok, sgate, SO, cnt, tst, (unsigned char*)(R + R_H8B), MOE_FP8 ? es_ * (1.0f / (W8_SCALE * H8_SCALE)) : es_, k_};
                  S.ssp = nullptr; pg8::gemm_phase<EpiMoeDown, MoeDownSched, false, MOE_FP8 != 0>(lds + RING_OFF, (LAS float*)(lds + MISC_OFF + 1024), FFE * MOE_ESZ / 2, FFE * MOE_ESZ / 2, FFE * MOE_ESZ / 2, S, E, wave_s); }
                if (k < 2) if (PH_ON(14)) DUP_FOR(14) { ES_; PH_LOCALS; LAYER_LOCALS; MOE_LOCALS(k); MoeGuSched S; S.ord.init(MT, 28, G, bx); if (k_ == 1) S.ord.comp(((int)MISC[MW_TST + 8] * 4) % G, 3);
                  S.A = (const char*)(R + R_XS8) + (size_t)k_ * SLOTS_PER_PASS * D; S.B = (const char*)(W + WB_MGU); S.stok = stok; S.cnt = cnt; S.tst = tst;
                  S.ssp = nullptr; EpiSwiGLU E{(bf16_t*)(R + (k_ ? R_MHID1 : R_MHID)), nullptr, (const float*)(MS + MS_SRS) + k_ * SLOTS_PER_PASS, FFE, MOE_FP8, MOE_FP8, 0};
                  pg8::gemm_phase<EpiSwiGLU, MoeGuSched, MOE_FP8 == 0, MOE_FP8 != 0>(lds + RING_OFF, (LAS float*)(lds + MISC_OFF + 1024), D * MOE_ESZ / 2, D * MOE_ESZ / 2, D * MOE_ESZ / 2, S, E, wave_s); }
                if (k < 2) { GRID_BAR(); if (k >= 1) cur ^= 1; }
            }
        }

        if (PH_ON(16)) DUP_FOR(16) { ES_; PH_LOCALS; LAYER_LOCALS; DenseSched S; S.ord.init(NTOK / 256, 4, G, bx); if (!is_attn) S.ord.comp(((int)MISC[MW_TST + 9 + 8] * 4) % G, 4); S.A = (const char*)P16; S.B = (const char*)(W + (is_attn ? WA_PP : WB_PP)); S.a_tstep = (size_t)256 * DPLE * 2; S.b_tstep = (size_t)256 * DPLE * 2;
          S.ssp = nullptr; EpiBf16 E{PROJ};
          pg8::gemm_phase<EpiBf16, DenseSched, false, false>(lds + RING_OFF, (LAS float*)(lds + MISC_OFF + 1024), DPLE, DPLE, DPLE, S, E, wave_s); }
        if (!is_attn) { GRID_BAR(); cur ^= 1; }
        if (PH_ON(17)) DUP_FOR(17) { ES_; PH_LOCALS; LAYER_LOCALS; DenseSched S; S.ord.init(NTOK / 256, 4, G, bx); S.A = (const char*)(R + (is_attn ? R_H8 : R_H8B)); S.B = (const char*)(W + (is_attn ? WA_PG : WB_PG)); S.a_tstep = (size_t)256 * D; S.b_tstep = (size_t)256 * D;
          S.ssp = nullptr; EpiPleGate E{HC, PROJ, SC, HO, SO, (li_ + 1 < DEPTH && QKV8(li_ + 1)) ? (unsigned char*)(R + R_H8) : nullptr, es_, 1.0f / W8_SCALE};
          pg8::gemm_phase<EpiPleGate, DenseSched, false, true>(lds + RING_OFF, (LAS float*)(lds + MISC_OFF + 1024), D / 2, D / 2, D / 2, S, E, wave_s); }
        if (!is_attn && li + 1 < nlayers) prep_layer(args, lds, wave_s, li + 1, cur);
        GRID_BAR(); cur ^= 1;
    }

    { PH_LOCALS; const float* ln_final = INP(5); const bool poison = xb_ld(&bar.bar[XB_TMO]) != 0u; float* OUT = args.out;
      const f32x4* gf = (const f32x4*)ln_final + 2 * lane; const f32x4 g00 = gf[0], g01 = gf[1], g10 = gf[128], g11 = gf[129];
      for (int m0 = gw * 4; m0 < NTOK; m0 += NGW * 4) {
        u32x4 w[4][2];
#pragma unroll
        for (int r = 0; r < 4; ++r) { const u32x4* xr = (const u32x4*)(HC + (size_t)(m0 + r) * D) + lane; w[r][0] = xr[0]; w[r][1] = xr[64]; }
        f32x4 v[4][4];
#pragma unroll
        for (int r = 0; r < 4; ++r) { float s = 0.f;
#pragma unroll
            for (int q = 0; q < 2; ++q) { const u32x4 x = w[r][q]; v[r][2 * q] = (f32x4){bf_lo(x.x), bf_hi(x.x), bf_lo(x.y), bf_hi(x.y)}; v[r][2 * q + 1] = (f32x4){bf_lo(x.z), bf_hi(x.z), bf_lo(x.w), bf_hi(x.w)}; s += sumsq8(v[r][2 * q], v[r][2 * q + 1]); }
            float rstd = __builtin_amdgcn_rsqf(wave_sum(s) * (1.f / D) + NORM_EPS); if (poison) rstd = __builtin_nanf("");
            v[r][0] = v[r][0] * rstd * g00; v[r][1] = v[r][1] * rstd * g01; v[r][2] = v[r][2] * rstd * g10; v[r][3] = v[r][3] * rstd * g11; }
#pragma unroll
        for (int r = 0; r < 4; ++r) { f32x4* o = (f32x4*)(OUT + (size_t)(m0 + r) * D) + 2 * lane; o[0] = v[r][0]; o[1] = v[r][1]; o[128] = v[r][2]; o[129] = v[r][3]; }
      } }
}

extern "C" void kernel_launch(void* const* d_in, const int* in_sizes, int n_in, void* d_out, int out_size, void* d_ws, size_t ws_size, hipStream_t stream) {
    static int grid = 0;
    if (grid == 0) {
        if (n_in != 34 || out_size != NTOK * D || ws_size < WS_END) { fprintf(stderr, "kernel_launch: unexpected shapes (n_in %d out %d ws %zu)\n", n_in, out_size, ws_size); grid = -1; return; }
        int dev = 0, cus = 0, per_cu = 0;
        if (hipGetDevice(&dev) != hipSuccess || hipDeviceGetAttribute(&cus, hipDeviceAttributeMultiprocessorCount, dev) != hipSuccess) { grid = -1; return; }
        if (hipFuncSetAttribute((const void*)fwd_kernel, hipFuncAttributeMaxDynamicSharedMemorySize, LDS_BYTES) != hipSuccess) { fprintf(stderr, "kernel_launch: hipFuncSetAttribute failed\n"); grid = -1; return; }
        if (hipOccupancyMaxActiveBlocksPerMultiprocessor(&per_cu, (const void*)fwd_kernel, 512, LDS_BYTES) != hipSuccess || per_cu < 1) { fprintf(stderr, "kernel_launch: occupancy query says %d\n", per_cu); }
        (void)hipGetLastError();
        grid = cus;
    }
    if (grid < 0) return;
    (void)hipMemsetAsync((char*)d_ws + WS_CTL, 0, CTL_ZERO_BYTES, stream);
    Args a{};
    for (int i = 0; i < 34; ++i) a.in[i] = (const float*)d_in[i];
    a.out = (float*)d_out; a.ws = (unsigned char*)d_ws; a.nlayers = DEPTH; a.pad = 0;
    hipLaunchKernelGGL(fwd_kernel, dim3(grid), dim3(512), LDS_BYTES, stream, a);
}
```

```cpp
#include <hip/hip_runtime.h>
#include <hip/hip_bf16.h>
#include <cstdio>
#include <cstdint>
#include <cmath>

#define GAS __attribute__((address_space(1)))
#define LAS __attribute__((address_space(3)))
typedef unsigned short bf16_t;
typedef short bf16x8 __attribute__((ext_vector_type(8)));
typedef float f32x4 __attribute__((ext_vector_type(4)));
typedef float f32x2 __attribute__((ext_vector_type(2)));
typedef unsigned u32x4 __attribute__((ext_vector_type(4)));
typedef unsigned u32x2 __attribute__((ext_vector_type(2)));
typedef int v4i_t __attribute__((ext_vector_type(4)));
typedef int v8i_t __attribute__((ext_vector_type(8)));

constexpr int NB = 16, SEQ = 4096, D = 1024, NTOK = NB * SEQ, DEPTH = 4;
constexpr int FF = 2816, FFE = 3584, NE = 8, DPLE = 256;
constexpr float NORM_EPS = 1e-6f, SUBLN_EPS = 1e-5f;
constexpr float C2 = 0.125f * 1.4426950408889634f;

__device__ __forceinline__ unsigned cvt_pk_bf16(float lo, float hi) { unsigned r; asm volatile("v_cvt_pk_bf16_f32 %0, %1, %2" : "=v"(r) : "v"(lo), "v"(hi)); return r; }
__device__ __forceinline__ float bf_lo(unsigned w) { return __uint_as_float(w << 16); }
__device__ __forceinline__ float bf_hi(unsigned w) { return __uint_as_float(w & 0xffff0000u); }
__device__ __forceinline__ float fast_sigmoid(float x) { return __builtin_amdgcn_rcpf(1.0f + __builtin_amdgcn_exp2f(-1.4426950408889634f * x)); }

template <int M> __device__ __forceinline__ float swz_xor(float v) { return __int_as_float(__builtin_amdgcn_ds_swizzle(__float_as_int(v), (M << 10) | 0x1f)); }
__device__ __forceinline__ float add_x32(float v) { auto rr = __builtin_amdgcn_permlane32_swap(__float_as_uint(v), __float_as_uint(v), false, false); return __uint_as_float(rr[0]) + __uint_as_float(rr[1]); }
__device__ __forceinline__ unsigned pk_fp8x4(float a, float b, float c, float d) {
    a = __builtin_fminf(__builtin_fmaxf(a, -448.f), 448.f); b = __builtin_fminf(__builtin_fmaxf(b, -448.f), 448.f); c = __builtin_fminf(__builtin_fmaxf(c, -448.f), 448.f); d = __builtin_fminf(__builtin_fmaxf(d, -448.f), 448.f);
    int w = 0; w = __builtin_amdgcn_cvt_pk_fp8_f32(a, b, w, false); w = __builtin_amdgcn_cvt_pk_fp8_f32(c, d, w, true); return (unsigned)w; }
__device__ __forceinline__ unsigned pk_fp8x4_m3(float a, float b, float c, float d) {
    a = __builtin_amdgcn_fmed3f(a, -448.f, 448.f); b = __builtin_amdgcn_fmed3f(b, -448.f, 448.f); c = __builtin_amdgcn_fmed3f(c, -448.f, 448.f); d = __builtin_amdgcn_fmed3f(d, -448.f, 448.f);
    int w = 0; w = __builtin_amdgcn_cvt_pk_fp8_f32(a, b, w, false); w = __builtin_amdgcn_cvt_pk_fp8_f32(c, d, w, true); return (unsigned)w; }
constexpr float W8_SCALE = 64.0f, H8_SCALE = 8.0f;
__device__ __forceinline__ int tid_of(int wave_s) { unsigned m_ = ~0u; asm volatile("" : "+s"(m_), "+s"(wave_s)); return wave_s * 64 + (int)__builtin_amdgcn_mbcnt_hi(m_, __builtin_amdgcn_mbcnt_lo(m_, 0u)); }
__device__ __forceinline__ float rstd_of(const float* ssp, int row) {
    const f32x4* p = (const f32x4*)(ssp + (size_t)row * 16); const f32x4 a = p[0], b = p[1], c = p[2], d = p[3];
    const float s = (((a[0] + a[1]) + (a[2] + a[3])) + ((b[0] + b[1]) + (b[2] + b[3]))) + (((c[0] + c[1]) + (c[2] + c[3])) + ((d[0] + d[1]) + (d[2] + d[3])));
    return __builtin_amdgcn_rsqf(s * (1.f / D) + NORM_EPS);
}
namespace pg8 {
constexpr int BM = 256, BK = 64, HALF = 128, HTB = HALF * BK * 2, STAGE_BYTES = 8 * HTB, NXCD = 8, WGM = 8;
__host__ __device__ __forceinline__ int lds_byte(int r, int c) { const int st = (r >> 4) * 2 + (c >> 5), rr = r & 15, cc = c & 31, ob = rr * 64 + cc * 2; return st * 1024 + (ob ^ (((ob >> 9) & 1) << 5)); }
__host__ __device__ __forceinline__ void stage_rc(int b, int& R, int& C) { const int st = b / 1024, sb = b % 1024, swz = sb ^ (((sb >> 9) & 1) << 5); R = (st >> 1) * 16 + swz / 64; C = (st & 1) * 32 + (swz % 64) / 2; }
__host__ __device__ __forceinline__ int perm32(int rho) { const int n = rho >> 4, i = rho & 15; return 8 * (i >> 2) + 4 * n + (i & 3); }

struct Unit { int pm, pn; };
struct StaticOrder {
    int nM, nN, nwg, G, c, heavy, xs;
    __device__ __forceinline__ void init(int nM_, int nN_, int G_, int c_) { nM = nM_; nN = nN_; nwg = nM * nN; G = G_; c = c_; heavy = 0; xs = 0; }
    __device__ __forceinline__ void comp(int heavy_, int xs_) { heavy = heavy_; xs = heavy_ > 0 ? xs_ : 0; }
    __device__ __forceinline__ bool next(int i, Unit& u) const {
        long L = (long)i * G + c;
        if (xs > 0) { const long base = (long)xs * (G - heavy); L = (c < heavy) ? base + (long)i * G + c : (i < xs ? (long)i * (G - heavy) + (c - heavy) : base + (long)(i - xs) * G + c); }
        if (L >= nwg) return false;
        int wgid = (int)L; { const int q = nwg / NXCD, r = nwg % NXCD, xcd = wgid % NXCD, off = wgid / NXCD; wgid = (xcd < r ? xcd * (q + 1) : r * (q + 1) + (xcd - r) * q) + off; }
        const int nig = WGM * nN, gid = wgid / nig, fm = gid * WGM, gsz = (nM - fm) < WGM ? (nM - fm) : WGM;
        u.pm = fm + ((wgid % nig) % gsz); u.pn = (wgid % nig) / gsz; return true;
    }
};

template <class Epi, class Sched, bool GATHER, bool FP8>
__device__ __forceinline__ void gemm_phase(LAS unsigned char* lds, LAS float* rs_lds, const int K, const int lda, const int ldb, const Sched& S, const Epi& E, const int wave_s) {
    int tid = tid_of(wave_s); asm volatile("" : "+v"(tid));
    const int wid = __builtin_amdgcn_readfirstlane(tid >> 6), lane = tid & 63, wr = wid >> 2, wc = wid & 3, fr = lane & 15, fq = lane >> 4;
    int K_ = K; asm volatile("" : "+s"(K_)); const int nt = K_ / BK;
    int sR[2], sC[2];
    unsigned voffB[2], vA[2][2], vN[2][2];
#pragma unroll
    for (int i = 0; i < 2; ++i) { stage_rc(tid * 16 + i * 8192, sR[i], sC[i]); const int Rb = Epi::PERM ? ((sR[i] & ~31) + perm32(sR[i] & 31)) : sR[i];
        voffB[i] = (unsigned)(Rb * ldb + sC[i]) * 2u; }
    const size_t kstep = (size_t)(BK * 2);
    const size_t hstepB = (size_t)HALF * ldb * 2;
    const unsigned ldsw = (unsigned)wid * 1024u;
    const int aoff = lds_byte(wr * 64 + fr, fq * 8), boff = lds_byte(wc * 32 + fr, fq * 8);
#define PG8_SA(b, h) (((b) * 2 + (h)) * HTB)
#define PG8_SB(b, h) ((4 + (b) * 2 + (h)) * HTB)
#define PG8_STAGE(bufoff, gbase, voff) do { _Pragma("unroll") for (int _i = 0; _i < 2; ++_i) \
        __builtin_amdgcn_global_load_lds((const unsigned*)((const char*)(gbase) + (voff)[_i]), (LAS unsigned*)(lds + (bufoff) + ldsw + _i * 8192), 16, 0, 0); } while (0)
#define PG8_LD2(p) __builtin_shufflevector(*(const LAS v4i_t*)(p), *(const LAS v4i_t*)((p) + 1024), 0, 1, 2, 3, 4, 5, 6, 7)
#define PG8_LDA(dst, b, h) do { _Pragma("unroll") for (int m = 0; m < 4; ++m) dst[m] = PG8_LD2(lds + PG8_SA(b, h) + aoff + m * 2048); } while (0)
#define PG8_LDB(dst, b, h) do { _Pragma("unroll") for (int n = 0; n < 2; ++n) dst[n] = PG8_LD2(lds + PG8_SB(b, h) + boff + n * 2048); } while (0)
#define PG8_HALF(x, k) __builtin_bit_cast(bf16x8, __builtin_shufflevector(x, x, 4 * (k), 4 * (k) + 1, 4 * (k) + 2, 4 * (k) + 3))
#define PG8_MMA(ai, bj, At, Bt) do { __builtin_amdgcn_s_setprio(1); _Pragma("unroll") for (int m = 0; m < 4; ++m) _Pragma("unroll") for (int n = 0; n < 2; ++n) { \
        if constexpr (FP8) asm volatile("v_mfma_scale_f32_16x16x128_f8f6f4 %0, %1, %2, %0, %3, %3 op_sel_hi:[0,0,0]" : "+v"(acc[ai][bj][m][n]) : "v"(Bt[n]), "v"(At[m]), "v"(sc127));        \
        else { acc[ai][bj][m][n] = __builtin_amdgcn_mfma_f32_16x16x32_bf16(PG8_HALF(Bt[n], 0), PG8_HALF(At[m], 0), acc[ai][bj][m][n], 0, 0, 0); \
               acc[ai][bj][m][n] = __builtin_amdgcn_mfma_f32_16x16x32_bf16(PG8_HALF(Bt[n], 1), PG8_HALF(At[m], 1), acc[ai][bj][m][n], 0, 0, 0); } } __builtin_amdgcn_s_setprio(0); } while (0)
#define PG8_WAIT_V(n) asm volatile("s_waitcnt vmcnt(" #n ")" ::: "memory")
#define PG8_WAIT_L(n) asm volatile("s_waitcnt lgkmcnt(" #n ")" ::: "memory")
#define PG8_BAR __builtin_amdgcn_s_barrier()
#define PG8_SCHED __builtin_amdgcn_sched_barrier(0)
#define PG8_AOFFS(dst, u) do { _Pragma("unroll") for (int _h = 0; _h < 2; ++_h) _Pragma("unroll") for (int _i = 0; _i < 2; ++_i) { \
        if constexpr (GATHER) dst[_h][_i] = (unsigned)(S.arow(u, _h * HALF + sR[_i]) * lda + sC[_i]) * 2u; else dst[_h][_i] = (unsigned)((_h * HALF + sR[_i]) * lda + sC[_i]) * 2u; } } while (0)
    Unit cur, nxt; int ui = 0;
    if (!S.next(0, cur)) return;
    f32x4 acc[2][2][4][2];
#pragma unroll
    for (int a = 0; a < 2; ++a)
#pragma unroll
        for (int b = 0; b < 2; ++b)
#pragma unroll
            for (int m = 0; m < 4; ++m)
#pragma unroll
                for (int n = 0; n < 2; ++n) acc[a][b][m][n] = (f32x4){0.f, 0.f, 0.f, 0.f};
    v8i_t At[4], B0[2], B1[2]; const int sc127 = 0x7f7f7f7f; (void)sc127;
    const char* cA = S.abase(cur); const char* cB = S.bbase(cur);
    PG8_AOFFS(vA, cur);
    PG8_STAGE(PG8_SB(0, 0), cB, voffB); PG8_STAGE(PG8_SB(0, 1), cB + hstepB, voffB); PG8_STAGE(PG8_SA(0, 0), cA, vA[0]); PG8_STAGE(PG8_SA(0, 1), cA, vA[1]);
    if (wr == 1) PG8_BAR;
    PG8_WAIT_V(2); PG8_BAR;
    PG8_STAGE(PG8_SB(1, 0), cB + kstep, voffB); PG8_STAGE(PG8_SA(1, 0), cA + kstep, vA[0]); PG8_STAGE(PG8_SB(1, 1), cB + hstepB + kstep, voffB);
    PG8_WAIT_V(6); PG8_BAR;
    for (;;) {
        const bool has_next = S.next(ui + 1, nxt);
        const char* nA = cA; const char* nB = cB;
#pragma unroll
        for (int _h = 0; _h < 2; ++_h)
#pragma unroll
            for (int _i = 0; _i < 2; ++_i) vN[_h][_i] = vA[_h][_i];
        if (has_next) { nA = S.abase(nxt); nB = S.bbase(nxt); if constexpr (GATHER) { PG8_AOFFS(vN, nxt); } }
        for (int t = 0; t < nt; t += 2) {
            const bool last = (t == nt - 2);
            const char* a1 = cA + (size_t)(t + 1) * kstep;
            const char* a2 = last ? nA : cA + (size_t)(t + 2) * kstep; const char* b2 = last ? nB : cB + (size_t)(t + 2) * kstep;
            const char* a3 = a2 + kstep; const char* b3 = b2 + kstep;
            unsigned o2[2][2];
#pragma unroll
            for (int _h = 0; _h < 2; ++_h)
#pragma unroll
                for (int _i = 0; _i < 2; ++_i) o2[_h][_i] = (GATHER && last) ? vN[_h][_i] : vA[_h][_i];
            PG8_LDB(B0, 0, 0); PG8_LDB(B1, 0, 1); PG8_SCHED; PG8_LDA(At, 0, 0); PG8_STAGE(PG8_SA(1, 1), a1, vA[1]);
            PG8_WAIT_V(8); PG8_WAIT_L(0); PG8_BAR; PG8_MMA(0, 0, At, B0); PG8_MMA(0, 1, At, B1); PG8_BAR; PG8_SCHED;
            PG8_LDA(At, 0, 1); PG8_STAGE(PG8_SB(0, 0), b2, voffB); PG8_STAGE(PG8_SB(0, 1), b2 + hstepB, voffB); PG8_STAGE(PG8_SA(0, 0), a2, o2[0]);
            PG8_WAIT_V(8); PG8_WAIT_L(0); PG8_BAR; PG8_MMA(1, 0, At, B0); PG8_MMA(1, 1, At, B1); PG8_BAR; PG8_SCHED;
            PG8_LDB(B0, 1, 0); PG8_LDB(B1, 1, 1); PG8_SCHED; PG8_LDA(At, 1, 0); PG8_STAGE(PG8_SA(0, 1), a2, o2[1]);
            PG8_WAIT_V(8); PG8_WAIT_L(0); PG8_BAR; PG8_MMA(0, 0, At, B0); PG8_MMA(0, 1, At, B1); PG8_BAR; PG8_SCHED;
            PG8_LDA(At, 1, 1); PG8_STAGE(PG8_SB(1, 0), b3, voffB); PG8_STAGE(PG8_SB(1, 1), b3 + hstepB, voffB); PG8_STAGE(PG8_SA(1, 0), a3, o2[0]);
            PG8_WAIT_V(8); PG8_WAIT_L(0); PG8_BAR; PG8_MMA(1, 0, At, B0); PG8_MMA(1, 1, At, B1); PG8_BAR; PG8_SCHED;
        }
        if (wr == 0) PG8_BAR;
        E(acc, cur, wr, wc, fr, fq);
#if defined(EPI_DUP) && EPI_DUP
        if constexpr (Epi::IDEMP) { asm volatile("" : "+v"(acc[0][0][0][0]), "+v"(acc[0][1][0][0]), "+v"(acc[1][0][0][0]), "+v"(acc[1][1][0][0]) :: "memory"); E(acc, cur, wr, wc, fr, fq); }
#endif
        if (!has_next) break;
#pragma unroll
        for (int a = 0; a < 2; ++a)
#pragma unroll
            for (int b = 0; b < 2; ++b)
#pragma unroll
                for (int m = 0; m < 4; ++m)
#pragma unroll
                    for (int n = 0; n < 2; ++n) { f32x2 z0, z1; asm volatile("v_mov_b64 %0, 0\n\tv_mov_b64 %1, 0" : "=v"(z0), "=v"(z1)); acc[a][b][m][n] = __builtin_shufflevector(z0, z1, 0, 1, 2, 3); }
        cur = nxt; cA = nA; cB = nB; ++ui;
#pragma unroll
        for (int _h = 0; _h < 2; ++_h)
#pragma unroll
            for (int _i = 0; _i < 2; ++_i) vA[_h][_i] = vN[_h][_i];
        if (wr == 1) PG8_BAR;
    }
    PG8_WAIT_V(0);
    PG8_BAR;
#undef PG8_SA
#undef PG8_SB
#undef PG8_STAGE
#undef PG8_LDA
#undef PG8_LDB
#undef PG8_MMA
#undef PG8_LD2
#undef PG8_HALF
#undef PG8_WAIT_V
#undef PG8_WAIT_L
#undef PG8_BAR
#undef PG8_SCHED
#undef PG8_AOFFS
}
}

namespace attn_body {
using bf16 = __hip_bfloat16;
using s16x4 = __attribute__((ext_vector_type(4))) short;
using f32x16 = __attribute__((ext_vector_type(16))) float;
constexpr int D64 = 64, DM = 1024, OPITCH = 2048;
constexpr int NW = 8, QBLK = 32, QB = QBLK * NW, KVBLK = 64, NQB = SEQ / QB;
__device__ __forceinline__ int crow(int r, int hi) { return (r & 3) + 8 * (r >> 2) + 4 * hi; }
#define SBAR() __builtin_amdgcn_sched_barrier(0)
__device__ __forceinline__ void cmask(f32x16& p0, f32x16& p1, int jb, int qrel, int hi) {
  const float NEG = -INFINITY; int kb = 64 * jb + 4 * hi;
  #pragma unroll
  for (int r = 0; r < 16; ++r) { int kv = kb + (r & 3) + 8 * (r >> 2); if (kv > qrel) p0[r] = NEG; if (kv + 32 > qrel) p1[r] = NEG; }
}
constexpr int NSLOT = 3, SLOTB = 8192;
constexpr int LDS_K = 0, LDS_V = NSLOT * SLOTB, LDS_WS = 2 * NSLOT * SLOTB, LDS_OST = LDS_WS + NW * 64 * 4, LDS_BYTES = LDS_OST + NW * 4096;
__device__ __forceinline__ void glds16(const void* gsrc, unsigned lds_dst) { unsigned keep;
  asm volatile("s_mov_b32 %0, m0\n\ts_mov_b32 m0, %2\n\ts_nop 0\n\tglobal_load_lds_dwordx4 %1, off\n\ts_mov_b32 m0, %0" : "=&s"(keep) : "v"(gsrc), "s"(lds_dst) : "memory"); }
__device__ __forceinline__ float max3f(float a, float b, float c) { float r; asm("v_max3_f32 %0, %1, %2, %3" : "=v"(r) : "v"(a), "v"(b), "v"(c)); return r; }
__device__ __forceinline__ float max2f(float a, float b) { float r; asm("v_max_f32_e32 %0, %1, %2" : "=v"(r) : "v"(a), "v"(b)); return r; }
__device__ __forceinline__ float fadd_s(float a, float b) { float r; asm("v_add_f32_e32 %0, %1, %2" : "=v"(r) : "v"(a), "v"(b)); return r; }
__device__ __forceinline__ float fsub_s(float a, float b) { float r; asm("v_sub_f32_e32 %0, %1, %2" : "=v"(r) : "v"(a), "v"(b)); return r; }
typedef float f32x2_t __attribute__((ext_vector_type(2))); typedef __bf16 bf16x2_t __attribute__((ext_vector_type(2)));
__device__ __forceinline__ unsigned cvtpk_s(float lo, float hi) { f32x2_t v = {lo, hi}; bf16x2_t b = __builtin_convertvector(v, bf16x2_t); return __builtin_bit_cast(unsigned, b); }
#define WAIT_BAR(N) asm volatile("s_waitcnt vmcnt(" #N ") lgkmcnt(0)\n\ts_barrier" ::: "memory")

__device__ __forceinline__ void qkt(f32x16& p0, f32x16& p1, const char* Kslot, const bf16x8* qr, const f32x16& negm, int r32, int hi) {
  const char* kb = Kslot + hi * 1024 + r32 * 16;
  #pragma unroll
  for (int d0 = 0; d0 < 4; ++d0) {
    const bf16x8 b0 = *reinterpret_cast<const bf16x8*>(kb + d0 * 2048);
    const bf16x8 b1 = *reinterpret_cast<const bf16x8*>(kb + d0 * 2048 + 512);
    if (d0 == 0) { p0 = __builtin_amdgcn_mfma_f32_32x32x16_bf16(b0, qr[0], negm, 0, 0, 0); p1 = __builtin_amdgcn_mfma_f32_32x32x16_bf16(b1, qr[0], negm, 0, 0, 0); }
    else { p0 = __builtin_amdgcn_mfma_f32_32x32x16_bf16(b0, qr[d0], p0, 0, 0, 0); p1 = __builtin_amdgcn_mfma_f32_32x32x16_bf16(b1, qr[d0], p1, 0, 0, 0); } }
}
typedef __attribute__((address_space(3))) const char* lds_cptr;
typedef short v4i16_t __attribute__((ext_vector_type(4)));
__device__ __forceinline__ void kload8(bf16x8* kf, lds_cptr kp) {
  kf[0] = *(const __attribute__((address_space(3))) bf16x8*)(kp);        kf[1] = *(const __attribute__((address_space(3))) bf16x8*)(kp + 512);
  kf[2] = *(const __attribute__((address_space(3))) bf16x8*)(kp + 2048); kf[3] = *(const __attribute__((address_space(3))) bf16x8*)(kp + 2560);
  kf[4] = *(const __attribute__((address_space(3))) bf16x8*)(kp + 4096); kf[5] = *(const __attribute__((address_space(3))) bf16x8*)(kp + 4608);
  kf[6] = *(const __attribute__((address_space(3))) bf16x8*)(kp + 6144); kf[7] = *(const __attribute__((address_space(3))) bf16x8*)(kp + 6656);
}
__device__ __forceinline__ void kload2(bf16x8* kf, lds_cptr kp, int j) { kf[2 * j] = *(const __attribute__((address_space(3))) bf16x8*)(kp + j * 2048); kf[2 * j + 1] = *(const __attribute__((address_space(3))) bf16x8*)(kp + j * 2048 + 512); }
__device__ __forceinline__ s16x4 vtr(lds_cptr p) { return __builtin_bit_cast(s16x4, __builtin_amdgcn_ds_read_tr16_b64_v4i16((__attribute__((address_space(3))) v4i16_t*)p)); }
__device__ __forceinline__ float rowmax(const f32x16& p0, const f32x16& p1) {
  float a = max3f(p0[0], p0[1], p1[0]), b = max3f(p0[2], p0[3], p1[1]); a = max3f(a, p1[2], p1[3]);
  #pragma unroll
  for (int r = 4; r < 16; r += 4) { a = max3f(a, p0[r], p0[r + 1]); b = max3f(b, p0[r + 2], p0[r + 3]); a = max3f(a, p1[r], p1[r + 1]); b = max3f(b, p1[r + 2], p1[r + 3]); }
  const float m = max2f(a, b);
  auto rr = __builtin_amdgcn_permlane32_swap(__float_as_uint(m), __float_as_uint(m), false, false);
  return max2f(__uint_as_float(rr[0]), __uint_as_float(rr[1]));
}
__device__ __forceinline__ void pv(f32x16* o, int vb, bf16x8 pa0, bf16x8 pa1, bf16x8 pa2, bf16x8 pa3) {
  #pragma unroll
  for (int d0 = 0; d0 < 2; ++d0) { s16x4 lo[4], hi[4];
    #pragma unroll
    for (int ks = 0; ks < 4; ++ks) {
      asm volatile("ds_read_b64_tr_b16 %0,%1 offset:%c2" : "=&v"(lo[ks]) : "v"(vb), "i"(d0 * 4096 + ks * 1024) : "memory");
      asm volatile("ds_read_b64_tr_b16 %0,%1 offset:%c2" : "=&v"(hi[ks]) : "v"(vb), "i"(d0 * 4096 + ks * 1024 + 512) : "memory"); }
    asm volatile("s_waitcnt lgkmcnt(0)" ::: "memory"); SBAR();
    #define PK(k) (bf16x8){lo[k][0], lo[k][1], lo[k][2], lo[k][3], hi[k][0], hi[k][1], hi[k][2], hi[k][3]}
    o[d0] = __builtin_amdgcn_mfma_f32_32x32x16_bf16(pa0, PK(0), o[d0], 0, 0, 0);
    o[d0] = __builtin_amdgcn_mfma_f32_32x32x16_bf16(pa1, PK(1), o[d0], 0, 0, 0);
    o[d0] = __builtin_amdgcn_mfma_f32_32x32x16_bf16(pa2, PK(2), o[d0], 0, 0, 0);
    o[d0] = __builtin_amdgcn_mfma_f32_32x32x16_bf16(pa3, PK(3), o[d0], 0, 0, 0);
    #undef PK
  }
}
#define ATTN_STORE16(p, v) (*(u32x4*)(p) = (v))
template<int THRL> __device__ __forceinline__ void attn_unit(int b, int qcol, int vcol, int ocol, int qb, const bf16* Q, const bf16* __restrict__ K, const bf16* __restrict__ V, bf16* O, char* shm, const int wave_s) {
  int tid = tid_of(wave_s); asm volatile("" : "+v"(tid)); const int lane = tid & 63, r32 = lane & 31, hi = lane >> 5; const int wid = __builtin_amdgcn_readfirstlane(tid >> 6);
  const long rowbase = (long)b * SEQ; const int q0 = qb * QB;
  const bf16* Qw = Q + (rowbase + q0 + wid * QBLK) * DM + qcol;
  const bf16* Kh = K + rowbase * DM + qcol, *Vh = V + rowbase * DM + vcol;
  const unsigned lds0 = (unsigned)(uintptr_t)shm;
  float* wsf = (float*)(shm + LDS_WS) + wid * 64;
  const bf16* ksrc = Kh + (long)lane * DM + wid * 8;
  const bf16* vsrc = Vh + (long)(16 * (wid & 3) + (lane >> 2)) * DM + (wid >> 2) * 32 + (lane & 3) * 8;
  const unsigned kdst = lds0 + LDS_K + wid * 1024, vdst = lds0 + LDS_V + wid * 1024;
  #define DMA_K(t, slot) glds16(ksrc + (long)(t) * KVBLK * DM, (unsigned)__builtin_amdgcn_readfirstlane(kdst + (slot)))
  #define DMA_V(t, slot) glds16(vsrc + (long)(t) * KVBLK * DM, (unsigned)__builtin_amdgcn_readfirstlane(vdst + (slot)))
  const int vb0 = (int)(lds0 + LDS_V) + ((lane >> 4) & 1) * 32 + (lane & 3) * 8 + (4 * hi + ((lane & 15) >> 2)) * 64;
  const char* Kbase = shm + LDS_K; bf16x8 kf[8];
  const lds_cptr shm3 = (lds_cptr)shm; const lds_cptr kp0 = shm3 + LDS_K + hi * 1024 + r32 * 16; const lds_cptr vp0 = shm3 + LDS_V + ((lane >> 4) & 1) * 32 + (lane & 3) * 8 + (4 * hi + ((lane & 15) >> 2)) * 64;
  const int NT = (q0 + QB) / KVBLK;
  DMA_K(0, 0); DMA_V(0, 0); DMA_K(1, SLOTB);
  bf16x8 qr[4];
  #pragma unroll
  for (int d0 = 0; d0 < 4; ++d0) qr[d0] = *reinterpret_cast<const bf16x8*>(&Qw[(long)r32 * DM + d0 * 16 + hi * 8]);
  float mhat = 0.f, l_reg = 0.f; f32x16 o[2]; o[0] = f32x16{}; o[1] = f32x16{}; f32x16 negm = f32x16{}; asm volatile("" : "+v"(negm));
  const int qrel = wid * QBLK + r32;
  #define CMASK(P0, P1, t) do { int jb_ = (t) - (NT - 4); if (jb_ >= 0) cmask(P0, P1, jb_, qrel, hi); } while (0)
  bool resc = false;
  #define START(P0, P1) do { const float rm = rowmax(P0, P1); resc = false; \
    { const float dl = rm; mhat = fadd_s(mhat, dl); \
      _Pragma("unroll") for (int r = 0; r < 16; ++r) { P0[r] = fsub_s(P0[r], dl); P1[r] = fsub_s(P1[r], dl); } \
      _Pragma("unroll") for (int r = 0; r < 16; ++r) negm[r] = -mhat; asm volatile("" : "+v"(negm)); } \
    _Pragma("unroll") for (int r = 0; r < 16; ++r) P0[r] = __builtin_amdgcn_exp2f(P0[r]); } while (0)
  #define RESC() do { if (resc) { asm volatile("s_waitcnt lgkmcnt(0)" ::: "memory"); \
      _Pragma("unroll") for (int d_ = 0; d_ < 2; ++d_) _Pragma("unroll") for (int r = 0; r < 16; ++r) o[d_][r] *= wsf[crow(r, hi)]; } } while (0)
  f32x16 pA0, pA1, pB0, pB1;
  int sl_prev = 0, sl_cur = 0, sl_next = SLOTB;
  #define ROT() do { sl_prev = sl_cur; sl_cur = sl_next; sl_next = (sl_next == (NSLOT - 1) * SLOTB) ? 0 : sl_next + SLOTB; } while (0)
  DMA_K(2, 2 * SLOTB);
  WAIT_BAR(3);
  qkt(pA0, pA1, Kbase, qr, negm, r32, hi); asm volatile("s_nop 15\n\ts_nop 7" : "+v"(pA0), "+v"(pA1)); CMASK(pA0, pA1, 0);
  START(pA0, pA1);
  _Pragma("unroll") for (int r = 0; r < 16; ++r) pA1[r] = __builtin_amdgcn_exp2f(pA1[r]);
  WAIT_BAR(0);
  DMA_K(3, 0); DMA_V(1, SLOTB);
  ROT();
  kload8(kf, kp0 + sl_cur);
  WAIT_BAR(2);
  s16x4 vlo[8], vhi[8]; u32x4 pw0, pw1, pw2, pw3;
  #define PKW(P, B) cvtpk_s(P[B], P[B + 1])
  #define PAF(k) __builtin_bit_cast(bf16x8, pw##k)
  #define VFR(i) (bf16x8){vlo[i][0], vlo[i][1], vlo[i][2], vlo[i][3], vhi[i][0], vhi[i][1], vhi[i][2], vhi[i][3]}
  #define PIN(x) asm volatile("" : "+v"(x))
  #define MX3(a, b, c) __builtin_fmaxf(__builtin_fmaxf((a), (b)), (c))
  #define GAPA(MF, A0, A1, A2, A3, W0, W1, PW) do { MF; sacc += A0; sacc += A1; sacc += A2; sacc += A3; PIN(sacc); W0; W1; PIN(PW); SBAR(); } while (0)
  #define EX(v) __builtin_amdgcn_exp2f(v)
  #define GAPB(MF, X, B) do { MF; X[B] = EX(X[B]); X[B + 1] = EX(X[B + 1]); X[B + 2] = EX(X[B + 2]); X[B + 3] = EX(X[B + 3]); PIN(X); SBAR(); } while (0)
  #define VRD(i) do { vlo[i] = vtr(vp_ + (((i) >> 2) * 4096 + ((i) & 3) * 1024)); vhi[i] = vtr(vp_ + (((i) >> 2) * 4096 + ((i) & 3) * 1024 + 512)); } while (0)
  #define KRD(G, j) do { if (G) { kload2(kf, kp0 + sl_next, j); SBAR(); } } while (0)
  #define STEP(C0, C1, P0, P1, t, GK, GV, GL) do { SBAR(); \
    const lds_cptr vp_ = vp0 + sl_prev; \
    VRD(0); SBAR(); float sacc = (P0[0] + P0[1]); \
    GAPA(C0 = __builtin_amdgcn_mfma_f32_32x32x16_bf16(kf[0], qr[0], negm, 0, 0, 0), P0[2], P0[3], P0[4], P0[5],     pw0[0] = PKW(P0, 0), pw0[1] = PKW(P0, 2), pw0); \
    VRD(4); SBAR(); GAPA(C1 = __builtin_amdgcn_mfma_f32_32x32x16_bf16(kf[1], qr[0], negm, 0, 0, 0), P0[6], P0[7], P0[8], P0[9],     pw0[2] = PKW(P0, 4), pw0[3] = PKW(P0, 6), pw0); \
    VRD(1); SBAR(); GAPA(C0 = __builtin_amdgcn_mfma_f32_32x32x16_bf16(kf[2], qr[1], C0, 0, 0, 0),   P0[10], P0[11], P0[12], P0[13], pw1[0] = PKW(P0, 8), pw1[1] = PKW(P0, 10), pw1); \
    VRD(5); SBAR(); GAPA(C1 = __builtin_amdgcn_mfma_f32_32x32x16_bf16(kf[3], qr[1], C1, 0, 0, 0),   P0[14], P0[15], P1[0], P1[1],   pw1[2] = PKW(P0, 12), pw1[3] = PKW(P0, 14), pw1); \
    VRD(2); SBAR(); GAPA(C0 = __builtin_amdgcn_mfma_f32_32x32x16_bf16(kf[4], qr[2], C0, 0, 0, 0),   P1[2], P1[3], P1[4], P1[5],     pw2[0] = PKW(P1, 0), pw2[1] = PKW(P1, 2), pw2); \
    VRD(6); SBAR(); GAPA(C1 = __builtin_amdgcn_mfma_f32_32x32x16_bf16(kf[5], qr[2], C1, 0, 0, 0),   P1[6], P1[7], P1[8], P1[9],     pw2[2] = PKW(P1, 4), pw2[3] = PKW(P1, 6), pw2); \
    VRD(3); SBAR(); GAPA(C0 = __builtin_amdgcn_mfma_f32_32x32x16_bf16(kf[6], qr[3], C0, 0, 0, 0),   P1[10], P1[11], P1[12], P1[13], pw3[0] = PKW(P1, 8), pw3[1] = PKW(P1, 10), pw3); \
    VRD(7); SBAR(); GAPA(C1 = __builtin_amdgcn_mfma_f32_32x32x16_bf16(kf[7], qr[3], C1, 0, 0, 0),   P1[14], P1[15], 0.f, 0.f,       pw3[2] = PKW(P1, 12), pw3[3] = PKW(P1, 14), pw3); \
    l_reg += sacc; \
    if (GK) { DMA_K((t) + 3, sl_cur); } if (GV) { DMA_V((t) + 1, sl_next); } \
    CMASK(C0, C1, t); \
    { float a = MX3(C0[0], C0[1], C1[0]), b = MX3(C0[2], C0[3], C1[1]); a = MX3(a, C1[2], C1[3]); \
      _Pragma("unroll") for (int r = 4; r < 16; r += 4) { a = MX3(a, C0[r], C0[r + 1]); b = MX3(b, C0[r + 2], C0[r + 3]); a = MX3(a, C1[r], C1[r + 1]); b = MX3(b, C1[r + 2], C1[r + 3]); } \
      float rm = __builtin_fmaxf(a, b); { auto rr = __builtin_amdgcn_permlane32_swap(__float_as_uint(rm), __float_as_uint(rm), false, false); rm = __builtin_fmaxf(__uint_as_float(rr[0]), __uint_as_float(rr[1])); } \
      resc = false; \
      if (__builtin_expect(__any(rm > (float)THRL), 0)) { const float dl = __builtin_fmaxf(rm, 0.f); mhat += dl; \
        _Pragma("unroll") for (int r = 0; r < 16; ++r) { C0[r] -= dl; C1[r] -= dl; } \
        _Pragma("unroll") for (int r = 0; r < 16; ++r) negm[r] = -mhat; asm volatile("" : "+v"(negm)); \
        const float f = __builtin_amdgcn_exp2f(-dl); l_reg *= f; if (hi == 0) wsf[r32] = f; resc = true; } } \
    SBAR(); \
    GAPB(o[0] = __builtin_amdgcn_mfma_f32_32x32x16_bf16(PAF(0), VFR(0), o[0], 0, 0, 0), C0, 0); \
    GAPB(o[1] = __builtin_amdgcn_mfma_f32_32x32x16_bf16(PAF(0), VFR(4), o[1], 0, 0, 0), C0, 4); \
    KRD(GL, 0); GAPB(o[0] = __builtin_amdgcn_mfma_f32_32x32x16_bf16(PAF(1), VFR(1), o[0], 0, 0, 0), C0, 8); \
    KRD(GL, 1); GAPB(o[1] = __builtin_amdgcn_mfma_f32_32x32x16_bf16(PAF(1), VFR(5), o[1], 0, 0, 0), C0, 12); \
    KRD(GL, 2); GAPB(o[0] = __builtin_amdgcn_mfma_f32_32x32x16_bf16(PAF(2), VFR(2), o[0], 0, 0, 0), C1, 0); \
    KRD(GL, 3); GAPB(o[1] = __builtin_amdgcn_mfma_f32_32x32x16_bf16(PAF(2), VFR(6), o[1], 0, 0, 0), C1, 4); \
    GAPB(o[0] = __builtin_amdgcn_mfma_f32_32x32x16_bf16(PAF(3), VFR(3), o[0], 0, 0, 0), C1, 8); \
    GAPB(o[1] = __builtin_amdgcn_mfma_f32_32x32x16_bf16(PAF(3), VFR(7), o[1], 0, 0, 0), C1, 12); \
    } while (0)
  int t = 1;
  #undef CMASK
  #define CMASK(P0, P1, t) do {} while (0)
  for (; t + 5 < NT; t += 2) {
    STEP(pB0, pB1, pA0, pA1, t, true, true, true);     WAIT_BAR(2); RESC(); ROT();
    STEP(pA0, pA1, pB0, pB1, t + 1, true, true, true);   WAIT_BAR(2); RESC(); ROT();
  }
  #undef CMASK
  #define CMASK(P0, P1, t) do { int jb_ = (t) - (NT - 4); if (jb_ >= 0) cmask(P0, P1, jb_, qrel, hi); } while (0)
  #define ENDW(tt) do { if ((tt) + 3 < NT) { WAIT_BAR(2); } else if ((tt) + 2 < NT) { WAIT_BAR(1); } else { WAIT_BAR(0); } } while (0)
  for (; t + 1 < NT; t += 2) {
    STEP(pB0, pB1, pA0, pA1, t, (t + 3 < NT), (t + 1 < NT), (t + 1 < NT));       ENDW(t);   RESC(); ROT();
    STEP(pA0, pA1, pB0, pB1, t + 1, (t + 4 < NT), (t + 2 < NT), (t + 2 < NT));     ENDW(t + 1); RESC(); ROT();
  }
  STEP(pB0, pB1, pA0, pA1, NT - 1, false, false, false); RESC();
  { float sacc = pB0[0] + pB0[1]; _Pragma("unroll") for (int r = 2; r < 16; ++r) sacc += pB0[r]; _Pragma("unroll") for (int r = 0; r < 16; ++r) sacc += pB1[r]; l_reg += sacc;
    pw0 = (u32x4){PKW(pB0, 0), PKW(pB0, 2), PKW(pB0, 4), PKW(pB0, 6)}; pw1 = (u32x4){PKW(pB0, 8), PKW(pB0, 10), PKW(pB0, 12), PKW(pB0, 14)}; pw2 = (u32x4){PKW(pB1, 0), PKW(pB1, 2), PKW(pB1, 4), PKW(pB1, 6)}; pw3 = (u32x4){PKW(pB1, 8), PKW(pB1, 10), PKW(pB1, 12), PKW(pB1, 14)};
    SBAR(); pv(o, vb0 + sl_cur, PAF(0), PAF(1), PAF(2), PAF(3)); }
  #undef PKW
  #undef PAF
  #undef VFR
  #undef PIN
  #undef MX3
  #undef GAPA
  #undef GAPB
  #undef EX
  #undef VRD
  #undef KRD
  #undef STEP
  #undef ENDW
  { auto rr = __builtin_amdgcn_permlane32_swap(__float_as_uint(l_reg), __float_as_uint(l_reg), false, false); l_reg = __uint_as_float(rr[0]) + __uint_as_float(rr[1]); }
  if (hi == 0) wsf[32 + r32] = l_reg; asm volatile("s_waitcnt lgkmcnt(0)" ::: "memory");
  float rli[16];
  #pragma unroll
  for (int r = 0; r < 16; ++r) rli[r] = __builtin_amdgcn_rcpf(wsf[32 + crow(r, hi)]);
  bf16* Ow = O + (rowbase + q0 + wid * QBLK) * OPITCH + ocol;
  { bf16* stg = (bf16*)(shm + LDS_OST) + wid * 2048;
    #pragma unroll
    for (int r = 0; r < 16; ++r) { const int orow = crow(r, hi);
      #pragma unroll
      for (int d0 = 0; d0 < 2; ++d0) stg[orow * 64 + d0 * 32 + r32] = __float2bfloat16(o[d0][r] * rli[r]); }
    asm volatile("s_waitcnt lgkmcnt(0)" ::: "memory");
    #pragma unroll
    for (int i = 0; i < 4; ++i) { const int row = i * 8 + (lane >> 3), ch = lane & 7; const u32x4 v = *(const u32x4*)(stg + row * 64 + ch * 8); ATTN_STORE16(Ow + (long)row * OPITCH + ch * 8, v); } }
  asm volatile("s_waitcnt lgkmcnt(0)\n\ts_barrier" ::: "memory");
  #undef DMA_K
  #undef DMA_V
  #undef CMASK
  #undef START
  #undef RESC
  #undef ROT
}
constexpr int PS_QB = 128, PS_LK = 0, PS_LV = 3 * 8192, PS_VSLOT = 16384, PS_LP = PS_LV + 4 * PS_VSLOT, PS_PSLOT = 16384, PS_LF = PS_LP + 2 * PS_PSLOT, PS_BYTES = PS_LF + 4 * 512;
#define WAIT_BAR(N) asm volatile("s_waitcnt vmcnt(" #N ") lgkmcnt(0)\n\ts_barrier" ::: "memory")
#define SBAR() __builtin_amdgcn_sched_barrier(0)
template<int THRL, int MODE> __device__ __forceinline__ void attn_unit_ps(int b, int qcol, int vcol, int ocol, int qb, const bf16* Q, const bf16* __restrict__ K, const bf16* __restrict__ V, bf16* O, char* shm, const int wave_s, f32x16 (&keep)[4], const float lam, const int o8 = 0) {
  int tid = tid_of(wave_s); asm volatile("" : "+v"(tid)); const int lane = tid & 63, r32 = lane & 31, hi = lane >> 5; const int wid = __builtin_amdgcn_readfirstlane(tid >> 6);
  const int role = wid >> 2, w = wid & 3;
  const long rowbase = (long)b * SEQ; const int q0 = qb * PS_QB;
  const bf16* Kh = K + rowbase * DM + qcol, *Vh = V + rowbase * DM + vcol;
  const unsigned lds0 = (unsigned)(uintptr_t)shm;
  const lds_cptr shm3 = (lds_cptr)shm;
  const bf16* ksrc = Kh + (long)lane * DM + wid * 8;
  const bf16* vsrc0 = Vh + (long)(16 * (wid & 3) + (lane >> 2)) * DM + (wid >> 2) * 32 + (lane & 3) * 8;
  const unsigned kdst = lds0 + PS_LK + wid * 1024, vdst = lds0 + PS_LV + wid * 1024;
  #define DMA_K(t, slot) glds16(ksrc + (long)(t) * KVBLK * DM, (unsigned)__builtin_amdgcn_readfirstlane(kdst + (slot)))
  #define DMA_V(t, slot) do { glds16(vsrc0 + (long)(t) * KVBLK * DM, (unsigned)__builtin_amdgcn_readfirstlane(vdst + (slot))); glds16(vsrc0 + (long)(t) * KVBLK * DM + 64, (unsigned)__builtin_amdgcn_readfirstlane(vdst + (slot) + 8192)); } while (0)
  const int NT = (q0 + PS_QB) / KVBLK;
  int ks_prev = 0, ks_cur = 0, ks_next = 8192;
  #define KROT() do { ks_prev = ks_cur; ks_cur = ks_next; ks_next = (ks_next == 2 * 8192) ? 0 : ks_next + 8192; } while (0)
  #define VSL(t) ((((t)) & 3) * PS_VSLOT)
  LAS float* fw = (LAS float*)((LAS char*)shm3 + PS_LF + w * 512);
  LAS unsigned* flagw = (LAS unsigned*)((LAS char*)shm3 + PS_LF + w * 512 + 256);
  const lds_cptr vfrag0 = shm3 + PS_LV + ((lane >> 4) & 1) * 32 + (lane & 3) * 8 + (4 * hi + ((lane & 15) >> 2)) * 64;
  LAS char* pbase = (LAS char*)shm3 + PS_LP + w * 4096 + lane * 16;
  DMA_K(0, 0); DMA_V(0, VSL(0)); DMA_K(1, 8192);
  if (role == 0) {
    const bf16* Qw = Q + (rowbase + q0 + w * QBLK) * DM + qcol;
    const lds_cptr kp0 = shm3 + PS_LK + hi * 1024 + r32 * 16;
    const char* Kbase = shm + PS_LK; bf16x8 kf[8];
    bf16x8 qr[4];
    #pragma unroll
    for (int d0 = 0; d0 < 4; ++d0) qr[d0] = *reinterpret_cast<const bf16x8*>(&Qw[(long)r32 * DM + d0 * 16 + hi * 8]);
    float mhat = 0.f, l_reg = 0.f; f32x16 negm = f32x16{}; asm volatile("" : "+v"(negm));
    const int qrel = w * QBLK + r32;
    #define CMASK(P0, P1, t) do { int jb_ = (t) - (NT - 2); if (jb_ >= 0) cmask(P0, P1, jb_, qrel, hi); } while (0)
    bool resc = false;
    #define START(P0, P1) do { const float rm = rowmax(P0, P1); resc = false; \
      { const float dl = rm; mhat = fadd_s(mhat, dl); \
        _Pragma("unroll") for (int r = 0; r < 16; ++r) { P0[r] = fsub_s(P0[r], dl); P1[r] = fsub_s(P1[r], dl); } \
        _Pragma("unroll") for (int r = 0; r < 16; ++r) negm[r] = -mhat; asm volatile("" : "+v"(negm)); } \
      _Pragma("unroll") for (int r = 0; r < 16; ++r) P0[r] = __builtin_amdgcn_exp2f(P0[r]); } while (0)
    #define RESC(par) do {} while (0)
    f32x16 pA0, pA1, pB0, pB1;
    DMA_K(2, 2 * 8192);
    WAIT_BAR(4);
    qkt(pA0, pA1, Kbase, qr, negm, r32, hi); asm volatile("s_nop 15\n\ts_nop 7" : "+v"(pA0), "+v"(pA1)); CMASK(pA0, pA1, 0);
    START(pA0, pA1);
    _Pragma("unroll") for (int r = 0; r < 16; ++r) pA1[r] = __builtin_amdgcn_exp2f(pA1[r]);
    WAIT_BAR(0);
    DMA_K(3, 0); DMA_V(1, VSL(1));
    KROT();
    kload8(kf, kp0 + ks_cur);
    WAIT_BAR(3);
    u32x4 pw0, pw1, pw2, pw3;
    #define PKW(P, B) cvtpk_s(P[B], P[B + 1])
    #define PAF(k) __builtin_bit_cast(bf16x8, pw##k)
    #define VFR(i) (bf16x8){vlo[i][0], vlo[i][1], vlo[i][2], vlo[i][3], vhi[i][0], vhi[i][1], vhi[i][2], vhi[i][3]}
    #define PIN(x) asm volatile("" : "+v"(x))
    #define MX3(a, b, c) __builtin_fmaxf(__builtin_fmaxf((a), (b)), (c))
    #define GAPA(MF, A0, A1, A2, A3, W0, W1, PW) do { MF; sacc += A0; sacc += A1; sacc += A2; sacc += A3; PIN(sacc); W0; W1; PIN(PW); SBAR(); } while (0)
    #define EX(v) __builtin_amdgcn_exp2f(v)
    #define GAPB(X, B) do { X[B] = EX(X[B]); X[B + 1] = EX(X[B + 1]); X[B + 2] = EX(X[B + 2]); X[B + 3] = EX(X[B + 3]); PIN(X); SBAR(); } while (0)
    #define VRD(i) do {} while (0)
    #define KRD(j) do { kload2(kf, kp0 + ks_next, j); SBAR(); } while (0)
    #define PUB(k) (*(LAS u32x4*)(pp_ + (k) * 1024) = pw##k)
    #define STEP(C0, C1, P0, P1, t) do { SBAR(); \
      LAS char* pp_ = pbase + ((t) & 1) * PS_PSLOT; \
      VRD(0); SBAR(); float sacc = (P0[0] + P0[1]); \
      GAPA(C0 = __builtin_amdgcn_mfma_f32_32x32x16_bf16(kf[0], qr[0], negm, 0, 0, 0), P0[2], P0[3], P0[4], P0[5],     pw0[0] = PKW(P0, 0), pw0[1] = PKW(P0, 2), pw0); \
      VRD(4); SBAR(); GAPA(C1 = __builtin_amdgcn_mfma_f32_32x32x16_bf16(kf[1], qr[0], negm, 0, 0, 0), P0[6], P0[7], P0[8], P0[9],     pw0[2] = PKW(P0, 4), pw0[3] = PKW(P0, 6), pw0); \
      PUB(0); VRD(1); SBAR(); GAPA(C0 = __builtin_amdgcn_mfma_f32_32x32x16_bf16(kf[2], qr[1], C0, 0, 0, 0),   P0[10], P0[11], P0[12], P0[13], pw1[0] = PKW(P0, 8), pw1[1] = PKW(P0, 10), pw1); \
      VRD(5); SBAR(); GAPA(C1 = __builtin_amdgcn_mfma_f32_32x32x16_bf16(kf[3], qr[1], C1, 0, 0, 0),   P0[14], P0[15], P1[0], P1[1],   pw1[2] = PKW(P0, 12), pw1[3] = PKW(P0, 14), pw1); \
      PUB(1); VRD(2); SBAR(); GAPA(C0 = __builtin_amdgcn_mfma_f32_32x32x16_bf16(kf[4], qr[2], C0, 0, 0, 0),   P1[2], P1[3], P1[4], P1[5],     pw2[0] = PKW(P1, 0), pw2[1] = PKW(P1, 2), pw2); \
      VRD(6); SBAR(); GAPA(C1 = __builtin_amdgcn_mfma_f32_32x32x16_bf16(kf[5], qr[2], C1, 0, 0, 0),   P1[6], P1[7], P1[8], P1[9],     pw2[2] = PKW(P1, 4), pw2[3] = PKW(P1, 6), pw2); \
      PUB(2); VRD(3); SBAR(); GAPA(C0 = __builtin_amdgcn_mfma_f32_32x32x16_bf16(kf[6], qr[3], C0, 0, 0, 0),   P1[10], P1[11], P1[12], P1[13], pw3[0] = PKW(P1, 8), pw3[1] = PKW(P1, 10), pw3); \
      VRD(7); SBAR(); GAPA(C1 = __builtin_amdgcn_mfma_f32_32x32x16_bf16(kf[7], qr[3], C1, 0, 0, 0),   P1[14], P1[15], 0.f, 0.f,       pw3[2] = PKW(P1, 12), pw3[3] = PKW(P1, 14), pw3); \
      PUB(3); l_reg += sacc; \
      DMA_K((t) + 3, ks_cur); DMA_V((t) + 1, VSL((t) + 1)); \
      CMASK(C0, C1, t); \
      { float a = MX3(C0[0], C0[1], C1[0]), b_ = MX3(C0[2], C0[3], C1[1]); a = MX3(a, C1[2], C1[3]); \
        _Pragma("unroll") for (int r = 4; r < 16; r += 4) { a = MX3(a, C0[r], C0[r + 1]); b_ = MX3(b_, C0[r + 2], C0[r + 3]); a = MX3(a, C1[r], C1[r + 1]); b_ = MX3(b_, C1[r + 2], C1[r + 3]); } \
        float rm = __builtin_fmaxf(a, b_); { auto rr = __builtin_amdgcn_permlane32_swap(__float_as_uint(rm), __float_as_uint(rm), false, false); rm = __builtin_fmaxf(__uint_as_float(rr[0]), __uint_as_float(rr[1])); } \
        resc = false; \
        if (__builtin_expect(__any(rm > (float)THRL), 0)) { const float dl = __builtin_fmaxf(rm, 0.f); mhat += dl; \
          _Pragma("unroll") for (int r = 0; r < 16; ++r) { C0[r] -= dl; C1[r] -= dl; } \
          _Pragma("unroll") for (int r = 0; r < 16; ++r) negm[r] = -mhat; asm volatile("" : "+v"(negm)); \
          const float f = __builtin_amdgcn_exp2f(-dl); l_reg *= f; if (hi == 0) fw[((t) & 1) * 32 + r32] = f; resc = true; } \
        if (lane == 0) flagw[(t) & 1] = resc ? 1u : 0u; } \
      SBAR(); \
      GAPB(C0, 0); GAPB(C0, 4); KRD(0); GAPB(C0, 8); KRD(1); GAPB(C0, 12); KRD(2); GAPB(C1, 0); KRD(3); GAPB(C1, 4); GAPB(C1, 8); GAPB(C1, 12); \
      } while (0)
    int t = 1;
    #undef CMASK
    #define CMASK(P0, P1, t) do {} while (0)
    for (; t + 3 < NT; t += 2) {
      STEP(pB0, pB1, pA0, pA1, t);       WAIT_BAR(3); RESC(t & 1); KROT();
      STEP(pA0, pA1, pB0, pB1, t + 1);   WAIT_BAR(3); RESC((t + 1) & 1); KROT();
    }
    #undef CMASK
    #define CMASK(P0, P1, t) do { int jb_ = (t) - (NT - 2); if (jb_ >= 0) cmask(P0, P1, jb_, qrel, hi); } while (0)
    if (t + 1 < NT) {
      STEP(pB0, pB1, pA0, pA1, t);       WAIT_BAR(3); RESC(t & 1); KROT();
      STEP(pA0, pA1, pB0, pB1, t + 1);   WAIT_BAR(3); RESC((t + 1) & 1); KROT();
      t += 2;
    }
    STEP(pB0, pB1, pA0, pA1, NT - 1);    WAIT_BAR(3); RESC((NT - 1) & 1);
    { float sacc = pB0[0] + pB0[1]; _Pragma("unroll") for (int r = 2; r < 16; ++r) sacc += pB0[r]; _Pragma("unroll") for (int r = 0; r < 16; ++r) sacc += pB1[r]; l_reg += sacc;
      pw0 = (u32x4){PKW(pB0, 0), PKW(pB0, 2), PKW(pB0, 4), PKW(pB0, 6)}; pw1 = (u32x4){PKW(pB0, 8), PKW(pB0, 10), PKW(pB0, 12), PKW(pB0, 14)}; pw2 = (u32x4){PKW(pB1, 0), PKW(pB1, 2), PKW(pB1, 4), PKW(pB1, 6)}; pw3 = (u32x4){PKW(pB1, 8), PKW(pB1, 10), PKW(pB1, 12), PKW(pB1, 14)};
      LAS char* pp_ = pbase + (NT & 1) * PS_PSLOT; PUB(0); PUB(1); PUB(2); PUB(3);
      { auto rr = __builtin_amdgcn_permlane32_swap(__float_as_uint(l_reg), __float_as_uint(l_reg), false, false); l_reg = __uint_as_float(rr[0]) + __uint_as_float(rr[1]); }
      if (hi == 0) fw[80 + r32] = l_reg;
      }
    asm volatile("s_waitcnt vmcnt(0) lgkmcnt(0)\n\ts_barrier" ::: "memory");
    #undef PKW
    #undef PAF
    #undef VFR
    #undef MX3
    #undef GAPA
    #undef GAPB
    #undef EX
    #undef VRD
    #undef KRD
    #undef PUB
    #undef STEP
    #undef CMASK
    #undef START
    #undef RESC
    asm volatile("s_barrier" ::: "memory");
  } else {
    f32x16 o[4]; o[0] = f32x16{}; o[1] = f32x16{}; o[2] = f32x16{}; o[3] = f32x16{};
    DMA_K(2, 2 * 8192);
    WAIT_BAR(4);
    WAIT_BAR(0);
    DMA_K(3, 0); DMA_V(1, VSL(1));
    KROT();
    WAIT_BAR(3);
    #define VPV(tt) do { const LAS char* pp_ = pbase + (((tt) + 1) & 1) * PS_PSLOT; \
        const bf16x8 pa0 = __builtin_bit_cast(bf16x8, *(const LAS u32x4*)(pp_)), pa1 = __builtin_bit_cast(bf16x8, *(const LAS u32x4*)(pp_ + 1024)), pa2 = __builtin_bit_cast(bf16x8, *(const LAS u32x4*)(pp_ + 2048)), pa3 = __builtin_bit_cast(bf16x8, *(const LAS u32x4*)(pp_ + 3072)); \
        _Pragma("unroll") for (int hf = 0; hf < 2; ++hf) { const lds_cptr vp_ = vfrag0 + hf * 8192 + VSL(tt); s16x4 vl[8], vh[8]; \
          _Pragma("unroll") for (int i = 0; i < 8; ++i) { vl[i] = vtr(vp_ + ((i >> 2) * 4096 + (i & 3) * 1024)); vh[i] = vtr(vp_ + ((i >> 2) * 4096 + (i & 3) * 1024 + 512)); } \
          _Pragma("unroll") for (int i = 0; i < 4; ++i) { const bf16x8 pa = i == 0 ? pa0 : i == 1 ? pa1 : i == 2 ? pa2 : pa3; \
            o[2 * hf] = __builtin_amdgcn_mfma_f32_32x32x16_bf16(pa, (bf16x8){vl[i][0], vl[i][1], vl[i][2], vl[i][3], vh[i][0], vh[i][1], vh[i][2], vh[i][3]}, o[2 * hf], 0, 0, 0); \
            o[2 * hf + 1] = __builtin_amdgcn_mfma_f32_32x32x16_bf16(pa, (bf16x8){vl[i + 4][0], vl[i + 4][1], vl[i + 4][2], vl[i + 4][3], vh[i + 4][0], vh[i + 4][1], vh[i + 4][2], vh[i + 4][3]}, o[2 * hf + 1], 0, 0, 0); } } } while (0)
    #define VRESC(s) do { if (__builtin_amdgcn_readfirstlane(flagw[(s) & 1]) != 0u) { \
        _Pragma("unroll") for (int d_ = 0; d_ < 4; ++d_) _Pragma("unroll") for (int r = 0; r < 16; ++r) o[d_][r] *= fw[((s) & 1) * 32 + crow(r, hi)]; } } while (0)
    for (int t = 1; t < NT; ++t) {
      DMA_K(t + 3, ks_cur); DMA_V(t + 1, VSL(t + 1));
      if (t >= 2) { VPV(t - 2); VRESC(t - 1); }
      WAIT_BAR(3); KROT();
    }
    VPV(NT - 2); VRESC(NT - 1);
    asm volatile("s_waitcnt vmcnt(0) lgkmcnt(0)\n\ts_barrier" ::: "memory");
    VPV(NT - 1);
    asm volatile("s_waitcnt lgkmcnt(0)\n\ts_barrier" ::: "memory");
    #undef VPV
    #undef VRESC
    float rli[16];
    #pragma unroll
    for (int r = 0; r < 16; ++r) rli[r] = __builtin_amdgcn_rcpf(fw[80 + crow(r, hi)]);
    if constexpr (MODE == 0) {
      #pragma unroll
      for (int d0 = 0; d0 < 4; ++d0)
        #pragma unroll
        for (int r = 0; r < 16; ++r) keep[d0][r] = o[d0][r] * rli[r];
    } else {
      bf16* Ow = O + (rowbase + q0 + w * QBLK) * DM + ocol;
      bf16* stg = (bf16*)(shm + PS_LP) + w * 4096;
      #pragma unroll
      for (int r = 0; r < 16; ++r) { const int orow = crow(r, hi); float dv[4]; float ss = 0.f;
        #pragma unroll
        for (int d0 = 0; d0 < 4; ++d0) { dv[d0] = keep[d0][r] - lam * (o[d0][r] * rli[r]); ss += dv[d0] * dv[d0]; }
        ss += swz_xor<1>(ss); ss += swz_xor<2>(ss); ss += swz_xor<4>(ss); ss += swz_xor<8>(ss); ss += swz_xor<16>(ss);
        const float rstd = __builtin_amdgcn_rsqf(ss * (1.f / 128.f) + SUBLN_EPS);
        #pragma unroll
        for (int d0 = 0; d0 < 4; ++d0) stg[orow * 128 + d0 * 32 + r32] = __float2bfloat16(dv[d0] * rstd); }
      asm volatile("s_waitcnt lgkmcnt(0)" ::: "memory");
      if (o8) { unsigned char* O8w = (unsigned char*)O + (rowbase + q0 + w * QBLK) * DM + ocol;
      #pragma unroll
      for (int i = 0; i < 8; ++i) { const int row = i * 4 + (lane >> 4), ch = lane & 15; const u32x4 v = *(const u32x4*)(stg + row * 128 + ch * 8);
        u32x2 q; q.x = pk_fp8x4(bf_lo(v.x), bf_hi(v.x), bf_lo(v.y), bf_hi(v.y)); q.y = pk_fp8x4(bf_lo(v.z), bf_hi(v.z), bf_lo(v.w), bf_hi(v.w)); *(u32x2*)(O8w + (long)row * DM + ch * 8) = q; } }
      else {
      #pragma unroll
      for (int i = 0; i < 8; ++i) { const int row = i * 4 + (lane >> 4), ch = lane & 15; const u32x4 v = *(const u32x4*)(stg + row * 128 + ch * 8); *(u32x4*)(Ow + (long)row * DM + ch * 8) = v; } }
    }
  }
  asm volatile("s_waitcnt lgkmcnt(0)\n\ts_barrier" ::: "memory");
  #undef DMA_K
  #undef DMA_V
  #undef KROT
  #undef VSL
  #undef PIN
}
#undef SBAR
#undef WAIT_BAR
constexpr int ATTN_LDS_BYTES = LDS_BYTES;
static_assert(PS_BYTES <= 131072, "P-sharing attention LDS");

#undef SBAR
#undef WAIT_BAR
}

constexpr size_t MiB = 1u << 20;
constexpr size_t WS_CTL = 0, CTL_ZERO_BYTES = 1 * MiB;
constexpr size_t WS_ROPE = 1 * MiB;
constexpr size_t WS_MISC = 2 * MiB;
constexpr size_t WS_WA = 8 * MiB;
constexpr size_t WS_WB = 36 * MiB;
constexpr size_t WS_XN = 214 * MiB;
constexpr size_t WS_P16 = 342 * MiB;
constexpr size_t WS_PROJ = 374 * MiB;
constexpr size_t WS_R = 502 * MiB;
constexpr size_t WS_HB0 = 1142 * MiB;
constexpr size_t WS_SSP0 = 1270 * MiB, WS_SSP1 = 1274 * MiB;
constexpr size_t WS_SCAN = 1278 * MiB;
constexpr size_t WS_P16B = 1296 * MiB;
constexpr size_t WS_END = 1328 * MiB;
constexpr size_t MS_SPL = 0;
constexpr size_t MS_BC = 64 * 1024;
constexpr size_t MS_TOPE = 128 * 1024;
constexpr size_t MS_TOPG = MS_TOPE + 512 * 1024;
constexpr size_t MS_RANK = MS_TOPG + 512 * 1024;
constexpr int SLOTS_PER_PASS = NTOK + NE * 256;
constexpr size_t MS_STOK = MS_RANK + 512 * 1024;
constexpr size_t MS_SGATE = MS_STOK + 2 * (size_t)SLOTS_PER_PASS * 4;
constexpr size_t MS_SRS = MS_SGATE + 2 * (size_t)SLOTS_PER_PASS * 4;
static_assert(MS_SRS + 2 * (size_t)SLOTS_PER_PASS * 4 <= 6 * MiB, "misc map");
constexpr size_t WA_QKV = 0, WA_O = 6 * MiB, WA_GU = 8 * MiB, WA_D = 19 * MiB, WA_PG = 25 * MiB, WA_PP = 27 * MiB;
constexpr size_t WB_IN = 0, WB_GT = 4 * MiB, WB_OUT = 5 * MiB, WB_PG = 7 * MiB, WB_PP = 9 * MiB, WB_MGU = 10 * MiB, WB_MD = 122 * MiB;
constexpr size_t R_Q = 0, R_K = 128 * MiB, R_V = 256 * MiB, R_O2 = 384 * MiB, R_OA = 384 * MiB, R_HID = 128 * MiB;
constexpr size_t R_XL = 0, R_Y = 128 * MiB, R_U = 256 * MiB, R_LA = 384 * MiB, R_BT = 512 * MiB, R_HY = 0, R_MHID = 0, R_MHID1 = 400 * MiB, R_H8 = 512 * MiB, R_H8B = 256 * MiB, R_XS8 = 256 * MiB;
constexpr int CW_TMO = 0, CW_BAR = 4096;

constexpr int RING_OFF = 0, RING_BYTES = 131072;
constexpr int LDSCTL_OFF = RING_BYTES, MISC_OFF = LDSCTL_OFF + 320;
constexpr int LDS_BYTES = 147456;
constexpr int MW_CNT = 16, MW_TST = 32;

#define XB_TMO      128
#define XB_XCNT(j)  (256  + 64 * (j))
#define XB_XSUB(j)  (1280 + 64 * (j))
#define XB_XGEN(j)  (2304 + 64 * (j))
#define XB_TOP      3328
#define XB_TOPGEN   3392
#define XCD_BAR_WORDS 3456
#define XB_SPIN_CAP (1u << 18)
__device__ __forceinline__ unsigned xb_ld(unsigned* p)              { return __hip_atomic_load(p, __ATOMIC_RELAXED, __HIP_MEMORY_SCOPE_AGENT); }
__device__ __forceinline__ unsigned xb_add(unsigned* p, unsigned v) { return __hip_atomic_fetch_add(p, v, __ATOMIC_RELAXED, __HIP_MEMORY_SCOPE_AGENT); }
__device__ __forceinline__ unsigned xb_xcc_id() { return (unsigned)__builtin_amdgcn_s_getreg((3 << 11) | 20) & 0xFu; }
#define XB_SPIN(cond, bar) do { unsigned _sp = 0; while (cond) { __builtin_amdgcn_s_sleep(1); \
    if ((++_sp & 255u) == 0u) { if (xb_ld(&(bar)[XB_TMO])) break; if (_sp > XB_SPIN_CAP) { atomicAdd(&(bar)[XB_TMO], 1u); break; } } } } while (0)
struct XcdBarrier { unsigned* bar; unsigned x; volatile LAS unsigned* st; };
__device__ __forceinline__ XcdBarrier xcd_barrier_post(unsigned* bar, volatile LAS unsigned* st, const int wave_s) {
    XcdBarrier b; b.bar = bar; b.x = xb_xcc_id(); b.st = st;
    if (tid_of(wave_s) == 0) (void)xb_add(&bar[XB_XCNT(b.x)], 1u);
    return b;
}
__device__ __forceinline__ void xcd_barrier_complete(unsigned* bar, unsigned x, unsigned& nloc, unsigned& nx) {
    const unsigned G = gridDim.x * gridDim.y * gridDim.z;
    unsigned sum, cnt, mine, sp = 0u;
    for (;;) {
        sum = 0u; cnt = 0u; mine = 0u;
#pragma unroll
        for (unsigned j = 0; j < 16; ++j) { const unsigned c = xb_ld(&bar[XB_XCNT(j)]); sum += c; cnt += (c > 0u) ? 1u : 0u; mine = (j == x) ? c : mine; }
        if (sum == G) break;
        __builtin_amdgcn_s_sleep(1);
        if ((++sp & 255u) == 0u) { if (xb_ld(&bar[XB_TMO])) break; if (sp > XB_SPIN_CAP) { atomicAdd(&bar[XB_TMO], 1u); break; } }
    }
    nloc = mine > 0u ? mine : 1u; nx = cnt > 0u ? cnt : 1u;
}
__device__ __forceinline__ void xcd_barrier(const XcdBarrier& b, const int wave_s) {
    asm volatile("s_waitcnt vmcnt(0)" ::: "memory");
    __syncthreads();
    if (tid_of(wave_s) == 0) {
        unsigned* bar = b.bar;
        __builtin_amdgcn_s_waitcnt(0);
        unsigned nloc = b.st[0], nx = b.st[1];
        if (nloc == 0u) { xcd_barrier_complete(bar, b.x, nloc, nx); b.st[0] = nloc; b.st[1] = nx; }
        const unsigned old = xb_add(&bar[XB_XSUB(b.x)], 1u);
        const unsigned gen = old / nloc;
        if (old + 1u == (gen + 1u) * nloc) {
            __builtin_amdgcn_fence(__ATOMIC_RELEASE, "agent");
            asm volatile("s_waitcnt vmcnt(0)" ::: "memory");
            const unsigned og = xb_add(&bar[XB_TOP], 1u);
            const unsigned tg = og / nx;
            if (og + 1u == (tg + 1u) * nx) xb_add(&bar[XB_TOPGEN], 1u);
            else XB_SPIN(xb_ld(&bar[XB_TOPGEN]) == tg, bar);
            __builtin_amdgcn_fence(__ATOMIC_ACQUIRE, "agent");
            xb_add(&bar[XB_XGEN(b.x)], 1u);
            asm volatile("s_waitcnt vmcnt(0)" ::: "memory");
        } else {
            XB_SPIN(xb_ld(&bar[XB_XGEN(b.x)]) == gen, bar);
            __builtin_amdgcn_fence(__ATOMIC_ACQUIRE, "agent");
            asm volatile("s_waitcnt vmcnt(0)" ::: "memory");
        }
    }
    __syncthreads();
}

#define LDS_WAIT() asm volatile("s_waitcnt lgkmcnt(0)" ::: "memory")
__device__ __forceinline__ float wave_sum(float v) {
    v += swz_xor<1>(v); v += swz_xor<2>(v); v += swz_xor<4>(v); v += swz_xor<8>(v); v += swz_xor<16>(v);
    return add_x32(v);
}
__device__ __forceinline__ void tr_item(const float* W, int ldsrc, int k0, int nsrc0, bf16_t* WT, int ldd, int vrow0, int dk0, const float* gain, float gscale, LAS float* scr, int lane) {
#pragma unroll 16
    for (int i = 0; i < 32; ++i) { const int kk = 2 * i + (lane >> 5); float v = W[(size_t)(k0 + kk) * ldsrc + nsrc0 + (lane & 31)]; if (gain) v *= gain[k0 + kk] * gscale; scr[kk * 33 + (lane & 31)] = v; }
    LDS_WAIT(); asm volatile("" ::: "memory");
    const int c = lane & 7;
#pragma unroll
    for (int j = 0; j < 4; ++j) { const int n = (lane >> 3) + 8 * j; const LAS float* s = scr + (8 * c) * 33 + n;
        u32x4 o; o.x = cvt_pk_bf16(s[0 * 33], s[1 * 33]); o.y = cvt_pk_bf16(s[2 * 33], s[3 * 33]); o.z = cvt_pk_bf16(s[4 * 33], s[5 * 33]); o.w = cvt_pk_bf16(s[6 * 33], s[7 * 33]);
        *(GAS u32x4*)(WT + (size_t)(vrow0 + n) * ldd + dk0 + 8 * c) = o; }
    LDS_WAIT(); asm volatile("" ::: "memory");
}

__device__ __forceinline__ void tr_item_fp8(const float* W, int ldsrc, int k0, int nsrc0, unsigned char* WT8, int ldd8, int vrow0, int dk0, const float* gain, float gscale, LAS float* scr, int lane) {
#pragma unroll 16
    for (int i = 0; i < 32; ++i) { const int kk = 2 * i + (lane >> 5); float v = W[(size_t)(k0 + kk) * ldsrc + nsrc0 + (lane & 31)]; v *= gain ? gain[k0 + kk] * gscale : gscale; scr[kk * 33 + (lane & 31)] = v; }
    LDS_WAIT(); asm volatile("" ::: "memory");
    const int c = lane & 7;
#pragma unroll
    for (int j = 0; j < 4; ++j) { const int n = (lane >> 3) + 8 * j; const LAS float* s = scr + (8 * c) * 33 + n;
        u32x2 o; o.x = pk_fp8x4(s[0 * 33], s[1 * 33], s[2 * 33], s[3 * 33]); o.y = pk_fp8x4(s[4 * 33], s[5 * 33], s[6 * 33], s[7 * 33]);
        *(GAS u32x2*)(WT8 + (size_t)(vrow0 + n) * ldd8 + dk0 + 8 * c) = o; }
    LDS_WAIT(); asm volatile("" ::: "memory");
}

__device__ __forceinline__ void tr_item64(const float* W, int ldsrc, int k0, int nsrc0, bf16_t* WT, int ldd, int vrow0, int dk0, const float* gain, LAS unsigned* scr, int lane) {
    float v[64];
    const float* src = W + (size_t)k0 * ldsrc + nsrc0 + lane;
#pragma unroll
    for (int i = 0; i < 64; ++i) v[i] = src[(size_t)i * ldsrc];
    if (gain) {
#pragma unroll
        for (int i = 0; i < 64; ++i) v[i] *= gain[k0 + i]; }
#pragma unroll
    for (int kp = 0; kp < 32; ++kp) scr[kp * 65 + lane] = cvt_pk_bf16(v[2 * kp], v[2 * kp + 1]);
    LDS_WAIT(); asm volatile("" ::: "memory");
    const int c = lane & 7;
#pragma unroll
    for (int j = 0; j < 8; ++j) { const int n = (lane >> 3) + 8 * j; const LAS unsigned* s = scr + (4 * c) * 65 + n;
        u32x4 o; o.x = s[0]; o.y = s[65]; o.z = s[130]; o.w = s[195];
        *(GAS u32x4*)(WT + (size_t)(vrow0 + n) * ldd + dk0 + 8 * c) = o; }
    LDS_WAIT(); asm volatile("" ::: "memory");
}

__device__ __forceinline__ void tr_item64_fp8(const float* W, int ldsrc, int k0, int nsrc0, unsigned char* WT, int ldd8, int vrow0, int dk0, const float* gain, float sc, LAS unsigned* scr, int lane) {
    float v[64];
    const float* src = W + (size_t)k0 * ldsrc + nsrc0 + lane;
#pragma unroll
    for (int i = 0; i < 64; ++i) v[i] = src[(size_t)i * ldsrc];
#pragma unroll
    for (int i = 0; i < 64; ++i) v[i] *= gain ? gain[k0 + i] * sc : sc;
#pragma unroll
    for (int kq = 0; kq < 16; ++kq) scr[kq * 65 + lane] = pk_fp8x4(v[4 * kq], v[4 * kq + 1], v[4 * kq + 2], v[4 * kq + 3]);
    LDS_WAIT(); asm volatile("" ::: "memory");
    const int c = lane & 3;
#pragma unroll
    for (int j = 0; j < 4; ++j) { const int n = (lane >> 2) + 16 * j; const LAS unsigned* s = scr + (4 * c) * 65 + n;
        u32x4 o; o.x = s[0]; o.y = s[65]; o.z = s[130]; o.w = s[195];
        *(GAS u32x4*)(WT + (size_t)(vrow0 + n) * ldd8 + dk0 + 16 * c) = o; }
    LDS_WAIT(); asm volatile("" ::: "memory");
}

typedef f32x4 (&AccRef)[2][2][4][2];
#define EPI_FENCE() asm volatile("" ::: "memory")
__device__ __forceinline__ void load_rstd8(float (&rs)[2][4], const float* ssp, int row0, int fq) {
    f32x4 p[2][4];
#pragma unroll
    for (int ai = 0; ai < 2; ++ai)
#pragma unroll
        for (int m = 0; m < 4; ++m) p[ai][m] = *(const f32x4*)(ssp + (size_t)(row0 + ai * 128 + m * 16) * 16 + fq * 4);
#pragma unroll
    for (int ai = 0; ai < 2; ++ai)
#pragma unroll
        for (int m = 0; m < 4; ++m) { float s = (p[ai][m][0] + p[ai][m][1]) + (p[ai][m][2] + p[ai][m][3]); s += swz_xor<16>(s); s = add_x32(s); rs[ai][m] = __builtin_amdgcn_rsqf(s * (1.f / D) + NORM_EPS); }
}
#define EPI_PIN(ai) asm volatile("" : "+v"(acc[ai][0][0][0]), "+v"(acc[ai][0][0][1]), "+v"(acc[ai][0][1][0]), "+v"(acc[ai][0][1][1]), "+v"(acc[ai][0][2][0]), "+v"(acc[ai][0][2][1]), "+v"(acc[ai][0][3][0]), "+v"(acc[ai][0][3][1]), \
    "+v"(acc[ai][1][0][0]), "+v"(acc[ai][1][0][1]), "+v"(acc[ai][1][1][0]), "+v"(acc[ai][1][1][1]), "+v"(acc[ai][1][2][0]), "+v"(acc[ai][1][2][1]), "+v"(acc[ai][1][3][0]), "+v"(acc[ai][1][3][1]) :: "memory")
#define EPI_PIN2(ai, m0) asm volatile("" : "+v"(acc[ai][0][m0][0]), "+v"(acc[ai][0][m0][1]), "+v"(acc[ai][0][m0 + 1][0]), "+v"(acc[ai][0][m0 + 1][1]), "+v"(acc[ai][1][m0][0]), "+v"(acc[ai][1][m0][1]), "+v"(acc[ai][1][m0 + 1][0]), "+v"(acc[ai][1][m0 + 1][1]) :: "memory")
__device__ __forceinline__ int moe_expert(const volatile LAS unsigned* tst, int pm) { int e = 0;
#pragma unroll
    for (int q = 1; q < NE; ++q) e += (pm >= (int)tst[q]) ? 1 : 0; return e; }
__device__ __forceinline__ u32x4 pack8(const f32x4 a, const f32x4 b) { u32x4 w; w.x = cvt_pk_bf16(a[0], a[1]); w.y = cvt_pk_bf16(a[2], a[3]); w.z = cvt_pk_bf16(b[0], b[1]); w.w = cvt_pk_bf16(b[2], b[3]); return w; }
__device__ __forceinline__ float sumsq8(const f32x4 a, const f32x4 b) { return ((a[0] * a[0] + a[1] * a[1]) + (a[2] * a[2] + a[3] * a[3])) + ((b[0] * b[0] + b[1] * b[1]) + (b[2] * b[2] + b[3] * b[3])); }

struct EpiQKV {
    static constexpr bool PERM = true, IDEMP = false;
    bf16_t* Q; bf16_t* K; bf16_t* V; const float* ssp; float zs; int pad_;
    __device__ __forceinline__ void operator()(AccRef acc, const pg8::Unit& u, int wr, int wc, int fr, int fq) const {
        const int rl0 = wr * 64 + fr, row0 = u.pm * 256 + rl0; float rs8[2][4]; load_rstd8(rs8, ssp, row0, fq);
#pragma unroll
        for (int ai = 0; ai < 2; ++ai)
#pragma unroll
            for (int m = 0; m < 4; ++m) rs8[ai][m] *= zs;
        if (u.pn < 8) {
            bf16_t* base = (u.pn < 4) ? Q : K; const float sc0 = (u.pn < 4) ? C2 : 1.0f;
            const int col = ((u.pn & 3) * 4 + wc) * 64 + 8 * fq;
            float inv[8];
#pragma unroll
            for (int q = 0; q < 8; ++q) inv[q] = __builtin_amdgcn_exp2f(-0.41524101186092029f * (float)(8 * fq + q));
#pragma unroll
            for (int ai = 0; ai < 2; ++ai)
#pragma unroll
                for (int m = 0; m < 4; ++m) { const int row = row0 + ai * 128 + m * 16; const float pos = (float)(row & (SEQ - 1)); const float sc = sc0 * rs8[ai][m];
#pragma unroll
                    for (int n = 0; n < 2; ++n) { f32x4 c, s;
#pragma unroll
                        for (int e = 0; e < 4; ++e) { const float ang = pos * inv[4 * n + e]; const float rev = ang * 0.15915494309189535f; const float fr_ = rev - __builtin_rintf(rev);
                            c[e] = __builtin_amdgcn_cosf(fr_) * sc; s[e] = __builtin_amdgcn_sinf(fr_) * sc; }
                        const f32x4 l = acc[ai][0][m][n], h = acc[ai][1][m][n];
                        acc[ai][0][m][n] = l * c - h * s; acc[ai][1][m][n] = h * c + l * s; } }
#pragma unroll
            for (int ai = 0; ai < 2; ++ai)
#pragma unroll
                for (int m = 0; m < 4; ++m) { bf16_t* rp = base + (size_t)(row0 + ai * 128 + m * 16) * D + col;
                    *(u32x4*)rp = pack8(acc[ai][0][m][0], acc[ai][0][m][1]); *(u32x4*)(rp + 32) = pack8(acc[ai][1][m][0], acc[ai][1][m][1]); }
        } else {
            const int col = (u.pn - 8) * 256 + wc * 32 + 8 * fq;
#pragma unroll
            for (int ai = 0; ai < 2; ++ai)
#pragma unroll
                for (int m = 0; m < 4; ++m) { bf16_t* rp = V + (size_t)(row0 + ai * 128 + m * 16) * D + col; const float rs = rs8[ai][m];
#pragma unroll
                    for (int bj = 0; bj < 2; ++bj) *(u32x4*)(rp + bj * 128) = pack8(acc[ai][bj][m][0] * rs, acc[ai][bj][m][1] * rs); }
        }
    }
};
__device__ __forceinline__ void add_bf8(f32x4& a0, f32x4& a1, const u32x4 w, const float sc) {
    a0[0] = bf_lo(w.x) + a0[0] * sc; a0[1] = bf_hi(w.x) + a0[1] * sc; a0[2] = bf_lo(w.y) + a0[2] * sc; a0[3] = bf_hi(w.y) + a0[3] * sc;
    a1[0] = bf_lo(w.z) + a1[0] * sc; a1[1] = bf_hi(w.z) + a1[1] * sc; a1[2] = bf_lo(w.w) + a1[2] * sc; a1[3] = bf_hi(w.w) + a1[3] * sc; }
struct EpiRes {
    static constexpr bool PERM = true, IDEMP = false;
    const bf16_t* in; bf16_t* out; float* ssp; unsigned char* out8; float es; int pad_;
    __device__ __forceinline__ void operator()(AccRef acc, const pg8::Unit& u, int wr, int wc, int fr, int fq) const {
        const int row0 = u.pm * 256 + wr * 64 + fr, col0 = u.pn * 256 + wc * 32 + 8 * fq;
#pragma unroll
        for (int ai = 0; ai < 2; ++ai) { u32x4 w[4][2];
#pragma unroll
            for (int m = 0; m < 4; ++m)
#pragma unroll
                for (int bj = 0; bj < 2; ++bj) w[m][bj] = *(const u32x4*)(in + (size_t)(row0 + ai * 128 + m * 16) * D + col0 + bj * 128);
#pragma unroll
            for (int m = 0; m < 4; ++m)
#pragma unroll
                for (int bj = 0; bj < 2; ++bj) add_bf8(acc[ai][bj][m][0], acc[ai][bj][m][1], w[m][bj], es);
            EPI_PIN(ai); }
        EPI_FENCE();
#pragma unroll
        for (int ai = 0; ai < 2; ++ai)
#pragma unroll
            for (int m = 0; m < 4; ++m) { const int row = row0 + ai * 128 + m * 16; const size_t off = (size_t)row * D + col0; float s = 0.f;
#pragma unroll
                for (int bj = 0; bj < 2; ++bj) { const f32x4 x0 = acc[ai][bj][m][0], x1 = acc[ai][bj][m][1]; *(u32x4*)(out + off + bj * 128) = pack8(x0, x1); s += sumsq8(x0, x1);
                    if (out8) { u32x2 q; q.x = pk_fp8x4(x0[0], x0[1], x0[2], x0[3]); q.y = pk_fp8x4(x1[0], x1[1], x1[2], x1[3]); *(u32x2*)(out8 + off + bj * 128) = q; } }
                s += swz_xor<16>(s); s = add_x32(s);
                if (fq == 0) ssp[(size_t)row * 16 + u.pn * 4 + wc] = s; }
    }
};
struct EpiSwiGLU {
    static constexpr bool PERM = true, IDEMP = true;
    bf16_t* out; const float* ssp; const float* srs; int ldc; int f8; int f8o; int pad_;
    __device__ __forceinline__ void operator()(AccRef acc, const pg8::Unit& u, int wr, int wc, int fr, int fq) const {
        const int rl0 = wr * 64 + fr, row0 = u.pm * 256 + rl0, col0 = u.pn * 128 + wc * 32 + 8 * fq; float rs8[2][4];
        if (srs) {
#pragma unroll
            for (int ai = 0; ai < 2; ++ai)
#pragma unroll
                for (int m = 0; m < 4; ++m) rs8[ai][m] = srs[row0 + ai * 128 + m * 16];
        } else load_rstd8(rs8, ssp, row0, fq);
#pragma unroll
        for (int ai = 0; ai < 2; ++ai)
#pragma unroll
            for (int m = 0; m < 4; ++m) { f32x4 h[2]; const float rs = f8 ? rs8[ai][m] * (1.0f / W8_SCALE) : rs8[ai][m];
                const float c1 = -1.4426950408889634f * rs, c2 = f8o ? rs * rs * H8_SCALE : rs * rs;
#pragma unroll
                for (int n = 0; n < 2; ++n) { const f32x4 ag = acc[ai][0][m][n], au = acc[ai][1][m][n];
#pragma unroll
                    for (int e = 0; e < 4; ++e) h[n][e] = (ag[e] * au[e]) * c2 * __builtin_amdgcn_rcpf(1.0f + __builtin_amdgcn_exp2f(ag[e] * c1)); }
                if (f8o) { u32x2 q; q.x = pk_fp8x4_m3(h[0][0], h[0][1], h[0][2], h[0][3]); q.y = pk_fp8x4_m3(h[1][0], h[1][1], h[1][2], h[1][3]);
                    *(u32x2*)((unsigned char*)out + (size_t)(row0 + ai * 128 + m * 16) * ldc + col0) = q; }
                else *(u32x4*)(out + (size_t)(row0 + ai * 128 + m * 16) * ldc + col0) = pack8(h[0], h[1]); }
    }
};
struct EpiLruIn {
    static constexpr bool PERM = true, IDEMP = true;
    bf16_t* XL; bf16_t* Y; const float* ssp;
    __device__ __forceinline__ void operator()(AccRef acc, const pg8::Unit& u, int wr, int wc, int fr, int fq) const {
        const int rl0 = wr * 64 + fr, row0 = u.pm * 256 + rl0, col0 = (u.pn & 3) * 256 + wc * 32 + 8 * fq; const bool isy = u.pn >= 4; bf16_t* base = isy ? Y : XL; float rs8[2][4]; load_rstd8(rs8, ssp, row0, fq);
#pragma unroll
        for (int ai = 0; ai < 2; ++ai)
#pragma unroll
            for (int m = 0; m < 4; ++m) { bf16_t* rp = base + (size_t)(row0 + ai * 128 + m * 16) * D + col0; const float rs = rs8[ai][m];
#pragma unroll
                for (int bj = 0; bj < 2; ++bj) { f32x4 v[2] = {acc[ai][bj][m][0] * rs, acc[ai][bj][m][1] * rs};
                    if (isy) {
#pragma unroll
                        for (int n = 0; n < 2; ++n)
#pragma unroll
                            for (int e = 0; e < 4; ++e) { const float x = v[n][e]; const float z = 0.7978845608028654f * (x + 0.044715f * x * x * x); v[n][e] = x * fast_sigmoid(2.0f * z); } }
                    *(u32x4*)(rp + bj * 128) = pack8(v[0], v[1]); } }
    }
};
struct EpiGates {
    static constexpr bool PERM = true, IDEMP = false;
    const bf16_t* U; const float* ba; const float* bx; const float* spl; bf16_t* LA; bf16_t* BT;
    __device__ __forceinline__ void operator()(AccRef acc, const pg8::Unit& u, int wr, int wc, int fr, int fq) const {
        const int row0 = u.pm * 256 + wr * 64 + fr, ch0 = u.pn * 128 + wc * 32 + 8 * fq;
        f32x4 vba[2], vbx[2], vsp[2]; u32x4 uu[2][4];
#pragma unroll
        for (int n = 0; n < 2; ++n) { vba[n] = *(const f32x4*)(ba + ch0 + 4 * n); vbx[n] = *(const f32x4*)(bx + ch0 + 4 * n); vsp[n] = *(const f32x4*)(spl + ch0 + 4 * n); }
#pragma unroll
        for (int ai = 0; ai < 2; ++ai)
#pragma unroll
            for (int m = 0; m < 4; ++m) uu[ai][m] = *(const u32x4*)(U + (size_t)(row0 + ai * 128 + m * 16) * D + ch0);
#pragma unroll
        for (int ai = 0; ai < 2; ++ai)
#pragma unroll
            for (int m = 0; m < 4; ++m) { const u32x4 q = uu[ai][m];
                const float uf[8] = {bf_lo(q.x), bf_hi(q.x), bf_lo(q.y), bf_hi(q.y), bf_lo(q.z), bf_hi(q.z), bf_lo(q.w), bf_hi(q.w)};
#pragma unroll
                for (int n = 0; n < 2; ++n)
#pragma unroll
                    for (int e = 0; e < 4; ++e) { const float r = fast_sigmoid(acc[ai][0][m][n][e] + vba[n][e]), ig = fast_sigmoid(acc[ai][1][m][n][e] + vbx[n][e]);
                        const float l = -8.0f * r * vsp[n][e]; const float a2 = __builtin_amdgcn_exp2f(2.8853900817779268f * l);
                        acc[ai][0][m][n][e] = l; acc[ai][1][m][n][e] = __builtin_sqrtf(fmaxf(1.0f - a2, 0.f)) * ig * uf[4 * n + e]; } }
        EPI_FENCE();
#pragma unroll
        for (int ai = 0; ai < 2; ++ai)
#pragma unroll
            for (int m = 0; m < 4; ++m) { const size_t off = (size_t)(row0 + ai * 128 + m * 16) * D + ch0;
                *(u32x4*)(LA + off) = pack8(acc[ai][0][m][0], acc[ai][0][m][1]); *(u32x4*)(BT + off) = pack8(acc[ai][1][m][0], acc[ai][1][m][1]); }
    }
};
struct EpiBf16 {
    static constexpr bool PERM = true, IDEMP = true;
    bf16_t* out;
    __device__ __forceinline__ void operator()(AccRef acc, const pg8::Unit& u, int wr, int wc, int fr, int fq) const {
        const int row0 = u.pm * 256 + wr * 64 + fr, col0 = u.pn * 256 + wc * 32 + 8 * fq;
#pragma unroll
        for (int ai = 0; ai < 2; ++ai)
#pragma unroll
            for (int m = 0; m < 4; ++m) { bf16_t* rp = out + (size_t)(row0 + ai * 128 + m * 16) * D + col0;
#pragma unroll
                for (int bj = 0; bj < 2; ++bj) *(u32x4*)(rp + bj * 128) = pack8(acc[ai][bj][m][0], acc[ai][bj][m][1]); }
    }
};
struct EpiPleGate {
    static constexpr bool PERM = true, IDEMP = false;
    const bf16_t* in; const bf16_t* proj; const float* ssp_in; bf16_t* out; float* ssp; unsigned char* out8; float es; float zs;
    __device__ __forceinline__ void operator()(AccRef acc, const pg8::Unit& u, int wr, int wc, int fr, int fq) const {
        const int rl0 = wr * 64 + fr, row0 = u.pm * 256 + rl0, col0 = u.pn * 256 + wc * 32 + 8 * fq; float rs8[2][4]; load_rstd8(rs8, ssp_in, row0, fq);
#pragma unroll
        for (int ai = 0; ai < 2; ++ai)
#pragma unroll
          for (int mp = 0; mp < 4; mp += 2) { u32x4 hw[4][2], pw[4][2];
#pragma unroll
            for (int m = mp; m < mp + 2; ++m)
#pragma unroll
                for (int bj = 0; bj < 2; ++bj) { const size_t off = (size_t)(row0 + ai * 128 + m * 16) * D + col0 + bj * 128; hw[m][bj] = *(const u32x4*)(in + off); pw[m][bj] = *(const u32x4*)(proj + off); }
#pragma unroll
            for (int m = mp; m < mp + 2; ++m) { const float rs = rs8[ai][m] * zs;
#pragma unroll
                for (int bj = 0; bj < 2; ++bj) { const u32x4 pp = pw[m][bj]; f32x4 a0 = acc[ai][bj][m][0] * rs, a1 = acc[ai][bj][m][1] * rs;
                    a0[0] = fast_sigmoid(a0[0]) * bf_lo(pp.x); a0[1] = fast_sigmoid(a0[1]) * bf_hi(pp.x); a0[2] = fast_sigmoid(a0[2]) * bf_lo(pp.y); a0[3] = fast_sigmoid(a0[3]) * bf_hi(pp.y);
                    a1[0] = fast_sigmoid(a1[0]) * bf_lo(pp.z); a1[1] = fast_sigmoid(a1[1]) * bf_hi(pp.z); a1[2] = fast_sigmoid(a1[2]) * bf_lo(pp.w); a1[3] = fast_sigmoid(a1[3]) * bf_hi(pp.w);
                    add_bf8(a0, a1, hw[m][bj], es); acc[ai][bj][m][0] = a0; acc[ai][bj][m][1] = a1; } }
            if (mp == 0) EPI_PIN2(ai, 0); else EPI_PIN2(ai, 2); }
        EPI_FENCE();
#pragma unroll
        for (int ai = 0; ai < 2; ++ai)
#pragma unroll
            for (int m = 0; m < 4; ++m) { const int row = row0 + ai * 128 + m * 16; const size_t off = (size_t)row * D + col0; float s = 0.f;
#pragma unroll
                for (int bj = 0; bj < 2; ++bj) { const f32x4 x0 = acc[ai][bj][m][0], x1 = acc[ai][bj][m][1]; *(u32x4*)(out + off + bj * 128) = pack8(x0, x1); s += sumsq8(x0, x1);
                    if (out8) { u32x2 q; q.x = pk_fp8x4(x0[0], x0[1], x0[2], x0[3]); q.y = pk_fp8x4(x1[0], x1[1], x1[2], x1[3]); *(u32x2*)(out8 + off + bj * 128) = q; } }
                s += swz_xor<16>(s); s = add_x32(s);
                if (fq == 0) ssp[(size_t)row * 16 + u.pn * 4 + wc] = s; }
    }
};
struct EpiMoeDown {
    static constexpr bool PERM = true, IDEMP = false;
    const bf16_t* in; bf16_t* out; const int* stok; const float* sgate; float* ssp; const volatile LAS unsigned* cnt; const volatile LAS unsigned* tst; unsigned char* out8; float es; int last_pass;
    __device__ __forceinline__ void operator()(AccRef acc, const pg8::Unit& u, int wr, int wc, int fr, int fq) const {
        const int e = moe_expert(tst, u.pm); const int nvalid = (int)cnt[e] - (u.pm - (int)tst[e]) * 256;
        const int r0 = wr * 64 + fr, col0 = u.pn * 256 + wc * 32 + 8 * fq;
        int tok[2][4]; float g[2][4];
#pragma unroll
        for (int ai = 0; ai < 2; ++ai)
#pragma unroll
            for (int m = 0; m < 4; ++m) { const int r = r0 + ai * 128 + m * 16; tok[ai][m] = -1; g[ai][m] = 0.f; if (r < nvalid) { tok[ai][m] = stok[u.pm * 256 + r]; g[ai][m] = sgate[u.pm * 256 + r] * es; } }
#pragma unroll
        for (int ai = 0; ai < 2; ++ai) { u32x4 w[4][2];
#pragma unroll
            for (int m = 0; m < 4; ++m)
#pragma unroll
                for (int bj = 0; bj < 2; ++bj) { w[m][bj] = (u32x4){0u, 0u, 0u, 0u}; if (tok[ai][m] >= 0) w[m][bj] = *(const u32x4*)(in + (size_t)tok[ai][m] * D + col0 + bj * 128); }
#pragma unroll
            for (int m = 0; m < 4; ++m)
#pragma unroll
                for (int bj = 0; bj < 2; ++bj) add_bf8(acc[ai][bj][m][0], acc[ai][bj][m][1], w[m][bj], g[ai][m]);
            EPI_PIN(ai); }
        EPI_FENCE();
#pragma unroll
        for (int ai = 0; ai < 2; ++ai)
#pragma unroll
            for (int m = 0; m < 4; ++m) { const bool ok = tok[ai][m] >= 0; const size_t off = (size_t)(ok ? tok[ai][m] : 0) * D + col0; float s = 0.f;
#pragma unroll
                for (int bj = 0; bj < 2; ++bj) { const f32x4 x0 = acc[ai][bj][m][0], x1 = acc[ai][bj][m][1]; if (ok) *(u32x4*)(out + off + bj * 128) = pack8(x0, x1); s += sumsq8(x0, x1);
                    if (last_pass && ok) { u32x2 q; q.x = pk_fp8x4(x0[0], x0[1], x0[2], x0[3]); q.y = pk_fp8x4(x1[0], x1[1], x1[2], x1[3]); *(u32x2*)(out8 + off + bj * 128) = q; } }
                if (last_pass) { s += swz_xor<16>(s); s = add_x32(s); if (ok && fq == 0) ssp[(size_t)tok[ai][m] * 16 + u.pn * 4 + wc] = s; } }
    }
};

#ifndef MOE_FP8
#define MOE_FP8 1
#endif
#ifndef FFN8_MASK
#define FFN8_MASK 0x4u
#endif
#define FFN8(li) (((FFN8_MASK) >> (li)) & 1u)
#ifndef DN8_MASK
#define DN8_MASK 0x5u
#endif
#define DN8(li) (((DN8_MASK) >> (li)) & 1u)
#ifndef QKV8_MASK
#define QKV8_MASK 0x4u
#endif
#define QKV8(li) (((QKV8_MASK) >> (li)) & 1u)
#ifndef WO8_MASK
#define WO8_MASK 0x4u
#endif
#define WO8(li) (((WO8_MASK) >> (li)) & 1u)
#ifndef FFN_FP8
#define FFN_FP8 0
#endif
constexpr int FFN_ESZ = FFN_FP8 ? 1 : 2;
constexpr int MOE_ESZ = MOE_FP8 ? 1 : 2;
struct DenseSched {
    pg8::StaticOrder ord; const char* A; const char* B; size_t a_tstep, b_tstep; const float* ssp;
    __device__ __forceinline__ bool next(int i, pg8::Unit& u) const { return ord.next(i, u); }
    __device__ __forceinline__ const char* abase(const pg8::Unit& u) const { return A + (size_t)u.pm * a_tstep; }
    __device__ __forceinline__ const char* bbase(const pg8::Unit& u) const { return B + (size_t)u.pn * b_tstep; }
    __device__ __forceinline__ int arow(const pg8::Unit&, int) const { return 0; }
    __device__ __forceinline__ int rsrow(const pg8::Unit& u, int r) const { return u.pm * 256 + r; }
};
struct GatesSched {
    pg8::StaticOrder ord; const char* A; const char* B; const float* ssp;
    __device__ __forceinline__ bool next(int i, pg8::Unit& u) const { return ord.next(i, u); }
    __device__ __forceinline__ const char* abase(const pg8::Unit& u) const { return A + (size_t)u.pm * (256 * D * 2) + (size_t)u.pn * 256; }
    __device__ __forceinline__ const char* bbase(const pg8::Unit& u) const { return B + (size_t)u.pn * (256 * 128 * 2); }
    __device__ __forceinline__ int arow(const pg8::Unit&, int) const { return 0; }
    __device__ __forceinline__ int rsrow(const pg8::Unit&, int) const { return -1; }
};
struct MoeGuSched {
    pg8::StaticOrder ord; const char* A; const char* B; const int* stok; const float* ssp; const volatile LAS unsigned* cnt; const volatile LAS unsigned* tst;
    __device__ __forceinline__ bool next(int i, pg8::Unit& u) const { return ord.next(i, u); }
    __device__ __forceinline__ const char* abase(const pg8::Unit& u) const { return MOE_FP8 ? A + (size_t)u.pm * (256 * D) : A; }
    __device__ __forceinline__ const char* bbase(const pg8::Unit& u) const { return B + (size_t)moe_expert(tst, u.pm) * ((size_t)2 * FFE * D * MOE_ESZ) + (size_t)u.pn * (256 * D * MOE_ESZ); }
    __device__ __forceinline__ int arow(const pg8::Unit& u, int r) const { const int e = moe_expert(tst, u.pm); const int nvalid = (int)cnt[e] - (u.pm - (int)tst[e]) * 256; return r < nvalid ? stok[u.pm * 256 + r] : 0; }
    __device__ __forceinline__ int rsrow(const pg8::Unit& u, int r) const { const int e = moe_expert(tst, u.pm); const int nvalid = (int)cnt[e] - (u.pm - (int)tst[e]) * 256; return r < nvalid ? stok[u.pm * 256 + r] : -1; }
};
struct MoeDownSched {
    pg8::StaticOrder ord; const char* A; const char* B; const float* ssp; const volatile LAS unsigned* tst;
    __device__ __forceinline__ bool next(int i, pg8::Unit& u) const { return ord.next(i, u); }
    __device__ __forceinline__ const char* abase(const pg8::Unit& u) const { return A + (size_t)u.pm * ((size_t)256 * FFE * MOE_ESZ); }
    __device__ __forceinline__ const char* bbase(const pg8::Unit& u) const { return B + (size_t)moe_expert(tst, u.pm) * ((size_t)D * FFE * MOE_ESZ) + (size_t)u.pn * ((size_t)256 * FFE * MOE_ESZ); }
    __device__ __forceinline__ int arow(const pg8::Unit&, int) const { return 0; }
    __device__ __forceinline__ int rsrow(const pg8::Unit&, int) const { return -1; }
};

#ifndef PH_MASK
#define PH_MASK 0xffffffffu
#endif
#define PH_ON(k) (((PH_MASK) >> (k)) & 1u)
#ifndef DUP_MASK
#define DUP_MASK 0u
#endif
#define DUP_FOR(k) for (int rep_ = (((DUP_MASK) >> (k)) & 1u) ? 0 : 1; rep_ < 2; ++rep_)
#define ES_ const float es_ = (rep_ == 1) ? 1.0f : 0.0f; (void)es_
struct Args { const float* in[34]; float* out; unsigned char* ws; int nlayers; int pad; };

#define MOE_CONV_BODY \
                { const float* wg = INP(31) + (size_t)j * NE * D * FFE; const float* wu = INP(32) + (size_t)j * NE * D * FFE; bf16_t* dst = (bf16_t*)(ws + WS_WB + WB_MGU); \
                  for (int it = gw; it < NE * 16 * 112; it += NGW) { const int e = it / (16 * 112), r = it % (16 * 112), kb = r / 112, vb = r % 112; const int vrow0 = vb * 64, pn = vrow0 >> 8, v = vrow0 & 255; \
                      if (MOE_FP8) tr_item64_fp8((v < 128 ? wg : wu) + (size_t)e * D * FFE, FFE, kb * 64, pn * 128 + (v & 127), (unsigned char*)dst + (size_t)e * 2 * FFE * D, D, vrow0, kb * 64, g_ffn_next, W8_SCALE, scr64, lane); \
                      else tr_item64((v < 128 ? wg : wu) + (size_t)e * D * FFE, FFE, kb * 64, pn * 128 + (v & 127), dst + (size_t)e * 2 * FFE * D, D, vrow0, kb * 64, g_ffn_next, scr64, lane); } } \
                { const float* wd = INP(33) + (size_t)j * NE * FFE * D; bf16_t* dst = (bf16_t*)(ws + WS_WB + WB_MD); \
                  for (int it = gw; it < NE * 56 * 16; it += NGW) { const int e = it / (56 * 16), r = it % (56 * 16), kb = r / 16, vb = r % 16; \
                      if (MOE_FP8) tr_item64_fp8(wd + (size_t)e * FFE * D, D, kb * 64, vb * 64, (unsigned char*)dst + (size_t)e * D * FFE, FFE, vb * 64, kb * 64, nullptr, W8_SCALE, scr64, lane); \
                      else tr_item64(wd + (size_t)e * FFE * D, D, kb * 64, vb * 64, dst + (size_t)e * D * FFE, FFE, vb * 64, kb * 64, nullptr, scr64, lane); } }
#define INP(i) ({ int _ix = (i); asm volatile("" : "+s"(_ix)); args.in[_ix]; })
#define PH_LOCALS \
    int tid = tid_of(wave_s); asm volatile("" : "+v"(tid)); const int lane = tid & 63; const int wave = __builtin_amdgcn_readfirstlane(tid >> 6); \
    int G = (int)gridDim.x; int bx = (int)blockIdx.x; asm volatile("" : "+s"(G), "+s"(bx)); \
    const int vcu = (G % 8 == 0) ? (bx % 8) * (G / 8) + bx / 8 : bx; const int gw = vcu * 8 + wave, NGW = G * 8; \
    size_t z_ = 0; asm volatile("" : "+s"(z_)); unsigned char* ws = args.ws + z_; \
    int cur_ = cur; asm volatile("" : "+s"(cur_)); \
    bf16_t* HC = (bf16_t*)(ws + (cur_ ? WS_HB0 : WS_XN)); bf16_t* HO = (bf16_t*)(ws + (cur_ ? WS_XN : WS_HB0));        \
    float* SC = (float*)(ws + (cur_ ? WS_SSP0 : WS_SSP1)); float* SO = (float*)(ws + (cur_ ? WS_SSP1 : WS_SSP0));        \
    bf16_t* PROJ = (bf16_t*)(ws + WS_PROJ); \
    unsigned char* R = ws + WS_R; unsigned char* MS = ws + WS_MISC; \
    LAS float* scr = (LAS float*)(lds + RING_OFF + wave * 16384); LAS unsigned* scr64 = (LAS unsigned*)(lds + RING_OFF + wave * 16384); \
    (void)lane; (void)vcu; (void)gw; (void)NGW; (void)HC; (void)HO; (void)SC; (void)SO; (void)PROJ; (void)R; (void)MS; (void)scr; (void)scr64
#define LAYER_LOCALS \
    int li_ = li; asm volatile("" : "+s"(li_)); const int j = li_ >> 1; const bool is_attn = !(li_ & 1); \
    unsigned char* W = ws + (is_attn ? WS_WA : WS_WB); bf16_t* P16 = (bf16_t*)(ws + ((li_ & 1) ? WS_P16B : WS_P16));        \
    const float* g_mix = INP(2) + li_ * D; const float* g_ffn = INP(3) + li_ * D; const float* g_ple = INP(4) + li_ * D; \
    (void)j; (void)W; (void)P16; (void)g_mix; (void)g_ffn; (void)g_ple

__device__ __forceinline__ void prep_layer(const Args& args, LAS unsigned char* lds, const int wave_s, const int li, const int cur) {
    PH_LOCALS; LAYER_LOCALS;
            { const float* wg = INP(7) + (size_t)li * D * D; unsigned char* dst = W + (is_attn ? WA_PG : WB_PG);
              for (int it = gw; it < 16 * 16; it += NGW) { const int kb = it / 16, vb = it % 16; tr_item64_fp8(wg, D, kb * 64, vb * 64, dst, D, vb * 64, kb * 64, g_ple, W8_SCALE, scr64, lane); } }
            { const float* wp = INP(6) + (size_t)li * DPLE * D; bf16_t* dst = (bf16_t*)(W + (is_attn ? WA_PP : WB_PP));
              for (int it = gw; it < 4 * 32; it += NGW) { const int kb = it / 32, vb = it % 32; tr_item(wp, D, kb * 64, vb * 32, dst, DPLE, vb * 32, kb * 64, nullptr, 1.f, scr, lane); } }
            if (is_attn) {
                const float* wq = INP(8) + (size_t)j * D * D; const float* wk = INP(9) + (size_t)j * D * D; const float* wv = INP(10) + (size_t)j * D * D;
                bf16_t* dqkv = (bf16_t*)(W + WA_QKV);
                for (int it = gw; it < 16 * 96; it += NGW) { const int kb = it / 96, vb = it % 96; const int vrow0 = vb * 32, pn = vrow0 >> 8, v = vrow0 & 255;
                    const float* src; int nsrc0;
                    if (pn < 8) { src = pn < 4 ? wq : wk; nsrc0 = ((pn & 3) * 4 + ((v & 127) >> 5)) * 64 + (v >> 7) * 32; }
                    else { src = wv; nsrc0 = (pn - 8) * 256 + v; }
                    if (QKV8(li_)) tr_item_fp8(src, D, kb * 64, nsrc0, (unsigned char*)dqkv, D, vrow0, kb * 64, g_mix, W8_SCALE, scr, lane);
                    else tr_item(src, D, kb * 64, nsrc0, dqkv, D, vrow0, kb * 64, g_mix, 1.f, scr, lane); }
                { const float* wo = INP(11) + (size_t)j * D * D; const float* sg = INP(16) + j * 128; bf16_t* dst = (bf16_t*)(W + WA_O);
                  const float linit = 0.8f - 0.6f * __expf(-0.3f * (float)li_);
                  for (int it = gw; it < 16 * 32; it += NGW) { const int kb = it / 32, vb = it % 32; if (WO8(li_)) tr_item_fp8(wo, D, kb * 64, vb * 32, (unsigned char*)dst, D, vb * 32, kb * 64, sg + ((kb * 64) & 127) - kb * 64, (1.0f - linit) * W8_SCALE, scr, lane);
                      else tr_item(wo, D, kb * 64, vb * 32, dst, D, vb * 32, kb * 64, sg + ((kb * 64) & 127) - kb * 64, 1.0f - linit, scr, lane); } }
                { const float* wg = INP(17) + (size_t)j * D * FF; const float* wu = INP(18) + (size_t)j * D * FF; bf16_t* dst = (bf16_t*)(W + WA_GU);
                  for (int it = gw; it < 16 * 88; it += NGW) { const int kb = it / 88, vb = it % 88; const int vrow0 = vb * 64, pn = vrow0 >> 8, v = vrow0 & 255;
                      if (FFN8(li_)) tr_item64_fp8(v < 128 ? wg : wu, FF, kb * 64, pn * 128 + (v & 127), (unsigned char*)dst, D, vrow0, kb * 64, g_ffn, W8_SCALE, scr64, lane);
                      else tr_item64(v < 128 ? wg : wu, FF, kb * 64, pn * 128 + (v & 127), dst, D, vrow0, kb * 64, g_ffn, scr64, lane); } }
                { const float* wd = INP(19) + (size_t)j * FF * D; bf16_t* dst = (bf16_t*)(W + WA_D);
                  for (int it = gw; it < 44 * 16; it += NGW) { const int kb = it / 16, vb = it % 16;
                      if (DN8(li_)) tr_item64_fp8(wd, D, kb * 64, vb * 64, (unsigned char*)dst, FF, vb * 64, kb * 64, nullptr, W8_SCALE, scr64, lane);
                      else tr_item64(wd, D, kb * 64, vb * 64, dst, FF, vb * 64, kb * 64, nullptr, scr64, lane); } }
            } else {
                { const float* wx = INP(20) + (size_t)j * D * D; const float* wy = INP(21) + (size_t)j * D * D; bf16_t* dst = (bf16_t*)(W + WB_IN);
                  for (int it = gw; it < 16 * 64; it += NGW) { const int kb = it / 64, vb = it % 64; const int vrow0 = vb * 32;
                      tr_item(vrow0 < D ? wx : wy, D, kb * 64, vrow0 & (D - 1), dst, D, vrow0, kb * 64, g_mix, 1.f, scr, lane); } }
                { const float* wa = INP(24) + (size_t)j * NE * 128 * 128; const float* wxg = INP(26) + (size_t)j * NE * 128 * 128; bf16_t* dst = (bf16_t*)(W + WB_GT);
                  for (int it = gw; it < 8 * 2 * 8; it += NGW) { const int n = it >> 4, kb = (it >> 3) & 1, vb = it & 7; const int v0 = vb * 32;
                      tr_item((v0 < 128 ? wa : wxg) + (size_t)n * 128 * 128, 128, kb * 64, v0 & 127, dst + (size_t)n * 256 * 128, 128, v0, kb * 64, nullptr, 1.f, scr, lane); } }
                { const float* wo = INP(29) + (size_t)j * D * D; bf16_t* dst = (bf16_t*)(W + WB_OUT);
                  for (int it = gw; it < 16 * 32; it += NGW) { const int kb = it / 32, vb = it % 32; tr_item(wo, D, kb * 64, vb * 32, dst, D, vb * 32, kb * 64, nullptr, 1.f, scr, lane); } }
                { const float* lam = INP(28) + j * D; float* spl = (float*)(MS + MS_SPL);
                  for (int it = bx * 512 + tid; it < D; it += G * 512) { const float xx = __expf(-lam[it]); spl[it] = xx * (1.0f - xx * (0.5f - xx * (0.33333333f - 0.25f * xx))); } }
            }
            { const f32x4* ps = (const f32x4*)(INP(1) + (size_t)li * NTOK * DPLE); u32x2* pd = (u32x2*)P16;
              const size_t stride = (size_t)G * 512;
              for (size_t it = (size_t)bx * 512 + tid; it < (size_t)NTOK * DPLE / 4; it += 8 * stride) { f32x4 v[8];
#pragma unroll
                  for (int q = 0; q < 8; ++q) { const size_t ix = it + q * stride; v[q] = (ix < (size_t)NTOK * DPLE / 4) ? ps[ix] : (f32x4){0.f, 0.f, 0.f, 0.f}; }
#pragma unroll
                  for (int q = 0; q < 8; ++q) { const size_t ix = it + q * stride; if (ix < (size_t)NTOK * DPLE / 4) { u32x2 o; o.x = cvt_pk_bf16(v[q][0], v[q][1]); o.y = cvt_pk_bf16(v[q][2], v[q][3]); pd[ix] = o; } } } }
            if (li_ == 0) for (int m = gw; m < NTOK; m += NGW) {
                const f32x4* xr = (const f32x4*)(INP(0) + (size_t)m * D) + lane; f32x4 v[4]; float s2 = 0.f;
#pragma unroll
                for (int q = 0; q < 4; ++q) { v[q] = xr[64 * q]; s2 += (v[q][0] * v[q][0] + v[q][1] * v[q][1]) + (v[q][2] * v[q][2] + v[q][3] * v[q][3]); }
                s2 = wave_sum(s2);
                u32x2* o8 = (u32x2*)(HC + (size_t)m * D) + lane;
#pragma unroll
                for (int q = 0; q < 4; ++q) { u32x2 o; o.x = cvt_pk_bf16(v[q][0], v[q][1]); o.y = cvt_pk_bf16(v[q][2], v[q][3]); o8[64 * q] = o; }
                if (lane < 16) SC[(size_t)m * 16 + lane] = (lane == 0) ? s2 : 0.f;
            }
}

__global__ void __launch_bounds__(512, 2) fwd_kernel(Args args) {
    extern __shared__ __attribute__((aligned(16))) unsigned char lds_raw[];
    LAS unsigned char* lds = (LAS unsigned char*)lds_raw;
    volatile LAS unsigned* MISC = (volatile LAS unsigned*)(lds + MISC_OFF);
    const int wave_s = __builtin_amdgcn_readfirstlane((int)threadIdx.x >> 6);
    for (int u = tid_of(wave_s); u < (LDS_BYTES - LDSCTL_OFF) / 4; u += 512) ((LAS unsigned*)(lds + LDSCTL_OFF))[u] = 0u;
    __syncthreads();
    XcdBarrier bar = xcd_barrier_post((unsigned*)(args.ws + WS_CTL) + CW_BAR, MISC + 8, wave_s);
#define GRID_BAR() xcd_barrier(bar, wave_s)
    int cur = 0;
    const int nlayers = args.nlayers;
    prep_layer(args, lds, wave_s, 0, cur);
    GRID_BAR();
    for (int li = 0; li < DEPTH; ++li) {
        if (li >= nlayers) break;
        const bool is_attn = !(li & 1);
        if (is_attn) {
            if (PH_ON(1)) DUP_FOR(1) { ES_; PH_LOCALS; LAYER_LOCALS; DenseSched S; S.ord.init(NTOK / 256, 12, G, bx); S.A = (const char*)HC; S.B = (const char*)(W + WA_QKV); S.a_tstep = (size_t)256 * D * 2; S.b_tstep = (size_t)256 * D * 2;
              S.ssp = nullptr;
              if (QKV8(li_)) { S.A = (const char*)(R + R_H8); S.a_tstep = (size_t)256 * D; S.b_tstep = (size_t)256 * D; EpiQKV E{(bf16_t*)(R + R_Q), (bf16_t*)(R + R_K), (bf16_t*)(R + R_V), SC, 1.0f / W8_SCALE, 0};
                pg8::gemm_phase<EpiQKV, DenseSched, false, true>(lds + RING_OFF, (LAS float*)(lds + MISC_OFF + 1024), D / 2, D / 2, D / 2, S, E, wave_s); }
              else { EpiQKV E{(bf16_t*)(R + R_Q), (bf16_t*)(R + R_K), (bf16_t*)(R + R_V), SC, 1.0f, 0};
                pg8::gemm_phase<EpiQKV, DenseSched, false, false>(lds + RING_OFF, (LAS float*)(lds + MISC_OFF + 1024), D, D, D, S, E, wave_s); } }
            GRID_BAR();
            if (PH_ON(2)) DUP_FOR(2) { ES_; PH_LOCALS; LAYER_LOCALS; const attn_body::bf16* Qp = (const attn_body::bf16*)(R + R_Q); const attn_body::bf16* Kp = (const attn_body::bf16*)(R + R_K); const attn_body::bf16* Vp = (const attn_body::bf16*)(R + R_V);
              attn_body::bf16* Op = (attn_body::bf16*)(R + R_OA);
              const float* g_ffn_next = INP(3) + (li_ + 1) * D; bool conv_done = false; const int conv_at = vcu & 15;
#define MOE_CONVERT() do { __syncthreads(); MOE_CONV_BODY __syncthreads(); conv_done = true; } while (0)
              if (((vcu >> 5) & 1) && li_ + 1 < args.nlayers) { __syncthreads(); prep_layer(args, lds, wave_s, li_ + 1, cur_); __syncthreads(); }
              int ii = 0;
              const float l1_ = wave_sum(INP(12)[j * 64 + lane] * INP(13)[j * 64 + lane]), l2_ = wave_sum(INP(14)[j * 64 + lane] * INP(15)[j * 64 + lane]);
              const float lam = __expf(l1_) - __expf(l2_) + (0.8f - 0.6f * __expf(-0.3f * (float)li_));
              attn_body::f32x16 keep[4];
#pragma unroll
              for (int d0 = 0; d0 < 4; ++d0) keep[d0] = attn_body::f32x16{};
              for (int item = vcu; item < 4096; item += G, ++ii) {
                  if (!conv_done && ii >= conv_at) MOE_CONVERT();
                  const int c = item & 31, xx = (item >> 5) & 7, step = item >> 8; const int bh = xx * 16 + step; const int b = bh >> 3, head = bh & 7; const int qb = (step & 1) ? 31 - c : c;
                  attn_body::attn_unit_ps<8, 0>(b, (2 * head) * 64, head * 128, head * 128, qb, Qp, Kp, Vp, Op, (char*)lds_raw + RING_OFF, wave_s, keep, lam);
                  attn_body::attn_unit_ps<8, 1>(b, (2 * head + 1) * 64, head * 128, head * 128, qb, Qp, Kp, Vp, Op, (char*)lds_raw + RING_OFF, wave_s, keep, lam, (int)WO8(li_));
              }
              if (!conv_done) MOE_CONVERT();
#undef MOE_CONVERT
              if (!((vcu >> 5) & 1) && li_ + 1 < args.nlayers) { __syncthreads(); prep_layer(args, lds, wave_s, li_ + 1, cur_); __syncthreads(); }
              }
            GRID_BAR();
            if (PH_ON(4)) DUP_FOR(4) { ES_; PH_LOCALS; LAYER_LOCALS; DenseSched S; S.ord.init(NTOK / 256, 4, G, bx); S.A = (const char*)(R + R_OA); S.B = (const char*)(W + WA_O); S.a_tstep = (size_t)256 * D * 2; S.b_tstep = (size_t)256 * D * 2;
              S.ssp = nullptr;
              if (WO8(li_)) { S.a_tstep = (size_t)256 * D; S.b_tstep = (size_t)256 * D; EpiRes E{HC, HO, SO, FFN8(li_) ? (unsigned char*)(R + R_H8) : nullptr, es_ * (1.0f / W8_SCALE), 0};
                pg8::gemm_phase<EpiRes, DenseSched, false, true>(lds + RING_OFF, (LAS float*)(lds + MISC_OFF + 1024), D / 2, D / 2, D / 2, S, E, wave_s); }
              else { EpiRes E{HC, HO, SO, FFN8(li_) ? (unsigned char*)(R + R_H8) : nullptr, es_, 0};
                pg8::gemm_phase<EpiRes, DenseSched, false, false>(lds + RING_OFF, (LAS float*)(lds + MISC_OFF + 1024), D, D, D, S, E, wave_s); } }
            GRID_BAR(); cur ^= 1;
        } else {
            if (PH_ON(5)) DUP_FOR(5) { ES_; PH_LOCALS; LAYER_LOCALS; DenseSched S; S.ord.init(NTOK / 256, 8, G, bx); S.A = (const char*)HC; S.B = (const char*)(W + WB_IN); S.a_tstep = (size_t)256 * D * 2; S.b_tstep = (size_t)256 * D * 2;
              S.ssp = nullptr; EpiLruIn E{(bf16_t*)(R + R_XL), (bf16_t*)(R + R_Y), SC};
              pg8::gemm_phase<EpiLruIn, DenseSched, false, false>(lds + RING_OFF, (LAS float*)(lds + MISC_OFF + 1024), D, D, D, S, E, wave_s); }
            GRID_BAR();
            if (PH_ON(6)) DUP_FOR(6) { ES_; PH_LOCALS; LAYER_LOCALS; const bf16_t* XL = (const bf16_t*)(R + R_XL); bf16_t* U = (bf16_t*)(R + R_U); const float* cw = INP(22) + (size_t)j * 4 * D; const float* cb = INP(23) + j * D;
              for (int it = gw; it < (NTOK / 32) * 2; it += NGW) { const int chunk = it >> 1, c0 = (it & 1) * 512 + lane * 8; const int row0 = chunk * 32; const int t0 = row0 & (SEQ - 1);
                  float w[4][8], bb[8];
#pragma unroll
                  for (int k = 0; k < 4; ++k) { const f32x4 a = *(const f32x4*)(cw + k * D + c0), b = *(const f32x4*)(cw + k * D + c0 + 4);
#pragma unroll
                      for (int e = 0; e < 4; ++e) { w[k][e] = a[e]; w[k][4 + e] = b[e]; } }
                  { const f32x4 a = *(const f32x4*)(cb + c0), b = *(const f32x4*)(cb + c0 + 4);
#pragma unroll
                    for (int e = 0; e < 4; ++e) { bb[e] = a[e]; bb[4 + e] = b[e]; } }
                  float x0[8], x1[8], x2[8];
#pragma unroll
                  for (int e = 0; e < 8; ++e) { x0[e] = 0.f; x1[e] = 0.f; x2[e] = 0.f; }
                  if (t0 > 0) {
                      const u32x4 q0 = *(const u32x4*)(XL + (size_t)(row0 - 3) * D + c0), q1 = *(const u32x4*)(XL + (size_t)(row0 - 2) * D + c0), q2 = *(const u32x4*)(XL + (size_t)(row0 - 1) * D + c0);
                      const unsigned a0[4] = {q0.x, q0.y, q0.z, q0.w}, a1[4] = {q1.x, q1.y, q1.z, q1.w}, a2[4] = {q2.x, q2.y, q2.z, q2.w};
#pragma unroll
                      for (int q = 0; q < 4; ++q) { x0[2 * q] = bf_lo(a0[q]); x0[2 * q + 1] = bf_hi(a0[q]); x1[2 * q] = bf_lo(a1[q]); x1[2 * q + 1] = bf_hi(a1[q]); x2[2 * q] = bf_lo(a2[q]); x2[2 * q + 1] = bf_hi(a2[q]); }
                  }
                  for (int r8 = 0; r8 < 32; r8 += 8) {
                      u32x4 qq[8];
#pragma unroll
                      for (int r = 0; r < 8; ++r) qq[r] = *(const u32x4*)(XL + (size_t)(row0 + r8 + r) * D + c0);
#pragma unroll
                      for (int r = 0; r < 8; ++r) { const unsigned aq[4] = {qq[r].x, qq[r].y, qq[r].z, qq[r].w}; float x3[8], o[8];
#pragma unroll
                          for (int q = 0; q < 4; ++q) { x3[2 * q] = bf_lo(aq[q]); x3[2 * q + 1] = bf_hi(aq[q]); }
#pragma unroll
                          for (int e = 0; e < 8; ++e) { o[e] = bb[e] + w[0][e] * x0[e] + w[1][e] * x1[e] + w[2][e] * x2[e] + w[3][e] * x3[e]; x0[e] = x1[e]; x1[e] = x2[e]; x2[e] = x3[e]; }
                          qq[r].x = cvt_pk_bf16(o[0], o[1]); qq[r].y = cvt_pk_bf16(o[2], o[3]); qq[r].z = cvt_pk_bf16(o[4], o[5]); qq[r].w = cvt_pk_bf16(o[6], o[7]); }
#pragma unroll
                      for (int r = 0; r < 8; ++r) *(u32x4*)(U + (size_t)(row0 + r8 + r) * D + c0) = qq[r];
                  } } }
            GRID_BAR();
            if (PH_ON(7)) DUP_FOR(7) { ES_; PH_LOCALS; LAYER_LOCALS; GatesSched S; S.ord.init(NTOK / 256, 8, G, bx); S.A = (const char*)(R + R_U); S.B = (const char*)(W + WB_GT);
              EpiGates E{(const bf16_t*)(R + R_U), INP(25) + j * D, INP(27) + j * D, (const float*)(MS + MS_SPL), (bf16_t*)(R + R_LA), (bf16_t*)(R + R_BT)};
              S.ssp = nullptr; pg8::gemm_phase<EpiGates, GatesSched, false, false>(lds + RING_OFF, (LAS float*)(lds + MISC_OFF + 1024), 128, D, 128, S, E, wave_s); }
            GRID_BAR();
            if (PH_ON(8)) DUP_FOR(8) { ES_; PH_LOCALS; LAYER_LOCALS; const bf16_t* LA = (const bf16_t*)(R + R_LA); const bf16_t* BT = (const bf16_t*)(R + R_BT);
              LAS float* cs = (LAS float*)(lds + RING_OFF);
              float* CS = (float*)(ws + WS_SCAN); float* CST = (float*)(ws + WS_SCAN + 16 * MiB);
              for (int item = bx; item < NB * 16; item += G) { const int b = item >> 4, cg = (item >> 1) & 7, half = item & 1, c0 = cg * 128 + lane * 2; const size_t base = ((size_t)b * SEQ + half * 2048 + wave * 256) * D + c0;
                  float P0[8], P1[8], h0[8], h1[8]; const char* pla[8]; const char* pbt[8];
#pragma unroll
                  for (int q = 0; q < 8; ++q) { P0[q] = 1.f; P1[q] = 1.f; h0[q] = 0.f; h1[q] = 0.f; const size_t o = (base + (size_t)q * 32 * D) * 2; pla[q] = (const char*)LA + o; pbt[q] = (const char*)BT + o; }
#pragma unroll 1
                  for (int t2 = 0; t2 < 32; t2 += 2) {
                      unsigned la[2][8], bt[2][8];
#pragma unroll
                      for (int s = 0; s < 2; ++s)
#pragma unroll
                          for (int q = 0; q < 8; ++q) { la[s][q] = *(const unsigned*)(pla[q] + s * (D * 2)); bt[s][q] = *(const unsigned*)(pbt[q] + s * (D * 2)); }
#pragma unroll
                      for (int s = 0; s < 2; ++s)
#pragma unroll
                          for (int q = 0; q < 8; ++q) { const float a0 = __builtin_amdgcn_exp2f(1.4426950408889634f * bf_lo(la[s][q])), a1 = __builtin_amdgcn_exp2f(1.4426950408889634f * bf_hi(la[s][q]));
                              h0[q] = a0 * h0[q] + bf_lo(bt[s][q]); h1[q] = a1 * h1[q] + bf_hi(bt[s][q]); P0[q] *= a0; P1[q] *= a1; }
#pragma unroll
                      for (int q = 0; q < 8; ++q) { pla[q] += 2 * D * 2; pbt[q] += 2 * D * 2; } }
#pragma unroll
                  for (int q = 0; q < 8; ++q) { const int sg = wave * 8 + q; cs[(sg * 2 + 0) * 128 + lane * 2] = P0[q]; cs[(sg * 2 + 0) * 128 + lane * 2 + 1] = P1[q]; cs[(sg * 2 + 1) * 128 + lane * 2] = h0[q]; cs[(sg * 2 + 1) * 128 + lane * 2 + 1] = h1[q]; }
                  __syncthreads();
                  if (tid < 128) { float pc = 1.f, hc = 0.f; float* csg = CS + (size_t)item * (64 * 2 * 128) + tid;
                      for (int sg = 0; sg < 64; ++sg) { csg[(sg * 2 + 0) * 128] = pc; csg[(sg * 2 + 1) * 128] = hc; const float p = cs[(sg * 2 + 0) * 128 + tid], h = cs[(sg * 2 + 1) * 128 + tid]; hc = p * hc + h; pc = p * pc; }
                      CST[item * 256 + tid] = pc; CST[item * 256 + 128 + tid] = hc; }
                  __syncthreads();
              } }
            GRID_BAR();
            if (PH_ON(8)) DUP_FOR(8) { ES_; PH_LOCALS; LAYER_LOCALS; const bf16_t* LA = (const bf16_t*)(R + R_LA); const bf16_t* BT = (const bf16_t*)(R + R_BT); const bf16_t* Y = (const bf16_t*)(R + R_Y); bf16_t* HY = (bf16_t*)(R + R_HY);
              const float* CS = (const float*)(ws + WS_SCAN); const float* CST = (const float*)(ws + WS_SCAN + 16 * MiB);
              for (int item = bx; item < NB * 16; item += G) { const int b = item >> 4, cg = (item >> 1) & 7, half = item & 1, c0 = cg * 128 + lane * 2; const size_t base = ((size_t)b * SEQ + half * 2048 + wave * 256) * D + c0;
                  float h0[8], h1[8]; const char* pla[8]; const char* pbt[8]; const char* py[8]; char* phy[8];
                  f32x2 hs = (f32x2){0.f, 0.f}; if (half) hs = *(const f32x2*)(CST + (item - 1) * 256 + 128 + lane * 2);
#pragma unroll
                  for (int q = 0; q < 8; ++q) { const float* cp = CS + (size_t)item * (64 * 2 * 128) + ((wave * 8 + q) * 2) * 128 + lane * 2; const f32x2 pc = *(const f32x2*)cp, hc = *(const f32x2*)(cp + 128);
                      h0[q] = pc[0] * hs[0] + hc[0]; h1[q] = pc[1] * hs[1] + hc[1];
                      const size_t o = (base + (size_t)q * 32 * D) * 2; pla[q] = (const char*)LA + o; pbt[q] = (const char*)BT + o; py[q] = (const char*)Y + o; phy[q] = (char*)HY + o; }
#pragma unroll 1
                  for (int t2 = 0; t2 < 32; t2 += 2) {
                      unsigned la[2][8], bt[2][8], yy[2][8];
#pragma unroll
                      for (int s = 0; s < 2; ++s)
#pragma unroll
                          for (int q = 0; q < 8; ++q) { la[s][q] = *(const unsigned*)(pla[q] + s * (D * 2)); bt[s][q] = *(const unsigned*)(pbt[q] + s * (D * 2)); yy[s][q] = *(const unsigned*)(py[q] + s * (D * 2)); }
#pragma unroll
                      for (int s = 0; s < 2; ++s)
#pragma unroll
                          for (int q = 0; q < 8; ++q) { const float a0 = __builtin_amdgcn_exp2f(1.4426950408889634f * bf_lo(la[s][q])), a1 = __builtin_amdgcn_exp2f(1.4426950408889634f * bf_hi(la[s][q]));
                              h0[q] = a0 * h0[q] + bf_lo(bt[s][q]); h1[q] = a1 * h1[q] + bf_hi(bt[s][q]); yy[s][q] = cvt_pk_bf16(h0[q] * bf_lo(yy[s][q]), h1[q] * bf_hi(yy[s][q])); }
#pragma unroll
                      for (int s = 0; s < 2; ++s)
#pragma unroll
                          for (int q = 0; q < 8; ++q) *(unsigned*)(phy[q] + s * (D * 2)) = yy[s][q];
#pragma unroll
                      for (int q = 0; q < 8; ++q) { pla[q] += 2 * D * 2; pbt[q] += 2 * D * 2; py[q] += 2 * D * 2; phy[q] += 2 * D * 2; } }
              } }
            GRID_BAR();
            if (PH_ON(9)) DUP_FOR(9) { ES_; PH_LOCALS; LAYER_LOCALS; DenseSched S; S.ord.init(NTOK / 256, 4, G, bx); S.A = (const char*)(R + R_HY); S.B = (const char*)(W + WB_OUT); S.a_tstep = (size_t)256 * D * 2; S.b_tstep = (size_t)256 * D * 2;
              S.ssp = nullptr; EpiRes E{HC, HO, SO, nullptr, es_, 0};
              pg8::gemm_phase<EpiRes, DenseSched, false, false>(lds + RING_OFF, (LAS float*)(lds + MISC_OFF + 1024), D, D, D, S, E, wave_s); }
            GRID_BAR(); cur ^= 1;
        }

        if (is_attn) {
            if (FFN8(li)) {
            if (PH_ON(10)) DUP_FOR(10) { ES_; PH_LOCALS; LAYER_LOCALS; DenseSched S; S.ord.init(NTOK / 256, 22, G, bx); S.A = (const char*)(R + R_H8); S.B = (const char*)(W + WA_GU); S.a_tstep = (size_t)256 * D * 1; S.b_tstep = (size_t)256 * D * 1;
              S.ssp = nullptr; EpiSwiGLU E{(bf16_t*)(R + R_HID), SC, nullptr, FF, 1, 1, 0};
              pg8::gemm_phase<EpiSwiGLU, DenseSched, false, true>(lds + RING_OFF, (LAS float*)(lds + MISC_OFF + 1024), D * 1 / 2, D * 1 / 2, D * 1 / 2, S, E, wave_s); }
            } else {
            if (PH_ON(10)) DUP_FOR(10) { ES_; PH_LOCALS; LAYER_LOCALS; DenseSched S; S.ord.init(NTOK / 256, 22, G, bx); S.A = (const char*)HC; S.B = (const char*)(W + WA_GU); S.a_tstep = (size_t)256 * D * 2; S.b_tstep = (size_t)256 * D * 2;
              S.ssp = nullptr; EpiSwiGLU E{(bf16_t*)(R + R_HID), SC, nullptr, FF, 0, (int)DN8(li_), 0};
              pg8::gemm_phase<EpiSwiGLU, DenseSched, false, false>(lds + RING_OFF, (LAS float*)(lds + MISC_OFF + 1024), D * 2 / 2, D * 2 / 2, D * 2 / 2, S, E, wave_s); }
            }
            GRID_BAR();
            if (DN8(li)) {
            if (PH_ON(11)) DUP_FOR(11) { ES_; PH_LOCALS; LAYER_LOCALS; DenseSched S; S.ord.init(NTOK / 256, 4, G, bx); S.A = (const char*)(R + R_HID); S.B = (const char*)(W + WA_D); S.a_tstep = (size_t)256 * FF * 1; S.b_tstep = (size_t)256 * FF * 1;
              S.ssp = nullptr; EpiRes E{HC, HO, SO, (unsigned char*)(R + R_H8), es_ * (1.0f / (W8_SCALE * H8_SCALE)), 0};
              pg8::gemm_phase<EpiRes, DenseSched, false, true>(lds + RING_OFF, (LAS float*)(lds + MISC_OFF + 1024), FF * 1 / 2, FF * 1 / 2, FF * 1 / 2, S, E, wave_s); }
            } else {
            if (PH_ON(11)) DUP_FOR(11) { ES_; PH_LOCALS; LAYER_LOCALS; DenseSched S; S.ord.init(NTOK / 256, 4, G, bx); S.A = (const char*)(R + R_HID); S.B = (const char*)(W + WA_D); S.a_tstep = (size_t)256 * FF * 2; S.b_tstep = (size_t)256 * FF * 2;
              S.ssp = nullptr; EpiRes E{HC, HO, SO, (unsigned char*)(R + R_H8), es_, 0};
              pg8::gemm_phase<EpiRes, DenseSched, false, false>(lds + RING_OFF, (LAS float*)(lds + MISC_OFF + 1024), FF * 2 / 2, FF * 2 / 2, FF * 2 / 2, S, E, wave_s); }
            }
            GRID_BAR(); cur ^= 1;
        } else {
            if (PH_ON(12)) DUP_FOR(12) { ES_; PH_LOCALS; LAYER_LOCALS; LAS float* wr_l = (LAS float*)(lds + RING_OFF);
              LAS int* e_l = (LAS int*)(lds + RING_OFF + 32768);
              LAS unsigned* bc_l = (LAS unsigned*)(lds + RING_OFF + 32768 + 2048);
              LAS float* lg_l = (LAS float*)(lds + RING_OFF + 32768 + 4096);
              const float* wrt = INP(30) + (size_t)j * D * NE;
              for (int it = tid; it < D * NE; it += 512) { const int k = it >> 3, e = it & 7, q = k >> 9, r = k & 511; wr_l[((q * 8 + (r & 7)) * 64 + (r >> 3)) * 8 + e] = wrt[it] * g_ffn[k]; }
              int* TOPE = (int*)(MS + MS_TOPE); float* TOPG = (float*)(MS + MS_TOPG); int* RANK = (int*)(MS + MS_RANK); int* BC = (int*)(MS + MS_BC);
              const bool b0 = lane & 1, b1 = lane & 2, b2 = lane & 4; const int eidx = 4 * (lane & 1) + (lane & 2) + ((lane >> 2) & 1);
              for (int vb = bx; vb < NTOK / 256; vb += G) {
                  if (tid < 16) bc_l[tid] = 0u;
                  __syncthreads();
                  for (int r8 = 0; r8 < 32; r8 += 8) {
                      u32x4 xw[8][2];
#pragma unroll
                      for (int rr = 0; rr < 8; ++rr) { const u32x4* xr = (const u32x4*)(HC + (size_t)(vb * 256 + wave * 32 + r8 + rr) * D) + lane; xw[rr][0] = xr[0]; xw[rr][1] = xr[64]; }
#pragma unroll
                      for (int rr = 0; rr < 8; ++rr) { float lg[8];
#pragma unroll
                          for (int e = 0; e < 8; ++e) lg[e] = 0.f;
#pragma unroll
                          for (int q = 0; q < 2; ++q) { const unsigned ww[4] = {xw[rr][q].x, xw[rr][q].y, xw[rr][q].z, xw[rr][q].w};
#pragma unroll
                              for (int c = 0; c < 8; ++c) { const float xv = (c & 1) ? bf_hi(ww[c >> 1]) : bf_lo(ww[c >> 1]); const LAS float* wp = wr_l + ((q * 8 + c) * 64 + lane) * 8; const f32x4 w0 = *(const LAS f32x4*)wp, w1 = *(const LAS f32x4*)(wp + 4);
#pragma unroll
                                  for (int e = 0; e < 4; ++e) { lg[e] += xv * w0[e]; lg[4 + e] += xv * w1[e]; } } }
                          float r4[4], r2[2];
#pragma unroll
                          for (int i = 0; i < 4; ++i) { const float snd = b0 ? lg[i] : lg[4 + i], kp = b0 ? lg[4 + i] : lg[i]; r4[i] = kp + swz_xor<1>(snd); }
#pragma unroll
                          for (int i = 0; i < 2; ++i) { const float snd = b1 ? r4[i] : r4[2 + i], kp = b1 ? r4[2 + i] : r4[i]; r2[i] = kp + swz_xor<2>(snd); }
                          float r1 = (b2 ? r2[1] : r2[0]) + swz_xor<4>(b2 ? r2[0] : r2[1]);
                          r1 += swz_xor<8>(r1); r1 += swz_xor<16>(r1); r1 = add_x32(r1);
                          if (lane < 8) lg_l[(wave * 32 + r8 + rr) * 8 + eidx] = r1; } }
                  __syncthreads();
                  if (tid < 256) { const int m = vb * 256 + tid; const float rstd = rstd_of(SC, m); float lg[8];
                      { const f32x4 a = *(const LAS f32x4*)(lg_l + tid * 8), b = *(const LAS f32x4*)(lg_l + tid * 8 + 4);
#pragma unroll
                        for (int e = 0; e < 4; ++e) { lg[e] = a[e] * rstd; lg[4 + e] = b[e] * rstd; } }
                      int e0 = 0; float v0 = lg[0];
#pragma unroll
                      for (int e = 1; e < 8; ++e) if (lg[e] > v0) { v0 = lg[e]; e0 = e; }
                      int e1 = -1; float v1 = -INFINITY;
#pragma unroll
                      for (int e = 0; e < 8; ++e) if (e != e0 && lg[e] > v1) { v1 = lg[e]; e1 = e; }
                      const float g0 = 1.0f / (1.0f + __expf(v1 - v0));
                      e_l[tid] = e0; e_l[256 + tid] = e1; TOPE[m * 2] = e0; TOPE[m * 2 + 1] = e1; TOPG[m * 2] = g0; TOPG[m * 2 + 1] = 1.0f - g0; }
                  __syncthreads();
                  if (tid < 256) { const int me0 = e_l[tid], me1 = e_l[256 + tid]; int r0 = 0, r1 = 0;
                      for (int q = 0; q < tid; ++q) { r0 += (e_l[q] == me0) ? 1 : 0; r1 += (e_l[256 + q] == me1) ? 1 : 0; }
                      const int m = vb * 256 + tid; RANK[m * 2] = r0; RANK[m * 2 + 1] = r1;
                      atomicAdd((unsigned*)&bc_l[me0], 1u); atomicAdd((unsigned*)&bc_l[8 + me1], 1u); }
                  __syncthreads();
                  if (tid < 16) BC[vb * 16 + tid] = (int)bc_l[tid];
                  __syncthreads();
              } }
            GRID_BAR();
            if (PH_ON(13)) DUP_FOR(13) { ES_; PH_LOCALS; LAYER_LOCALS; LAS int* bcl = (LAS int*)(lds + RING_OFF);
              const int* BC = (const int*)(MS + MS_BC); const int* TOPE = (const int*)(MS + MS_TOPE); const float* TOPG = (const float*)(MS + MS_TOPG); const int* RANK = (const int*)(MS + MS_RANK);
              int* STOK = (int*)(MS + MS_STOK); float* SGATE = (float*)(MS + MS_SGATE); float* SRS = (float*)(MS + MS_SRS);
              for (int it = tid; it < 256 * 16; it += 512) bcl[it] = BC[it];
              __syncthreads();
              if (tid < 16) { int run = 0; for (int vb = 0; vb < 256; ++vb) { const int c = bcl[vb * 16 + tid]; bcl[vb * 16 + tid] = run; run += c; } MISC[MW_CNT + tid] = (unsigned)run; }
              __syncthreads();
              if (tid < 2) { int ts = 0; for (int e = 0; e < 8; ++e) { MISC[MW_TST + tid * 9 + e] = (unsigned)ts; ts += ((int)MISC[MW_CNT + tid * 8 + e] + 255) >> 8; } MISC[MW_TST + tid * 9 + 8] = (unsigned)ts; }
              __syncthreads();
              LAS int* sl_l = (LAS int*)(lds + RING_OFF + 16384);
              for (int vb = bx; vb < NTOK / 256; vb += G) {
                  if (tid < 256) { const int m = vb * 256 + tid; const float rsm = rstd_of(SC, m);
#pragma unroll
                      for (int k = 0; k < 2; ++k) { const int e = TOPE[m * 2 + k]; const int slot = (int)MISC[MW_TST + k * 9 + e] * 256 + bcl[vb * 16 + k * 8 + e] + RANK[m * 2 + k];
                          STOK[k * SLOTS_PER_PASS + slot] = m; SGATE[k * SLOTS_PER_PASS + slot] = TOPG[m * 2 + k]; SRS[k * SLOTS_PER_PASS + slot] = rsm; sl_l[k * 256 + tid] = slot; } }
                  __syncthreads();
                  if (MOE_FP8) {
                      unsigned char* XS8 = R + R_XS8;
                      for (int t4 = wave * 32; t4 < wave * 32 + 32; t4 += 8) { u32x4 v[8];
#pragma unroll
                          for (int q = 0; q < 8; ++q) { const u32x4* hp = (const u32x4*)(HC + (size_t)(vb * 256 + t4 + q) * D + lane * 16); const u32x4 a = hp[0], b = hp[1];
                              v[q].x = pk_fp8x4(bf_lo(a.x), bf_hi(a.x), bf_lo(a.y), bf_hi(a.y)); v[q].y = pk_fp8x4(bf_lo(a.z), bf_hi(a.z), bf_lo(a.w), bf_hi(a.w));
                              v[q].z = pk_fp8x4(bf_lo(b.x), bf_hi(b.x), bf_lo(b.y), bf_hi(b.y)); v[q].w = pk_fp8x4(bf_lo(b.z), bf_hi(b.z), bf_lo(b.w), bf_hi(b.w)); }
#pragma unroll
                          for (int q = 0; q < 8; ++q) { const int s0 = sl_l[t4 + q], s1 = sl_l[256 + t4 + q];
                              *(u32x4*)(XS8 + (size_t)s0 * D + lane * 16) = v[q]; *(u32x4*)(XS8 + ((size_t)SLOTS_PER_PASS + s1) * D + lane * 16) = v[q]; } } }
                  __syncthreads();
              }
              __syncthreads();
            }
            GRID_BAR();
            static_assert(MOE_FP8 != 0, "the merged MoE phase parts read the pre-gathered e4m3 tokens");
            for (int k = 0; k < 3; ++k) {
#define MOE_LOCALS(kk) int k_ = (kk); asm volatile("" : "+s"(k_)); const volatile LAS unsigned* cnt = MISC + MW_CNT + k_ * 8; const volatile LAS unsigned* tst = MISC + MW_TST + k_ * 9; const int MT = (int)tst[8]; \
                const int* stok = (const int*)(MS + MS_STOK) + k_ * SLOTS_PER_PASS; const float* sgate = (const float*)(MS + MS_SGATE) + k_ * SLOTS_PER_PASS; (void)cnt; (void)sgate
                if (k >= 1) if (PH_ON(15)) DUP_FOR(15) { ES_; PH_LOCALS; LAYER_LOCALS; MOE_LOCALS(k - 1); MoeDownSched S; S.ord.init(MT, 4, G, bx); S.A = (const char*)(R + (k_ ? R_MHID1 : R_MHID)); S.B = (const char*)(W + WB_MD); S.tst = tst;
                  EpiMoeDown E{HC, HO, stok, sgate, SO, cnt, tst, (unsigned char*)(R + R_H8B), MOE_FP8 ? es_ * (1.0f / (W8_SCALE * H8_SCALE)) : es_, k_};
                  S.ssp = nullptr; pg8::gemm_phase<EpiMoeDown, MoeDownSched, false, MOE_FP8 != 0>(lds + RING_OFF, (LAS float*)(lds + MISC_OFF + 1024), FFE * MOE_ESZ / 2, FFE * MOE_ESZ / 2, FFE * MOE_ESZ / 2, S, E, wave_s); }
                if (k < 2) if (PH_ON(14)) DUP_FOR(14) { ES_; PH_LOCALS; LAYER_LOCALS; MOE_LOCALS(k); MoeGuSched S; S.ord.init(MT, 28, G, bx); if (k_ == 1) S.ord.comp(((int)MISC[MW_TST + 8] * 4) % G, 3);
                  S.A = (const char*)(R + R_XS8) + (size_t)k_ * SLOTS_PER_PASS * D; S.B = (const char*)(W + WB_MGU); S.stok = stok; S.cnt = cnt; S.tst = tst;
                  S.ssp = nullptr; EpiSwiGLU E{(bf16_t*)(R + (k_ ? R_MHID1 : R_MHID)), nullptr, (const float*)(MS + MS_SRS) + k_ * SLOTS_PER_PASS, FFE, MOE_FP8, MOE_FP8, 0};
                  pg8::gemm_phase<EpiSwiGLU, MoeGuSched, MOE_FP8 == 0, MOE_FP8 != 0>(lds + RING_OFF, (LAS float*)(lds + MISC_OFF + 1024), D * MOE_ESZ / 2, D * MOE_ESZ / 2, D * MOE_ESZ / 2, S, E, wave_s); }
                if (k < 2) { GRID_BAR(); if (k >= 1) cur ^= 1; }
            }
        }

        if (PH_ON(16)) DUP_FOR(16) { ES_; PH_LOCALS; LAYER_LOCALS; DenseSched S; S.ord.init(NTOK / 256, 4, G, bx); if (!is_attn) S.ord.comp(((int)MISC[MW_TST + 9 + 8] * 4) % G, 4); S.A = (const char*)P16; S.B = (const char*)(W + (is_attn ? WA_PP : WB_PP)); S.a_tstep = (size_t)256 * DPLE * 2; S.b_tstep = (size_t)256 * DPLE * 2;
          S.ssp = nullptr; EpiBf16 E{PROJ};
          pg8::gemm_phase<EpiBf16, DenseSched, false, false>(lds + RING_OFF, (LAS float*)(lds + MISC_OFF + 1024), DPLE, DPLE, DPLE, S, E, wave_s); }
        if (!is_attn) { GRID_BAR(); cur ^= 1; }
        if (PH_ON(17)) DUP_FOR(17) { ES_; PH_LOCALS; LAYER_LOCALS; DenseSched S; S.ord.init(NTOK / 256, 4, G, bx); S.A = (const char*)(R + (is_attn ? R_H8 : R_H8B)); S.B = (const char*)(W + (is_attn ? WA_PG : WB_PG)); S.a_tstep = (size_t)256 * D; S.b_tstep = (size_t)256 * D;
          S.ssp = nullptr; EpiPleGate E{HC, PROJ, SC, HO, SO, (li_ + 1 < DEPTH && QKV8(li_ + 1)) ? (unsigned char*)(R + R_H8) : nullptr, es_, 1.0f / W8_SCALE};
          pg8::gemm_phase<EpiPleGate, DenseSched, false, true>(lds + RING_OFF, (LAS float*)(lds + MISC_OFF + 1024), D / 2, D / 2, D / 2, S, E, wave_s); }
        if (!is_attn && li + 1 < nlayers) prep_layer(args, lds, wave_s, li + 1, cur);
        GRID_BAR(); cur ^= 1;
    }

    { PH_LOCALS; const float* ln_final = INP(5); const bool poison = xb_ld(&bar.bar[XB_TMO]) != 0u; float* OUT = args.out;
      const f32x4* gf = (const f32x4*)ln_final + 2 * lane; const f32x4 g00 = gf[0], g01 = gf[1], g10 = gf[128], g11 = gf[129];
      for (int m0 = gw * 4; m0 < NTOK; m0 += NGW * 4) {
        u32x4 w[4][2];
#pragma unroll
        for (int r = 0; r < 4; ++r) { const u32x4* xr = (const u32x4*)(HC + (size_t)(m0 + r) * D) + lane; w[r][0] = xr[0]; w[r][1] = xr[64]; }
        f32x4 v[4][4];
#pragma unroll
        for (int r = 0; r < 4; ++r) { float s = 0.f;
#pragma unroll
            for (int q = 0; q < 2; ++q) { const u32x4 x = w[r][q]; v[r][2 * q] = (f32x4){bf_lo(x.x), bf_hi(x.x), bf_lo(x.y), bf_hi(x.y)}; v[r][2 * q + 1] = (f32x4){bf_lo(x.z), bf_hi(x.z), bf_lo(x.w), bf_hi(x.w)}; s += sumsq8(v[r][2 * q], v[r][2 * q + 1]); }
            float rstd = __builtin_amdgcn_rsqf(wave_sum(s) * (1.f / D) + NORM_EPS); if (poison) rstd = __builtin_nanf("");
            v[r][0] = v[r][0] * rstd * g00; v[r][1] = v[r][1] * rstd * g01; v[r][2] = v[r][2] * rstd * g10; v[r][3] = v[r][3] * rstd * g11; }
#pragma unroll
        for (int r = 0; r < 4; ++r) { f32x4* o = (f32x4*)(OUT + (size_t)(m0 + r) * D) + 2 * lane; o[0] = v[r][0]; o[1] = v[r][1]; o[128] = v[r][2]; o[129] = v[r][3]; }
      } }
}

extern "C" void kernel_launch(void* const* d_in, const int* in_sizes, int n_in, void* d_out, int out_size, void* d_ws, size_t ws_size, hipStream_t stream) {
    static int grid = 0;
    if (grid == 0) {
        if (n_in != 34 || out_size != NTOK * D || ws_size < WS_END) { fprintf(stderr, "kernel_launch: unexpected shapes (n_in %d out %d ws %zu)\n", n_in, out_size, ws_size); grid = -1; return; }
        int dev = 0, cus = 0, per_cu = 0;
        if (hipGetDevice(&dev) != hipSuccess || hipDeviceGetAttribute(&cus, hipDeviceAttributeMultiprocessorCount, dev) != hipSuccess) { grid = -1; return; }
        if (hipFuncSetAttribute((const void*)fwd_kernel, hipFuncAttributeMaxDynamicSharedMemorySize, LDS_BYTES) != hipSuccess) { fprintf(stderr, "kernel_launch: hipFuncSetAttribute failed\n"); grid = -1; return; }
        if (hipOccupancyMaxActiveBlocksPerMultiprocessor(&per_cu, (const void*)fwd_kernel, 512, LDS_BYTES) != hipSuccess || per_cu < 1) { fprintf(stderr, "kernel_launch: occupancy query says %d\n", per_cu); }
        (void)hipGetLastError();
        grid = cus;
    }
    if (grid < 0) return;
    (void)hipMemsetAsync((char*)d_ws + WS_CTL, 0, CTL_ZERO_BYTES, stream);
    Args a{};
    for (int i = 0; i < 34; ++i) a.in[i] = (const float*)d_in[i];
    a.out = (float*)d_out; a.ws = (unsigned char*)d_ws; a.nlayers = DEPTH; a.pad = 0;
    hipLaunchKernelGGL(fwd_kernel, dim3(grid), dim3(512), LDS_BYTES, stream, a);
}
```
